# Optimizing an MI355X kernel written in HIP

```python
import math
import jax, jax.numpy as jnp
from jax import lax
import numpy as np

D_MODEL = 2048
BATCH = 4
SEQ = 2048
DEPTH = 1

RMS_EPS = 1e-6
GLA_HEADS = 4
GLA_DK = D_MODEL // 2 // GLA_HEADS
GLA_DV = D_MODEL // GLA_HEADS
GLA_QK = GLA_HEADS * GLA_DK
GLA_V = GLA_HEADS * GLA_DV
GLA_GATE_RANK = 16
GLA_TAU = 16.0
GLA_CHUNK = 64
DSA_HEADS = 16
DSA_HEAD_DIM = 128
DSA_W = DSA_HEADS * DSA_HEAD_DIM
IDX_HEADS = 8
IDX_DIM = 64
IDX_TOPK_MAX = 256
DSA_QBLOCK = 64
ROPE_THETA = 500000.0
ROPE_FRACTION = 4
D_FF = -(-8 * D_MODEL // (3 * 256)) * 256
N_MOD = 6

IN_SPLITS = (GLA_QK, GLA_QK, GLA_V, GLA_V, GLA_GATE_RANK,
             DSA_W, DSA_W, DSA_W,
             IDX_HEADS * IDX_DIM, IDX_DIM, IDX_HEADS,
             D_MODEL, D_MODEL)
IN_WIDTH = sum(IN_SPLITS)

kernel_name = "hybrid_gla_dsa_gated_merge_adaln"


def rms_norm(x, gain):
    xf = x.astype(jnp.float32)
    y = xf * lax.rsqrt(jnp.mean(xf * xf, axis=-1, keepdims=True) + RMS_EPS)
    return (y * gain.astype(jnp.float32)).astype(x.dtype)


def partial_rope(x, positions):
    d = x.shape[-1]
    rot = d // ROPE_FRACTION
    half = rot // 2
    inv_freq = jnp.power(ROPE_THETA, -jnp.arange(0, rot, 2, dtype=jnp.float32) / rot)
    ang = positions.astype(jnp.float32)[..., None] * inv_freq
    cos = jnp.cos(ang)[:, :, None, :]
    sin = jnp.sin(ang)[:, :, None, :]
    xf = x.astype(jnp.float32)
    x1, x2, rest = xf[..., :half], xf[..., half:rot], xf[..., rot:]
    out = jnp.concatenate([x1 * cos - x2 * sin, x1 * sin + x2 * cos, rest], axis=-1)
    return out.astype(x.dtype)


def gla_chunked(q, k, v, log_g):
    B, S, H, dk = q.shape
    dv = v.shape[-1]
    C = GLA_CHUNK
    N = S // C

    def chunks(a):
        return jnp.moveaxis(a.astype(jnp.float32).reshape(B, N, C, H, a.shape[-1]), 1, 0)

    qc, kc, vc = chunks(q), chunks(k), chunks(v)
    bc = jnp.cumsum(chunks(log_g), axis=2)
    causal = jnp.tril(jnp.ones((C, C), dtype=bool))[None, :, :, None, None]

    def step(state, inp):
        q_, k_, v_, b_ = inp
        diff = b_[:, :, None] - b_[:, None, :]
        decay = jnp.exp(jnp.where(causal, diff, -jnp.inf))
        attn = jnp.einsum('bihd,bjhd,bijhd->bijh', q_, k_, decay)
        o = (jnp.einsum('bijh,bjhv->bihv', attn, v_)
             + jnp.einsum('bihd,bhdv->bihv', q_ * jnp.exp(b_), state))
        b_last = b_[:, -1]
        k_dec = k_ * jnp.exp(b_last[:, None] - b_)
        state = state * jnp.exp(b_last)[..., None] + jnp.einsum('bjhd,bjhv->bhdv', k_dec, v_)
        return state, o

    state0 = jnp.zeros((B, H, dk, dv), jnp.float32)
    _, o = lax.scan(step, state0, (qc, kc, vc, bc))
    return jnp.moveaxis(o, 0, 1).reshape(B, S, H, dv)


def dsa_attention(q, k, v, iq, ik, iw):
    B, S, H, Dh = q.shape
    topk = min(IDX_TOPK_MAX, S // 4)
    QB = DSA_QBLOCK
    nblk = S // QB
    key_pos = jnp.arange(S)

    def blocks(a):
        return jnp.moveaxis(a.reshape((B, nblk, QB) + a.shape[2:]), 1, 0)

    ik32 = ik.astype(jnp.float32)

    def one_block(inp):
        qb, iqb, iwb, start = inp
        qpos = start + jnp.arange(QB)
        dots = jnp.einsum('bqhd,bsd->bqhs', iqb.astype(jnp.float32), ik32) * (IDX_DIM ** -0.5)
        score = jnp.einsum('bqh,bqhs->bqs', iwb.astype(jnp.float32), jax.nn.relu(dots))
        admissible = key_pos[None, :] <= qpos[:, None]
        score = jnp.where(admissible[None], score, -jnp.inf)
        _, idx = lax.top_k(score, topk)
        kg = jax.vmap(lambda kk, ii: kk[ii])(k, idx)
        vg = jax.vmap(lambda vv, ii: vv[ii])(v, idx)
        valid = idx <= qpos[None, :, None]
        logits = jnp.einsum('bqhd,bqkhd->bqhk', qb, kg).astype(jnp.float32) * (Dh ** -0.5)
        logits = jnp.where(valid[:, :, None, :], logits, -jnp.inf)
        p = jax.nn.softmax(logits, axis=-1)
        return jnp.einsum('bqhk,bqkhd->bqhd', p.astype(vg.dtype), vg)

    starts = jnp.arange(nblk) * QB
    out = lax.map(one_block, (blocks(q), blocks(iq), blocks(iw), starts))
    return jnp.moveaxis(out, 0, 1).reshape(B, S, H, Dh)


def hybrid_mixer(h, positions, w_in, gla_gate_up, gla_gate_bias, gla_norm_gain,
                 w_branch_gla, w_branch_dsa, w_merge_out):
    B, S, _ = h.shape
    proj = h @ w_in
    offsets = [int(o) for o in np.cumsum(IN_SPLITS)[:-1]]
    (g_q, g_k, g_v, g_r, g_lr, d_q, d_k, d_v, i_q, i_k, i_w,
     gate_a, gate_b) = jnp.split(proj, offsets, axis=-1)

    q_a = g_q.reshape(B, S, GLA_HEADS, GLA_DK) * (GLA_DK ** -0.5)
    k_a = g_k.reshape(B, S, GLA_HEADS, GLA_DK)
    v_a = g_v.reshape(B, S, GLA_HEADS, GLA_DV)
    log_g = jax.nn.log_sigmoid((g_lr @ gla_gate_up + gla_gate_bias).astype(jnp.float32)) / GLA_TAU
    o_a = gla_chunked(q_a, k_a, v_a, log_g.reshape(B, S, GLA_HEADS, GLA_DK))
    o_a = o_a * lax.rsqrt(jnp.mean(o_a * o_a, axis=-1, keepdims=True) + RMS_EPS)
    o_a = o_a * gla_norm_gain.astype(jnp.float32).reshape(GLA_HEADS, GLA_DV)
    o_a = (o_a.reshape(B, S, GLA_V) * jax.nn.silu(g_r.astype(jnp.float32))).astype(h.dtype)
    y_a = o_a @ w_branch_gla

    q_b = partial_rope(d_q.reshape(B, S, DSA_HEADS, DSA_HEAD_DIM), positions)
    k_b = partial_rope(d_k.reshape(B, S, DSA_HEADS, DSA_HEAD_DIM), positions)
    v_b = d_v.reshape(B, S, DSA_HEADS, DSA_HEAD_DIM)
    iq = partial_rope(i_q.reshape(B, S, IDX_HEADS, IDX_DIM), positions)
    ik = partial_rope(i_k[:, :, None, :], positions)[:, :, 0, :]
    iw = i_w * (IDX_HEADS ** -0.5)
    o_b = dsa_attention(q_b, k_b, v_b, iq, ik, iw).reshape(B, S, DSA_W)
    y_b = o_b @ w_branch_dsa

    merged = jax.nn.sigmoid(gate_a) * y_a + jax.nn.sigmoid(gate_b) * y_b
    return merged @ w_merge_out


def swiglu(h, w_gate_up, w_down):
    g, u = jnp.split(h @ w_gate_up, 2, axis=-1)
    return (jax.nn.silu(g) * u) @ w_down


def setup_inputs(seed: int = 0) -> dict:
    key = jax.random.key(seed)
    ks = jax.random.split(key, 17)
    f32 = jnp.float32

    def dense(k, shape, fan_in):
        return jax.random.normal(k, shape, f32) * (fan_in ** -0.5)

    x = jax.random.normal(ks[0], (BATCH, SEQ, D_MODEL), f32)
    c = jax.random.normal(ks[1], (BATCH, D_MODEL), f32)
    positions = jnp.broadcast_to(jnp.arange(SEQ, dtype=jnp.int32)[None, :], (BATCH, SEQ))
    norm1_gain = 1.0 + 0.02 * jax.random.normal(ks[2], (DEPTH, D_MODEL), f32)
    norm2_gain = 1.0 + 0.02 * jax.random.normal(ks[3], (DEPTH, D_MODEL), f32)
    w_ada = dense(ks[4], (DEPTH, D_MODEL, N_MOD * D_MODEL), D_MODEL)
    b_ada = 0.02 * jax.random.normal(ks[5], (DEPTH, N_MOD * D_MODEL), f32)
    w_in = dense(ks[6], (DEPTH, D_MODEL, IN_WIDTH), D_MODEL)
    gla_gate_up = dense(ks[7], (DEPTH, GLA_GATE_RANK, GLA_QK), GLA_GATE_RANK)
    gla_gate_bias = 0.1 * jax.random.normal(ks[8], (DEPTH, GLA_QK), f32)
    gla_norm_gain = 1.0 + 0.02 * jax.random.normal(ks[9], (DEPTH, GLA_V), f32)
    w_branch_gla = dense(ks[10], (DEPTH, GLA_V, D_MODEL), GLA_V)
    w_branch_dsa = dense(ks[11], (DEPTH, DSA_W, D_MODEL), DSA_W)
    w_merge_out = dense(ks[12], (DEPTH, D_MODEL, D_MODEL), D_MODEL)
    w_ffn_gate_up = dense(ks[13], (DEPTH, D_MODEL, 2 * D_FF), D_MODEL)
    w_ffn_down = dense(ks[14], (DEPTH, D_FF, D_MODEL), D_FF)
    final_norm_gain = 1.0 + 0.02 * jax.random.normal(ks[15], (D_MODEL,), f32)
    return {"x": x, "c": c, "positions": positions,
            "norm1_gain": norm1_gain, "norm2_gain": norm2_gain,
            "w_ada": w_ada, "b_ada": b_ada, "w_in": w_in,
            "gla_gate_up": gla_gate_up, "gla_gate_bias": gla_gate_bias,
            "gla_norm_gain": gla_norm_gain, "w_branch_gla": w_branch_gla,
            "w_branch_dsa": w_branch_dsa, "w_merge_out": w_merge_out,
            "w_ffn_gate_up": w_ffn_gate_up, "w_ffn_down": w_ffn_down,
            "final_norm_gain": final_norm_gain}


def reference(x, c, positions, norm1_gain, norm2_gain, w_ada, b_ada, w_in,
              gla_gate_up, gla_gate_bias, gla_norm_gain, w_branch_gla, w_branch_dsa,
              w_merge_out, w_ffn_gate_up, w_ffn_down, final_norm_gain):
    for layer in range(DEPTH):
        mod = jax.nn.silu(c) @ w_ada[layer] + b_ada[layer]
        sh1, sc1, g1, sh2, sc2, g2 = [m[:, None, :] for m in jnp.split(mod, N_MOD, axis=-1)]
        h = rms_norm(x, norm1_gain[layer]) * (1.0 + sc1) + sh1
        x = x + g1 * hybrid_mixer(h, positions, w_in[layer], gla_gate_up[layer],
                                  gla_gate_bias[layer], gla_norm_gain[layer],
                                  w_branch_gla[layer], w_branch_dsa[layer], w_merge_out[layer])
        h = rms_norm(x, norm2_gain[layer]) * (1.0 + sc2) + sh2
        x = x + g2 * swiglu(h, w_ffn_gate_up[layer], w_ffn_down[layer])
    return rms_norm(x, final_norm_gain)
```

```cpp
#include <hip/hip_runtime.h>
#include <hip/hip_cooperative_groups.h>
#include <cstdio>
#include <cstdint>
namespace cg = cooperative_groups;

#ifndef DBG
#define DBG 0
#endif
#ifndef PH_STOP
#define PH_STOP 99
#endif

constexpr int BATCH = 4, SEQ = 2048, DM = 2048, MTOK = BATCH * SEQ;
constexpr int INW = 16984, INWP = 17152, DFF = 5632, NMOD = 6 * DM;
constexpr int GH = 4, GDK = 256, GDV = 512, GRANK = 16, NCH = SEQ / 64;
constexpr int DH = 16, DHD = 128, IH = 8, ID = 64, TOPK = 256;
constexpr int SMALLW = 768;
constexpr float RMS_EPS = 1e-6f;
constexpr int SRC_GQ = 0, SRC_GK = 1024, SRC_GV = 2048, SRC_GR = 4096, SRC_GLR = 6144, SRC_DQ = 6160, SRC_DK = 8208, SRC_DV = 10256,
              SRC_IQ = 12304, SRC_IK = 12816, SRC_IW = 12880, SRC_GA = 12888, SRC_GB = 14936;
enum { I_X = 0, I_C, I_POS, I_N1G, I_N2G, I_WADA, I_BADA, I_WIN, I_GUP, I_GBIAS, I_GNG, I_WBGA, I_WBDSA, I_WMO, I_WGU, I_WDN, I_FNG };

constexpr size_t MiB = 1u << 20;
constexpr size_t WS_CTL = 0, CTL_BYTES = 1 * MiB;
constexpr size_t WS_MOD = 65536;
constexpr size_t WS_DBG = 512 * 1024;
constexpr size_t WS_ROPED = 1 * MiB;
constexpr size_t WS_ROPEI = 2 * MiB;
constexpr size_t WS_IW = 2 * MiB + 512 * 1024;
constexpr size_t WS_GDEC = 3 * MiB;
constexpr size_t WS_MASK = 4 * MiB;
constexpr size_t WS_IK = 6 * MiB;
constexpr size_t WS_IQ = 7 * MiB;
constexpr size_t WS_ATTN = 15 * MiB;
constexpr size_t WS_WBGA = 20 * MiB, WS_WBDSA = 28 * MiB, WS_WMO = 36 * MiB, WS_WGU = 44 * MiB, WS_WDN = 88 * MiB;
constexpr size_t WS_WIN = 110 * MiB;
constexpr size_t WS_OA = 110 * MiB;
constexpr size_t WS_H = 177 * MiB;
constexpr size_t WS_QA = 209 * MiB, WS_KA = 225 * MiB;
constexpr size_t WS_VA = 241 * MiB;
constexpr size_t WS_RA = 273 * MiB;
constexpr size_t WS_DQ = 305 * MiB, WS_DK = 337 * MiB;
constexpr size_t WS_DV = 369 * MiB;
constexpr size_t WS_SGA = 401 * MiB, WS_SGB = 433 * MiB;
constexpr size_t WS_SMALL = 465 * MiB;
constexpr size_t WS_END = 489 * MiB;
constexpr size_t WS_OB = WS_QA;
constexpr size_t WS_TMP = WS_VA;
constexpr size_t WS_MERGED = WS_DQ;
constexpr size_t WS_X1 = WS_DK;
constexpr size_t WS_ACT = WS_QA;

#define LAS __attribute__((address_space(3)))
typedef unsigned short bf16_t;
typedef short bf16x8 __attribute__((ext_vector_type(8)));
typedef short bf16x4 __attribute__((ext_vector_type(4)));
typedef float f32x4 __attribute__((ext_vector_type(4)));
typedef float f32x16 __attribute__((ext_vector_type(16)));
typedef unsigned u32x4 __attribute__((ext_vector_type(4)));
typedef unsigned u32x2 __attribute__((ext_vector_type(2)));
constexpr int NT = 512, NW = 8;
constexpr int RING_BYTES = 131072;
constexpr int LDS_BYTES = 147456;

__device__ __forceinline__ float bf2f(unsigned v) { return __uint_as_float(v << 16); }
__device__ __forceinline__ unsigned f2bf(float f) { unsigned u = __float_as_uint(f); return (u + 0x7fffu + ((u >> 16) & 1u)) >> 16; }
__device__ __forceinline__ unsigned pk2(float lo, float hi) { return f2bf(lo) | (f2bf(hi) << 16); }
__device__ __forceinline__ float wave_sum(float v) {
#pragma unroll
    for (int o = 1; o < 64; o <<= 1) v += __shfl_xor(v, o);
    return v;
}
__device__ __forceinline__ float siluf(float v) { return v / (1.f + __expf(-v)); }
__device__ __forceinline__ float sigmf(float v) { return 1.f / (1.f + __expf(-v)); }
__device__ __forceinline__ int crow(int r, int hi) { return (r & 3) + 8 * (r >> 2) + 4 * hi; }
namespace pg8 {
#define PG8_LAS __attribute__((address_space(3)))
typedef unsigned short bf16_t;
typedef short bf16x8 __attribute__((ext_vector_type(8)));
typedef float f32x4 __attribute__((ext_vector_type(4)));
typedef unsigned u32x4 __attribute__((ext_vector_type(4)));
constexpr int BM = 256, BK = 64, HALF = 128, HTB = HALF * BK * 2  , STAGE_BYTES = 8 * HTB, NXCD = 8, WGM = 8;

__host__ __device__ __forceinline__ int lds_byte(int r, int c) { const int st = (r >> 4) * 2 + (c >> 5), rr = r & 15, cc = c & 31, ob = rr * 64 + cc * 2; return st * 1024 + (ob ^ (((ob >> 9) & 1) << 5)); }
__host__ __device__ __forceinline__ void stage_rc(int b, int& R, int& C) { const int st = b / 1024, sb = b % 1024, swz = sb ^ (((sb >> 9) & 1) << 5); R = (st >> 1) * 16 + swz / 64; C = (st & 1) * 32 + (swz % 64) / 2; }
__host__ __device__ __forceinline__ int perm32(int rho) { const int n = rho >> 4, i = rho & 15; return 8 * (i >> 2) + 4 * n + (i & 3); }

struct Unit { int pm, pn; };
struct Gemm { const bf16_t* A; const bf16_t* Bt; int M, N, K; };

struct StaticOrder {
    int nM, nN, nwg, G, c;
    __host__ __device__ void init(int M, int N, int G_, int c_) { nM = M / BM; nN = N / BM; nwg = nM * nN; G = G_; c = c_; }
    __host__ __device__ bool next(int i, Unit& u) const {
        const long L = (long)i * G + c; if (L >= nwg) return false;
        int wgid = (int)L; { const int q = nwg / NXCD, r = nwg % NXCD, xcd = wgid % NXCD, off = wgid / NXCD; wgid = (xcd < r ? xcd * (q + 1) : r * (q + 1) + (xcd - r) * q) + off; }
        const int nig = WGM * nN, gid = wgid / nig, fm = gid * WGM, gsz = (nM - fm) < WGM ? (nM - fm) : WGM;
        u.pm = fm + ((wgid % nig) % gsz); u.pn = (wgid % nig) / gsz; return true;
    }
    __device__ __forceinline__ void a_ready(const Unit&) const {}
    __device__ __forceinline__ void done(const Unit&) const {}
};


__device__ __forceinline__ unsigned cvt_pk_bf16(float lo, float hi) { unsigned r; asm volatile("v_cvt_pk_bf16_f32 %0, %1, %2" : "=v"(r) : "v"(lo), "v"(hi)); return r; }
__device__ __forceinline__ void store8bf(bf16_t* p, f32x4 v0, f32x4 v1) {
    u32x4 w; w.x = cvt_pk_bf16(v0[0], v0[1]); w.y = cvt_pk_bf16(v0[2], v0[3]); w.z = cvt_pk_bf16(v1[0], v1[1]); w.w = cvt_pk_bf16(v1[2], v1[3]); *(u32x4*)p = w;
}
__device__ __forceinline__ f32x4 silu4(f32x4 v) { f32x4 o; o[0] = v[0] / (1.f + __expf(-v[0])); o[1] = v[1] / (1.f + __expf(-v[1])); o[2] = v[2] / (1.f + __expf(-v[2])); o[3] = v[3] / (1.f + __expf(-v[3])); return o; }
__device__ __forceinline__ f32x4 sigm4(f32x4 v) { f32x4 o; o[0] = 1.f / (1.f + __expf(-v[0])); o[1] = 1.f / (1.f + __expf(-v[1])); o[2] = 1.f / (1.f + __expf(-v[2])); o[3] = 1.f / (1.f + __expf(-v[3])); return o; }
__device__ __forceinline__ f32x4 bf4_to_f32(u32x2 w) { f32x4 o; o[0] = __uint_as_float(w.x << 16); o[1] = __uint_as_float(w.x & 0xffff0000u); o[2] = __uint_as_float(w.y << 16); o[3] = __uint_as_float(w.y & 0xffff0000u); return o; }

struct EpiInProj {
    static constexpr bool PERM = true, AFTER_DRAIN = false;
    unsigned char* ws;
    __device__ __forceinline__ void operator()(const f32x4 (&acc)[2][2][4][2], const Unit& u, int wr, int wc, int fr, int fq) const {
        const int pn = u.pn, row0 = u.pm * BM + wr * 64 + fr, cl = wc * 32 + 8 * fq;
        if (pn >= 64) {
            float* base = (float*)(ws + WS_SMALL) + 256 * (pn - 64) + cl;
#pragma unroll
            for (int ai = 0; ai < 2; ++ai)
#pragma unroll
                for (int m = 0; m < 4; ++m) { const int r = row0 + ai * HALF + m * 16; float* rp = base + (size_t)r * SMALLW;
#pragma unroll
                    for (int bj = 0; bj < 2; ++bj) { *(f32x4*)(rp + bj * HALF) = acc[ai][bj][m][0]; *(f32x4*)(rp + bj * HALF + 4) = acc[ai][bj][m][1]; } asm volatile("" ::: "memory"); }
            return;
        }
        size_t wsoff; int A, B, C, E = HALF, op = 0;
        if (pn < 8) { wsoff = pn < 4 ? WS_QA : WS_KA; A = 4 * 64 * 256; B = 256; C = (pn & 3) * 64 * 256; }
        else if (pn < 16) { wsoff = WS_VA; A = 4 * 64 * 512; B = 512; C = ((pn - 8) >> 1) * 64 * 512 + 256 * ((pn - 8) & 1); }
        else if (pn < 24) { wsoff = WS_RA; A = 64 * DM; B = DM; C = 256 * (pn - 16); op = 1; }
        else if (pn < 40) { wsoff = pn < 32 ? WS_DQ : WS_DK; A = 64 * DM; B = DM; C = 256 * ((pn - 24) & 7); op = 3; }
        else if (pn < 48) { wsoff = WS_DV; A = 16 * 64 * 128; B = 128; C = 2 * (pn - 40) * 64 * 128; E = 64 * 128; }
        else { wsoff = pn < 56 ? WS_SGA : WS_SGB; A = 64 * DM; B = DM; C = 256 * ((pn - 48) & 7); op = 2; }
        bf16_t* base = (bf16_t*)(ws + wsoff) + C + cl;
        const float2* roped = (const float2*)(ws + WS_ROPED) + 8 * (fq & 1);
        const float sg = (fq < 2) ? -1.f : 1.f;
        const bool rot = (op == 3) && (wc == 0);
#pragma unroll
        for (int ai = 0; ai < 2; ++ai)
#pragma unroll
            for (int m = 0; m < 4; ++m) { const int r = row0 + ai * HALF + m * 16; bf16_t* rp = base + (size_t)(r >> 6) * A + (r & 63) * B;
#pragma unroll
                for (int bj = 0; bj < 2; ++bj) { f32x4 v0 = acc[ai][bj][m][0], v1 = acc[ai][bj][m][1];
                    if (op == 1) { v0 = silu4(v0); v1 = silu4(v1); }
                    else if (op == 2) { v0 = sigm4(v0); v1 = sigm4(v1); }
                    else if (rot) { const f32x4* cs = (const f32x4*)(roped + (size_t)r * 16);
                        const f32x4 c01 = cs[0], c23 = cs[1], c45 = cs[2], c67 = cs[3];
                        const float p0 = __shfl_xor(v0[0], 32), p1 = __shfl_xor(v0[1], 32), p2 = __shfl_xor(v0[2], 32), p3 = __shfl_xor(v0[3], 32);
                        const float p4 = __shfl_xor(v1[0], 32), p5 = __shfl_xor(v1[1], 32), p6 = __shfl_xor(v1[2], 32), p7 = __shfl_xor(v1[3], 32);
                        v0[0] = v0[0] * c01[0] + sg * p0 * c01[1]; v0[1] = v0[1] * c01[2] + sg * p1 * c01[3]; v0[2] = v0[2] * c23[0] + sg * p2 * c23[1]; v0[3] = v0[3] * c23[2] + sg * p3 * c23[3];
                        v1[0] = v1[0] * c45[0] + sg * p4 * c45[1]; v1[1] = v1[1] * c45[2] + sg * p5 * c45[3]; v1[2] = v1[2] * c67[0] + sg * p6 * c67[1]; v1[3] = v1[3] * c67[2] + sg * p7 * c67[3]; }
                    store8bf(rp + bj * E, v0, v1); }
                asm volatile("" ::: "memory"); }
    }
};

struct EpiScaleF32 {
    static constexpr bool PERM = false, AFTER_DRAIN = false;
    float* C; const bf16_t* G;
    __device__ __forceinline__ void operator()(const f32x4 (&acc)[2][2][4][2], const Unit& u, int wr, int wc, int fr, int fq) const {
        const int row0 = u.pm * BM + wr * 64 + fr, col0 = u.pn * BM + wc * 32 + 4 * fq;
#pragma unroll
        for (int ai = 0; ai < 2; ++ai)
#pragma unroll
            for (int m = 0; m < 4; ++m) { const size_t off = (size_t)(row0 + ai * HALF + m * 16) * DM + col0;
#pragma unroll
                for (int bj = 0; bj < 2; ++bj)
#pragma unroll
                    for (int n = 0; n < 2; ++n) { const f32x4 g = bf4_to_f32(*(const u32x2*)(G + off + bj * HALF + n * 16)); *(f32x4*)(C + off + bj * HALF + n * 16) = acc[ai][bj][m][n] * g; } }
    }
};
struct EpiMerge {
    static constexpr bool PERM = true, AFTER_DRAIN = false;
    bf16_t* O; const float* T; const bf16_t* G;
    __device__ __forceinline__ void operator()(const f32x4 (&acc)[2][2][4][2], const Unit& u, int wr, int wc, int fr, int fq) const {
        const int row0 = u.pm * BM + wr * 64 + fr, col0 = u.pn * BM + wc * 32 + 8 * fq;
#pragma unroll
        for (int ai = 0; ai < 2; ++ai)
#pragma unroll
            for (int m = 0; m < 4; ++m) { const size_t off = (size_t)(row0 + ai * HALF + m * 16) * DM + col0;
#pragma unroll
                for (int bj = 0; bj < 2; ++bj) { const u32x4 gw = *(const u32x4*)(G + off + bj * HALF);
                    const f32x4 g0 = bf4_to_f32((u32x2){gw.x, gw.y}), g1 = bf4_to_f32((u32x2){gw.z, gw.w});
                    const f32x4 t0 = *(const f32x4*)(T + off + bj * HALF), t1 = *(const f32x4*)(T + off + bj * HALF + 4);
                    store8bf(O + off + bj * HALF, t0 + acc[ai][bj][m][0] * g0, t1 + acc[ai][bj][m][1] * g1); } }
    }
};
struct EpiResid {
    static constexpr bool PERM = false, AFTER_DRAIN = false;
    const float* base; float* out; const float* gate;
    __device__ __forceinline__ void operator()(const f32x4 (&acc)[2][2][4][2], const Unit& u, int wr, int wc, int fr, int fq) const {
        const int row0 = u.pm * BM + wr * 64 + fr, col0 = u.pn * BM + wc * 32 + 4 * fq;
        const float* gb = gate + (size_t)((u.pm * BM) >> 11) * NMOD + col0;
        f32x4 gv[2][2];
#pragma unroll
        for (int bj = 0; bj < 2; ++bj)
#pragma unroll
            for (int n = 0; n < 2; ++n) gv[bj][n] = *(const f32x4*)(gb + bj * HALF + n * 16);
#pragma unroll
        for (int ai = 0; ai < 2; ++ai)
#pragma unroll
            for (int m = 0; m < 4; ++m) { const size_t off = (size_t)(row0 + ai * HALF + m * 16) * DM + col0;
#pragma unroll
                for (int bj = 0; bj < 2; ++bj)
#pragma unroll
                    for (int n = 0; n < 2; ++n) *(f32x4*)(out + off + bj * HALF + n * 16) = *(const f32x4*)(base + off + bj * HALF + n * 16) + gv[bj][n] * acc[ai][bj][m][n]; }
    }
};
struct EpiSwiglu {
    static constexpr bool PERM = true, AFTER_DRAIN = false;
    bf16_t* O;
    __device__ __forceinline__ void operator()(const f32x4 (&acc)[2][2][4][2], const Unit& u, int wr, int wc, int fr, int fq) const {
        const int row0 = u.pm * BM + wr * 64 + fr, col0 = u.pn * HALF + wc * 32 + 8 * fq;
#pragma unroll
        for (int ai = 0; ai < 2; ++ai)
#pragma unroll
            for (int m = 0; m < 4; ++m) { bf16_t* rp = O + (size_t)(row0 + ai * HALF + m * 16) * DFF + col0;
                store8bf(rp, silu4(acc[ai][0][m][0]) * acc[ai][1][m][0], silu4(acc[ai][0][m][1]) * acc[ai][1][m][1]); }
    }
};
template <class Epi, class Sched, bool ALIGN_EPI = false, bool SP2 = false>
__device__ __forceinline__ void gemm_phase(PG8_LAS unsigned char* lds, const Gemm g, const Sched& S, const Epi& E) {
    const int tid = threadIdx.x, wid = __builtin_amdgcn_readfirstlane(tid >> 6), lane = tid & 63, wr = wid >> 2, wc = wid & 3, fr = lane & 15, fq = lane >> 4;
    const int K = g.K, nt = K / BK;
    unsigned voffA[2], voffB[2];
#pragma unroll
    for (int i = 0; i < 2; ++i) { int R, C; stage_rc(tid * 16 + i * 8192, R, C); const int Rb = Epi::PERM ? ((R & ~31) + perm32(R & 31)) : R;
        voffA[i] = (unsigned)(R * K + C) * 2u; voffB[i] = (unsigned)(Rb * K + C) * 2u; }
    const size_t kstep = (size_t)(BK * 2);
    const size_t hstep = (size_t)HALF * K * 2;
    const size_t tstep = 2 * hstep;
    const unsigned ldsw = (unsigned)wid * 1024u;
    const int aoff = lds_byte(wr * 64 + fr, fq * 8), boff = lds_byte(wc * 32 + fr, fq * 8);
#define PG8_SA(b, h) (((b) * 2 + (h)) * HTB)
#define PG8_SB(b, h) ((4 + (b) * 2 + (h)) * HTB)
#define PG8_STAGE(bufoff, gbase, voff) do { _Pragma("unroll") for (int _i = 0; _i < 2; ++_i) \
        __builtin_amdgcn_global_load_lds((const unsigned*)((const char*)(gbase) + (voff)[_i]), (PG8_LAS unsigned*)(lds + (bufoff) + ldsw + _i * 8192), 16, 0, 0); } while (0)
#define PG8_LDA(dst, b, h) do { _Pragma("unroll") for (int m = 0; m < 4; ++m) _Pragma("unroll") for (int k = 0; k < 2; ++k) dst[m][k] = *(const PG8_LAS bf16x8*)(lds + PG8_SA(b, h) + aoff + m * 2048 + k * 1024); } while (0)
#define PG8_LDB(dst, b, h) do { _Pragma("unroll") for (int n = 0; n < 2; ++n) _Pragma("unroll") for (int k = 0; k < 2; ++k) dst[n][k] = *(const PG8_LAS bf16x8*)(lds + PG8_SB(b, h) + boff + n * 2048 + k * 1024); } while (0)
#define PG8_MMA(ai, bj, At, Bt) do { __builtin_amdgcn_s_setprio(1); _Pragma("unroll") for (int m = 0; m < 4; ++m) _Pragma("unroll") for (int n = 0; n < 2; ++n) _Pragma("unroll") for (int k = 0; k < 2; ++k) \
        acc[ai][bj][m][n] = __builtin_amdgcn_mfma_f32_16x16x32_bf16(Bt[n][k], At[m][k], acc[ai][bj][m][n], 0, 0, 0); __builtin_amdgcn_s_setprio(0); } while (0)
#define PG8_WAIT_V(n) asm volatile("s_waitcnt vmcnt(" #n ")" ::: "memory")
#define PG8_WAIT_L(n) asm volatile("s_waitcnt lgkmcnt(" #n ")" ::: "memory")
#define PG8_BAR __builtin_amdgcn_s_barrier()
#define PG8_SCHED __builtin_amdgcn_sched_barrier(0)
    Unit cur, nxt; int ui = 0;
    if (!S.next(0, cur)) return;
    f32x4 acc[2][2][4][2];
#pragma unroll
    for (int a = 0; a < 2; ++a)
#pragma unroll
        for (int b = 0; b < 2; ++b)
#pragma unroll
            for (int m = 0; m < 4; ++m)
#pragma unroll
                for (int n = 0; n < 2; ++n) acc[a][b][m][n] = (f32x4){0.f, 0.f, 0.f, 0.f};
    bf16x8 At[4][2], B0[2][2], B1[2][2];
    const char* cA = (const char*)g.A + (size_t)cur.pm * tstep; const char* cB = (const char*)g.Bt + (size_t)cur.pn * tstep;
    S.a_ready(cur);
    if constexpr (SP2) {
        PG8_STAGE(PG8_SB(0, 0), cB, voffB); PG8_STAGE(PG8_SB(0, 1), cB + hstep, voffB); PG8_STAGE(PG8_SA(0, 0), cA, voffA); PG8_STAGE(PG8_SA(0, 1), cA + hstep, voffA);
        if (wr == 1) PG8_BAR;
        PG8_WAIT_V(2); PG8_BAR;
        PG8_STAGE(PG8_SB(1, 0), cB + kstep, voffB); PG8_STAGE(PG8_SA(1, 0), cA + kstep, voffA); PG8_STAGE(PG8_SB(1, 1), cB + hstep + kstep, voffB);
        PG8_WAIT_V(6); PG8_BAR;
    } else {
        PG8_STAGE(PG8_SB(0, 0), cB, voffB); PG8_STAGE(PG8_SA(0, 0), cA, voffA); PG8_STAGE(PG8_SB(0, 1), cB + hstep, voffB); PG8_STAGE(PG8_SA(0, 1), cA + hstep, voffA);
        if (wr == 1) PG8_BAR;
        PG8_WAIT_V(4); PG8_BAR;
        PG8_STAGE(PG8_SB(1, 0), cB + kstep, voffB); PG8_STAGE(PG8_SA(1, 0), cA + kstep, voffA); PG8_STAGE(PG8_SB(1, 1), cB + hstep + kstep, voffB);
        PG8_WAIT_V(6); PG8_BAR;
    }
    for (;;) {
        const bool has_next = S.next(ui + 1, nxt);
        const char* nA = has_next ? (const char*)g.A + (size_t)nxt.pm * tstep : cA; const char* nB = has_next ? (const char*)g.Bt + (size_t)nxt.pn * tstep : cB;
        for (int t = 0; t < nt; t += 2) {
            const bool last = (t == nt - 2);
            const char* a1 = cA + (size_t)(t + 1) * kstep;
            const char* a2 = last ? nA : cA + (size_t)(t + 2) * kstep; const char* b2 = last ? nB : cB + (size_t)(t + 2) * kstep;
            const char* a3 = a2 + kstep; const char* b3 = b2 + kstep;
            if (last && has_next) S.a_ready(nxt);
            if constexpr (SP2) {
            PG8_LDB(B0, 0, 0); PG8_LDB(B1, 0, 1); PG8_SCHED; PG8_LDA(At, 0, 0); PG8_STAGE(PG8_SA(1, 1), a1 + hstep, voffA);
            PG8_WAIT_V(8); PG8_WAIT_L(0); PG8_BAR; PG8_MMA(0, 0, At, B0); PG8_MMA(0, 1, At, B1); PG8_BAR; PG8_SCHED;
            PG8_LDA(At, 0, 1); PG8_STAGE(PG8_SB(0, 0), b2, voffB); PG8_STAGE(PG8_SB(0, 1), b2 + hstep, voffB); PG8_STAGE(PG8_SA(0, 0), a2, voffA);
            PG8_WAIT_V(8); PG8_WAIT_L(0); PG8_BAR; PG8_MMA(1, 0, At, B0); PG8_MMA(1, 1, At, B1); PG8_BAR; PG8_SCHED;
            PG8_LDB(B0, 1, 0); PG8_LDB(B1, 1, 1); PG8_SCHED; PG8_LDA(At, 1, 0); PG8_STAGE(PG8_SA(0, 1), a2 + hstep, voffA);
            PG8_WAIT_V(8); PG8_WAIT_L(0); PG8_BAR; PG8_MMA(0, 0, At, B0); PG8_MMA(0, 1, At, B1); PG8_BAR; PG8_SCHED;
            PG8_LDA(At, 1, 1); PG8_STAGE(PG8_SB(1, 0), b3, voffB); PG8_STAGE(PG8_SB(1, 1), b3 + hstep, voffB); PG8_STAGE(PG8_SA(1, 0), a3, voffA);
            PG8_WAIT_V(8); PG8_WAIT_L(0); PG8_BAR; PG8_MMA(1, 0, At, B0); PG8_MMA(1, 1, At, B1); PG8_BAR; PG8_SCHED;
            } else {
            PG8_LDB(B0, 0, 0); PG8_SCHED; PG8_LDA(At, 0, 0); PG8_STAGE(PG8_SA(1, 1), a1 + hstep, voffA);
            PG8_WAIT_L(8); PG8_BAR; PG8_WAIT_L(0); PG8_MMA(0, 0, At, B0); PG8_BAR; PG8_SCHED;
            PG8_LDB(B1, 0, 1); PG8_STAGE(PG8_SB(0, 0), b2, voffB);
            PG8_BAR; PG8_WAIT_L(0); PG8_MMA(0, 1, At, B1); PG8_BAR;
            PG8_LDA(At, 0, 1); PG8_STAGE(PG8_SA(0, 0), a2, voffA);
            PG8_BAR; PG8_WAIT_L(0); PG8_MMA(1, 0, At, B0); PG8_BAR; PG8_SCHED;
            PG8_STAGE(PG8_SB(0, 1), b2 + hstep, voffB);
            PG8_WAIT_V(6); PG8_BAR; PG8_MMA(1, 1, At, B1); PG8_BAR;
            PG8_LDB(B0, 1, 0); PG8_SCHED; PG8_LDA(At, 1, 0); PG8_STAGE(PG8_SA(0, 1), a2 + hstep, voffA);
            PG8_WAIT_L(8); PG8_BAR; PG8_WAIT_L(0); PG8_MMA(0, 0, At, B0); PG8_BAR; PG8_SCHED;
            PG8_LDB(B1, 1, 1); PG8_STAGE(PG8_SB(1, 0), b3, voffB);
            PG8_BAR; PG8_WAIT_L(0); PG8_MMA(0, 1, At, B1); PG8_BAR;
            PG8_LDA(At, 1, 1); PG8_STAGE(PG8_SA(1, 0), a3, voffA);
            PG8_BAR; PG8_WAIT_L(0); PG8_MMA(1, 0, At, B0); PG8_BAR; PG8_SCHED;
            PG8_STAGE(PG8_SB(1, 1), b3 + hstep, voffB);
            PG8_WAIT_V(6); PG8_BAR; PG8_MMA(1, 1, At, B1); PG8_BAR;
            }
        }
        if constexpr (ALIGN_EPI) { if (wr == 0) PG8_BAR; }
        if constexpr (!Epi::AFTER_DRAIN) { E(acc, cur, wr, wc, fr, fq); S.done(cur); }
        if (!has_next) break;
#pragma unroll
        for (int a = 0; a < 2; ++a)
#pragma unroll
            for (int b = 0; b < 2; ++b)
#pragma unroll
                for (int m = 0; m < 4; ++m)
#pragma unroll
                    for (int n = 0; n < 2; ++n) acc[a][b][m][n] = (f32x4){0.f, 0.f, 0.f, 0.f};
        cur = nxt; cA = nA; cB = nB; ++ui;
        if constexpr (ALIGN_EPI) { if (wr == 1) PG8_BAR; }
    }
    PG8_WAIT_V(0);
    if constexpr (!ALIGN_EPI) { if (wr == 0) PG8_BAR; }
    PG8_BAR;
    if constexpr (Epi::AFTER_DRAIN) { E.fused(acc, cur, wr, wc, fr, fq, lds, wid, lane); S.done(cur); }
#undef PG8_SA
#undef PG8_SB
#undef PG8_STAGE
#undef PG8_LDA
#undef PG8_LDB
#undef PG8_MMA
#undef PG8_WAIT_V
#undef PG8_WAIT_L
#undef PG8_BAR
#undef PG8_SCHED
}
}

struct Args { const float* in[17]; float* out; unsigned char* ws; int ph_lo, ph_hi; };

struct Ctx { LAS unsigned char* lds; unsigned char* ws; int tid, lane, wave, bid, G; };

#define LDS_WAIT() asm volatile("s_waitcnt lgkmcnt(0)" ::: "memory")
#define MFMA32(a, b, c) __builtin_amdgcn_mfma_f32_32x32x16_bf16((a), (b), (c), 0, 0, 0)
#define MFMA16(a, b, c) __builtin_amdgcn_mfma_f32_16x16x32_bf16((a), (b), (c), 0, 0, 0)

__device__ __forceinline__ int map_win(int n) {
    if (n < 1024) return SRC_GQ + n;
    if (n < 2048) return SRC_GK + (n - 1024);
    if (n < 4096) return SRC_GV + (n - 2048);
    if (n < 6144) return SRC_GR + (n - 4096);
    if (n < 8192) return SRC_DQ + (n - 6144);
    if (n < 10240) return SRC_DK + (n - 8192);
    if (n < 12288) return SRC_DV + (n - 10240);
    if (n < 14336) return SRC_GA + (n - 12288);
    if (n < 16384) return SRC_GB + (n - 14336);
    if (n < 16896) return SRC_IQ + (n - 16384);
    n -= 16896;
    if (n < 16) return SRC_GLR + n;
    if (n < 80) return SRC_IK + (n - 16);
    if (n < 88) return SRC_IW + (n - 80);
    return -1;
}
__device__ __forceinline__ int map_wgu(int n) { const int j = n >> 8, rr = n & 255; return rr < 128 ? 128 * j + rr : DFF + 128 * j + (rr - 128); }

__device__ __forceinline__ void transpose_item(const float* W, int N, bf16_t* WT, int K, LAS float* scr, int kb, int nb, int lane, int src) {
    const int k0 = 64 * kb, n0 = 32 * nb;
    const float* wp = W + (size_t)(k0 + (lane >> 5)) * N + (src >= 0 ? src : 0);
#pragma unroll 8
    for (int i = 0; i < 32; ++i) { const float v = (src >= 0) ? wp[(size_t)(2 * i) * N] : 0.f; scr[(2 * i + (lane >> 5)) * 33 + (lane & 31)] = v; }
    LDS_WAIT();
    const int c = lane & 7;
#pragma unroll
    for (int j = 0; j < 4; ++j) { const int n = (lane >> 3) + 8 * j; const LAS float* s = scr + (8 * c) * 33 + n;
        u32x4 o; o.x = pk2(s[0 * 33], s[1 * 33]); o.y = pk2(s[2 * 33], s[3 * 33]); o.z = pk2(s[4 * 33], s[5 * 33]); o.w = pk2(s[6 * 33], s[7 * 33]);
        *(u32x4*)(WT + (size_t)(n0 + n) * K + k0 + 8 * c) = o; }
    LDS_WAIT();
}

__device__ __forceinline__ void p0_prologue(const Ctx& X, const Args& a) {
    unsigned char* ws = X.ws;
    {
        LAS float* sc = (LAS float*)X.lds;
        float* mod = (float*)(ws + WS_MOD);
        const float* wada = a.in[I_WADA]; const float* cvec = a.in[I_C]; const float* bada = a.in[I_BADA];
        for (int u = X.bid; u < 384; u += X.G) {
            const int kc = u / 6, cb = u % 6, k0 = 32 * kc, col = cb * 2048 + 4 * X.tid;
            if (X.tid < 128) { const float v = cvec[(X.tid >> 5) * DM + k0 + (X.tid & 31)]; sc[X.tid] = siluf(v); }
            __syncthreads();
            f32x4 acc[4];
#pragma unroll
            for (int b = 0; b < 4; ++b) acc[b] = (f32x4){0.f, 0.f, 0.f, 0.f};
#pragma unroll 4
            for (int kk = 0; kk < 32; ++kk) { const f32x4 w = *(const f32x4*)(wada + (size_t)(k0 + kk) * NMOD + col);
#pragma unroll
                for (int b = 0; b < 4; ++b) acc[b] += w * sc[b * 32 + kk]; }
            if (kc == 0) { const f32x4 bv = *(const f32x4*)(bada + col);
#pragma unroll
                for (int b = 0; b < 4; ++b) acc[b] += bv; }
#pragma unroll
            for (int b = 0; b < 4; ++b)
#pragma unroll
                for (int j = 0; j < 4; ++j) unsafeAtomicAdd(mod + b * NMOD + col + j, acc[b][j]);
            __syncthreads();
        }
    }
    {
        const int* pos = (const int*)a.in[I_POS];
        float2* rd = (float2*)(ws + WS_ROPED); float2* ri = (float2*)(ws + WS_ROPEI);
        for (int i = X.bid * NT + X.tid; i < MTOK * 24; i += X.G * NT) {
            if (i < MTOK * 16) { const int m = i >> 4, j = i & 15; const float inv = powf(500000.0f, -(float)j / 16.0f); const float ang = (float)pos[m] * inv; float s, c; sincosf(ang, &s, &c); rd[i] = make_float2(c, s); }
            else { const int i2 = i - MTOK * 16, m = i2 >> 3, j = i2 & 7; const float inv = powf(500000.0f, -(float)j / 8.0f); const float ang = (float)pos[m] * inv; float s, c; sincosf(ang, &s, &c); ri[i2] = make_float2(c, s); }
        }
    }
    {
        LAS float* scr = (LAS float*)(X.lds + 1024 + X.wave * 8704);
        const int gw = X.bid * NW + X.wave, NGW = X.G * NW;
        constexpr int I_IN = 32 * (INWP / 32), I_SQ = 32 * 64, I_GU = 32 * (2 * DFF / 32), I_DN = (DFF / 64) * 64;
        constexpr int NITEMS = I_IN + 3 * I_SQ + I_GU + I_DN;
        for (int it = gw; it < NITEMS; it += NGW) {
            int r = it;
            if (r < I_IN) { const int nbk = INWP / 32, kb = r / nbk, nb = r % nbk; transpose_item(a.in[I_WIN], INW, (bf16_t*)(ws + WS_WIN), DM, scr, kb, nb, X.lane, map_win(32 * nb + (X.lane & 31))); continue; } r -= I_IN;
            if (r < I_SQ) { const int kb = r / 64, nb = r % 64; transpose_item(a.in[I_WBGA], DM, (bf16_t*)(ws + WS_WBGA), DM, scr, kb, nb, X.lane, 32 * nb + (X.lane & 31)); continue; } r -= I_SQ;
            if (r < I_SQ) { const int kb = r / 64, nb = r % 64; transpose_item(a.in[I_WBDSA], DM, (bf16_t*)(ws + WS_WBDSA), DM, scr, kb, nb, X.lane, 32 * nb + (X.lane & 31)); continue; } r -= I_SQ;
            if (r < I_SQ) { const int kb = r / 64, nb = r % 64; transpose_item(a.in[I_WMO], DM, (bf16_t*)(ws + WS_WMO), DM, scr, kb, nb, X.lane, 32 * nb + (X.lane & 31)); continue; } r -= I_SQ;
            if (r < I_GU) { const int nbk = 2 * DFF / 32, kb = r / nbk, nb = r % nbk; transpose_item(a.in[I_WGU], 2 * DFF, (bf16_t*)(ws + WS_WGU), DM, scr, kb, nb, X.lane, map_wgu(32 * nb + (X.lane & 31))); continue; } r -= I_GU;
            { const int kb = r / 64, nb = r % 64; transpose_item(a.in[I_WDN], DM, (bf16_t*)(ws + WS_WDN), DFF, scr, kb, nb, X.lane, 32 * nb + (X.lane & 31)); }
        }
    }
}

__device__ __forceinline__ void norm_mod_rows(const Ctx& X, const float* x, const float* gain, const float* mod, int i_sh, int i_sc, bf16_t* out) {
    const int gw = X.bid * NW + X.wave, NGW = X.G * NW;
    for (int row = gw; row < MTOK; row += NGW) {
        const int b = row >> 11;
        const f32x4* xr = (const f32x4*)(x + (size_t)row * DM) + X.lane;
        f32x4 v[8]; float s = 0.f;
#pragma unroll
        for (int j = 0; j < 8; ++j) { v[j] = xr[64 * j]; s += (v[j][0] * v[j][0] + v[j][1] * v[j][1]) + (v[j][2] * v[j][2] + v[j][3] * v[j][3]); }
        const float rs = rsqrtf(wave_sum(s) * (1.f / DM) + RMS_EPS);
        const f32x4* g4 = (const f32x4*)gain + X.lane;
        const f32x4* sh4 = (const f32x4*)(mod + (size_t)b * NMOD + i_sh * DM) + X.lane;
        const f32x4* sc4 = (const f32x4*)(mod + (size_t)b * NMOD + i_sc * DM) + X.lane;
        u32x2* o8 = (u32x2*)(out + (size_t)row * DM) + X.lane;
#pragma unroll
        for (int j = 0; j < 8; ++j) { const f32x4 y = v[j] * rs * g4[64 * j] * (sc4[64 * j] + 1.f) + sh4[64 * j]; u32x2 w; w.x = pk2(y[0], y[1]); w.y = pk2(y[2], y[3]); o8[64 * j] = w; }
    }
}
__device__ __forceinline__ void final_norm_rows(const Ctx& X, float* x, const float* gain) {
    const int gw = X.bid * NW + X.wave, NGW = X.G * NW;
    for (int row = gw; row < MTOK; row += NGW) {
        f32x4* xr = (f32x4*)(x + (size_t)row * DM) + X.lane;
        f32x4 v[8]; float s = 0.f;
#pragma unroll
        for (int j = 0; j < 8; ++j) { v[j] = xr[64 * j]; s += (v[j][0] * v[j][0] + v[j][1] * v[j][1]) + (v[j][2] * v[j][2] + v[j][3] * v[j][3]); }
        const float rs = rsqrtf(wave_sum(s) * (1.f / DM) + RMS_EPS);
        const f32x4* g4 = (const f32x4*)gain + X.lane;
#pragma unroll
        for (int j = 0; j < 8; ++j) xr[64 * j] = v[j] * rs * g4[64 * j];
    }
}

__device__ __forceinline__ float log_sigmoid_f(float z) { return fminf(z, 0.f) - log1pf(expf(-fabsf(z))); }

__device__ __forceinline__ void gla_prep_unit(const Ctx& X, const Args& a, int u) {
    unsigned char* ws = X.ws; const int tid = X.tid, lane = X.lane, wave = X.wave;
    LAS bf16_t* qs = (LAS bf16_t*)X.lds;
    LAS bf16_t* ks = (LAS bf16_t*)(X.lds + 33792);
    LAS float* glr = (LAS float*)(X.lds + 67584);
    LAS float* tot = (LAS float*)(X.lds + 71680);
    const int h = u & 3, row0 = (u >> 2) * 64;
    bf16_t* qblk = (bf16_t*)(ws + WS_QA) + (size_t)u * 64 * 256;
    bf16_t* kblk = (bf16_t*)(ws + WS_KA) + (size_t)u * 64 * 256;
    const float* small = (const float*)(ws + WS_SMALL);
    for (int i = tid; i < 1024; i += NT) glr[i] = small[(size_t)(row0 + (i >> 4)) * SMALLW + 512 + (i & 15)];
    const int d = tid & 255, half = tid >> 8;
    float up[16];
#pragma unroll
    for (int r = 0; r < 16; ++r) up[r] = a.in[I_GUP][r * 1024 + h * 256 + d];
    const float bias = a.in[I_GBIAS][h * 256 + d];
    __syncthreads();
    float tsum = 0.f;
    for (int tt = 0; tt < 32; ++tt) { const int t = 32 * half + tt; float z = bias;
#pragma unroll
        for (int r = 0; r < 16; ++r) z += glr[t * 16 + r] * up[r];
        tsum += log_sigmoid_f(z) * 0.0625f; }
    if (half == 0) tot[d] = tsum;
    __syncthreads();
    float cum = half ? tot[d] : 0.f;
#pragma unroll 2
    for (int tt = 0; tt < 32; ++tt) { const int t = 32 * half + tt; float z = bias;
#pragma unroll
        for (int r = 0; r < 16; ++r) z += glr[t * 16 + r] * up[r];
        cum += log_sigmoid_f(z) * 0.0625f;
        const float qv = bf2f(qblk[t * 256 + d]), kv = bf2f(kblk[t * 256 + d]);
        const unsigned qt = f2bf(qv * expf(cum) * 0.0625f), kt = f2bf(kv * expf(-cum));
        qblk[t * 256 + d] = (bf16_t)qt; qs[t * 264 + d] = (bf16_t)qt; ks[t * 264 + d] = (bf16_t)kt; }
    if (half == 1) ((float*)(ws + WS_GDEC))[(size_t)u * 256 + d] = expf(cum);
    __syncthreads();
    {
        u32x4* dst = (u32x4*)(kblk + d * 64 + 32 * half);
#pragma unroll
        for (int i = 0; i < 4; ++i) { unsigned e[8];
#pragma unroll
            for (int k = 0; k < 8; ++k) e[k] = ks[(32 * half + 8 * i + k) * 264 + d];
            dst[i] = (u32x4){e[0] | (e[1] << 16), e[2] | (e[3] << 16), e[4] | (e[5] << 16), e[6] | (e[7] << 16)}; }
    }
    if (wave < 4) {
        const int ti = wave >> 1, tj = wave & 1, r32 = lane & 31, hi = lane >> 5;
        f32x16 acc;
#pragma unroll
        for (int r = 0; r < 16; ++r) acc[r] = 0.f;
#pragma unroll
        for (int s = 0; s < 16; ++s) { const bf16x8 af = *(const LAS bf16x8*)(qs + (32 * ti + r32) * 264 + 16 * s + 8 * hi); const bf16x8 bf = *(const LAS bf16x8*)(ks + (32 * tj + r32) * 264 + 16 * s + 8 * hi); acc = MFMA32(af, bf, acc); }
        bf16_t* at = (bf16_t*)(ws + WS_ATTN) + (size_t)u * 4096;
#pragma unroll
        for (int r = 0; r < 16; ++r) { const int i = 32 * ti + crow(r, hi), j = 32 * tj + r32; at[i * 64 + j] = (bf16_t)f2bf(j <= i ? acc[r] : 0.f); }
    }
    __syncthreads();
    {
        LAS bf16_t* vs = (LAS bf16_t*)X.lds;
        bf16_t* vblk = (bf16_t*)(ws + WS_VA) + (size_t)u * 64 * 512;
#pragma unroll
        for (int i = 0; i < 8; ++i) { const int id = tid + NT * i, t = id >> 6, c16 = id & 63; *(LAS u32x4*)(vs + t * 520 + 8 * c16) = *(const u32x4*)(vblk + t * 512 + 8 * c16); }
        __syncthreads();
#pragma unroll
        for (int i = 0; i < 8; ++i) { const int id = tid + NT * i, tq = id & 7, dv = id >> 3; unsigned e[8];
#pragma unroll
            for (int k = 0; k < 8; ++k) e[k] = vs[(8 * tq + k) * 520 + dv];
            *(u32x4*)(vblk + dv * 64 + 8 * tq) = (u32x4){e[0] | (e[1] << 16), e[2] | (e[3] << 16), e[4] | (e[5] << 16), e[6] | (e[7] << 16)}; }
    }
    __syncthreads();
}

__device__ __forceinline__ void dv_transpose(const Ctx& X) {
    LAS bf16_t* scr = (LAS bf16_t*)(X.lds + X.wave * 17408);
    const int gw = X.bid * NW + X.wave, NGW = X.G * NW, lane = X.lane;
    for (int blk = gw; blk < BATCH * NCH * DH; blk += NGW) {
        bf16_t* p = (bf16_t*)(X.ws + WS_DV) + (size_t)blk * 64 * 128;
#pragma unroll
        for (int i = 0; i < 16; ++i) { const int id = lane + 64 * i, t = id >> 4, c16 = id & 15; *(LAS u32x4*)(scr + t * 136 + 8 * c16) = *(const u32x4*)(p + t * 128 + 8 * c16); }
        LDS_WAIT();
#pragma unroll
        for (int i = 0; i < 16; ++i) { const int id = lane + 64 * i, kq = id & 7, dd = id >> 3; unsigned e[8];
#pragma unroll
            for (int k = 0; k < 8; ++k) e[k] = scr[(8 * kq + k) * 136 + dd];
            *(u32x4*)(p + dd * 64 + 8 * kq) = (u32x4){e[0] | (e[1] << 16), e[2] | (e[3] << 16), e[4] | (e[5] << 16), e[6] | (e[7] << 16)}; }
        LDS_WAIT();
    }
}

__device__ __forceinline__ void idx_prep(const Ctx& X) {
    const int gw = X.bid * NW + X.wave, NGW = X.G * NW, lane = X.lane;
    const float* small = (const float*)(X.ws + WS_SMALL);
    const float2* ri = (const float2*)(X.ws + WS_ROPEI);
    for (int m = gw; m < MTOK; m += NGW) {
        const float* sr = small + (size_t)m * SMALLW;
        float2 cs[8];
#pragma unroll
        for (int e = 0; e < 8; ++e) cs[e] = ri[(size_t)m * 8 + e];
        {
            const int seg = lane & 7; float v[8];
            const f32x4 a0 = *(const f32x4*)(sr + 8 * lane), a1 = *(const f32x4*)(sr + 8 * lane + 4);
            v[0] = a0[0]; v[1] = a0[1]; v[2] = a0[2]; v[3] = a0[3]; v[4] = a1[0]; v[5] = a1[1]; v[6] = a1[2]; v[7] = a1[3];
#pragma unroll
            for (int e = 0; e < 8; ++e) { const float p = __shfl_xor(v[e], 1); if (seg == 0) v[e] = v[e] * cs[e].x - p * cs[e].y; else if (seg == 1) v[e] = p * cs[e].y + v[e] * cs[e].x; }
            *(u32x4*)((bf16_t*)(X.ws + WS_IQ) + (size_t)m * 512 + 8 * lane) = (u32x4){pk2(v[0], v[1]), pk2(v[2], v[3]), pk2(v[4], v[5]), pk2(v[6], v[7])};
        }
        {
            const int l7 = lane & 7; float v[8];
            const f32x4 a0 = *(const f32x4*)(sr + 528 + 8 * l7), a1 = *(const f32x4*)(sr + 528 + 8 * l7 + 4);
            v[0] = a0[0]; v[1] = a0[1]; v[2] = a0[2]; v[3] = a0[3]; v[4] = a1[0]; v[5] = a1[1]; v[6] = a1[2]; v[7] = a1[3];
#pragma unroll
            for (int e = 0; e < 8; ++e) { const float p = __shfl_xor(v[e], 1); if (l7 == 0) v[e] = v[e] * cs[e].x - p * cs[e].y; else if (l7 == 1) v[e] = p * cs[e].y + v[e] * cs[e].x; }
            if (lane < 8) *(u32x4*)((bf16_t*)(X.ws + WS_IK) + (size_t)m * 64 + 8 * lane) = (u32x4){pk2(v[0], v[1]), pk2(v[2], v[3]), pk2(v[4], v[5]), pk2(v[6], v[7])};
            if (lane < 8) ((float*)(X.ws + WS_IW))[(size_t)m * 8 + lane] = sr[592 + lane] * 0.044194173824159216f;
        }
    }
}

__device__ __forceinline__ void gla_scan_unit(const Ctx& X, int unit) {
    unsigned char* ws = X.ws; const int tid = X.tid, lane = X.lane, wave = X.wave, r32 = lane & 31, hi = lane >> 5;
    const int half = unit & 1, h = (unit >> 1) & 3, b = unit >> 3;
    LAS bf16_t* qs = (LAS bf16_t*)X.lds;
    LAS bf16_t* kts = (LAS bf16_t*)(X.lds + 33792);
    LAS bf16_t* as_ = (LAS bf16_t*)(X.lds + 70656);
    LAS bf16_t* vts = (LAS bf16_t*)(X.lds + 79872);
    LAS float* gd = (LAS float*)(X.lds + 116736);
    f32x16 S[8];
#pragma unroll
    for (int k = 0; k < 8; ++k)
#pragma unroll
        for (int r = 0; r < 16; ++r) S[k][r] = 0.f;
    float* oa = (float*)(ws + WS_OA);
    for (int c = 0; c < NCH; ++c) {
        const int ub = (b * NCH + c) * 4 + h;
        const bf16_t* qblk = (const bf16_t*)(ws + WS_QA) + (size_t)ub * 64 * 256;
        const bf16_t* kblk = (const bf16_t*)(ws + WS_KA) + (size_t)ub * 64 * 256;
        const bf16_t* vblk = (const bf16_t*)(ws + WS_VA) + (size_t)ub * 64 * 512 + (size_t)(256 * half) * 64;
        const bf16_t* ablk = (const bf16_t*)(ws + WS_ATTN) + (size_t)ub * 4096;
        __syncthreads();
#pragma unroll
        for (int i = 0; i < 4; ++i) { const int id = tid + NT * i;
            { const int t = id >> 5, c16 = id & 31; *(LAS u32x4*)(qs + t * 264 + 8 * c16) = *(const u32x4*)(qblk + t * 256 + 8 * c16); }
            { const int r = id >> 3, c16 = id & 7; *(LAS u32x4*)(kts + r * 72 + 8 * c16) = *(const u32x4*)(kblk + r * 64 + 8 * c16);
              *(LAS u32x4*)(vts + r * 72 + 8 * c16) = *(const u32x4*)(vblk + r * 64 + 8 * c16); } }
        { const int t = tid >> 3, c16 = tid & 7; *(LAS u32x4*)(as_ + t * 72 + 8 * c16) = *(const u32x4*)(ablk + t * 64 + 8 * c16); }
        if (tid < 256) gd[tid] = ((const float*)(ws + WS_GDEC))[(size_t)ub * 256 + tid];
        __syncthreads();
        bf16x8 bv[4];
#pragma unroll
        for (int s = 0; s < 4; ++s) bv[s] = *(const LAS bf16x8*)(vts + (32 * wave + r32) * 72 + 16 * s + 8 * hi);
        f32x16 o[2];
#pragma unroll
        for (int tt = 0; tt < 2; ++tt) {
#pragma unroll
            for (int r = 0; r < 16; ++r) o[tt][r] = 0.f;
#pragma unroll
            for (int s = 0; s < 4; ++s) { const bf16x8 af = *(const LAS bf16x8*)(as_ + (32 * tt + r32) * 72 + 16 * s + 8 * hi); o[tt] = MFMA32(af, bv[s], o[tt]); }
        }
#pragma unroll
        for (int k = 0; k < 8; ++k)
#pragma unroll
            for (int s = 0; s < 2; ++s) {
                u32x4 sw; sw.x = pg8::cvt_pk_bf16(S[k][8 * s + 0], S[k][8 * s + 1]); sw.y = pg8::cvt_pk_bf16(S[k][8 * s + 2], S[k][8 * s + 3]);
                sw.z = pg8::cvt_pk_bf16(S[k][8 * s + 4], S[k][8 * s + 5]); sw.w = pg8::cvt_pk_bf16(S[k][8 * s + 6], S[k][8 * s + 7]);
                const bf16x8 bs = __builtin_bit_cast(bf16x8, sw);
#pragma unroll
                for (int tt = 0; tt < 2; ++tt) { const LAS bf16_t* qp = qs + (32 * tt + r32) * 264 + 32 * k + 16 * s + 4 * hi;
                    const u32x2 lo = *(const LAS u32x2*)qp, hi2 = *(const LAS u32x2*)(qp + 8);
                    const bf16x8 af = __builtin_bit_cast(bf16x8, (u32x4){lo.x, lo.y, hi2.x, hi2.y});
                    o[tt] = MFMA32(af, bs, o[tt]); }
            }
#pragma unroll
        for (int tt = 0; tt < 2; ++tt)
#pragma unroll
            for (int r = 0; r < 16; ++r) oa[(size_t)(b * SEQ + c * 64 + 32 * tt + crow(r, hi)) * DM + h * GDV + 256 * half + 32 * wave + r32] = o[tt][r];
#pragma unroll
        for (int k = 0; k < 8; ++k) {
#pragma unroll
            for (int s = 0; s < 4; ++s) { const bf16x8 af = *(const LAS bf16x8*)(kts + (32 * k + r32) * 72 + 16 * s + 8 * hi); S[k] = MFMA32(af, bv[s], S[k]); }
#pragma unroll
            for (int g = 0; g < 4; ++g) { const f32x4 dv = *(const LAS f32x4*)(gd + 32 * k + 8 * g + 4 * hi);
#pragma unroll
                for (int j = 0; j < 4; ++j) S[k][4 * g + j] *= dv[j]; }
        }
    }
    __syncthreads();
}

__device__ __forceinline__ unsigned fkey(float f) { const unsigned u = __float_as_uint(f); return (u & 0x80000000u) ? ~u : (u | 0x80000000u); }
__device__ __forceinline__ void idx_topk_unit(const Ctx& X, int unit) {
    unsigned char* ws = X.ws; const int lane = X.lane, wave = X.wave;
    const int b = unit >> 7, qb = unit & 127, q0 = 16 * qb;
    LAS float* sc = (LAS float*)X.lds;
    const bf16_t* IQ = (const bf16_t*)(ws + WS_IQ); const bf16_t* IK = (const bf16_t*)(ws + WS_IK); const float* IW = (const float*)(ws + WS_IW);
    const int l15 = lane & 15, l4 = lane >> 4;
    {
        bf16x8 bq[8][2]; float wq[8];
        const size_t mq = (size_t)(b * SEQ + q0 + l15);
#pragma unroll
        for (int hh = 0; hh < 8; ++hh) { wq[hh] = IW[mq * 8 + hh];
#pragma unroll
            for (int s = 0; s < 2; ++s) bq[hh][s] = *(const bf16x8*)(IQ + mq * 512 + hh * 64 + 32 * s + 8 * l4); }
        const int ntile = qb + 1;
        for (int tile = wave; tile < ntile; tile += NW) {
            const int key0 = 16 * tile; const size_t mk = (size_t)(b * SEQ + key0 + l15);
            const bf16x8 a0 = *(const bf16x8*)(IK + mk * 64 + 8 * l4), a1 = *(const bf16x8*)(IK + mk * 64 + 32 + 8 * l4);
            f32x4 s4 = (f32x4){0.f, 0.f, 0.f, 0.f};
#pragma unroll
            for (int hh = 0; hh < 8; ++hh) { f32x4 acc = (f32x4){0.f, 0.f, 0.f, 0.f}; acc = MFMA16(a0, bq[hh][0], acc); acc = MFMA16(a1, bq[hh][1], acc);
#pragma unroll
                for (int r = 0; r < 4; ++r) s4[r] += wq[hh] * fmaxf(acc[r], 0.f); }
            *(LAS f32x4*)(sc + l15 * 2048 + key0 + 4 * l4) = s4;
        }
    }
    __syncthreads();
    unsigned long long* mask = (unsigned long long*)(ws + WS_MASK);
    for (int qi = 0; qi < 2; ++qi) {
        const int q = 2 * wave + qi, t = q0 + q, n = t + 1;
        unsigned long long myw = 0ull;
        if (n <= TOPK) {
            const int lo = 64 * lane;
            if (lo + 63 <= t) myw = ~0ull; else if (lo <= t) myw = (~0ull) >> (63 - (t - lo));
        } else {
            unsigned u[32];
#pragma unroll
            for (int r = 0; r < 32; ++r) { const int key = 64 * r + lane; u[r] = (key <= t) ? fkey(sc[q * 2048 + (key <= t ? key : 0)]) : 0u; }
            unsigned T = 0u;
            for (int bit = 31; bit >= 0; --bit) { const unsigned cand = T | (1u << bit); int cnt = 0;
#pragma unroll
                for (int r = 0; r < 32; ++r) cnt += __popcll(__ballot(u[r] >= cand));
                if (cnt >= TOPK) T = cand; }
            int ngt = 0;
#pragma unroll
            for (int r = 0; r < 32; ++r) ngt += __popcll(__ballot(u[r] > T));
            int need = TOPK - ngt;
#pragma unroll
            for (int r = 0; r < 32; ++r) { unsigned long long w = __ballot(u[r] > T); unsigned long long me = __ballot(u[r] == T);
                if (need > 0 && me != 0ull) { const int c = __popcll(me);
                    if (c <= need) { w |= me; need -= c; }
                    else { while (need > 0) { const unsigned long long lowb = me & (0ull - me); w |= lowb; me ^= lowb; --need; } } }
                if (lane == r) myw = w; }
        }
        if (lane < 32) mask[(size_t)(b * SEQ + t) * 32 + lane] = myw;
    }
    __syncthreads();
}

__device__ __forceinline__ void dsa_attn_unit(const Ctx& X, int b, int head, int qb) {
    unsigned char* ws = X.ws; const int tid = X.tid, lane = X.lane, wave = X.wave, r32 = lane & 31, hi = lane >> 5;
    LAS bf16_t* Kb = (LAS bf16_t*)X.lds;
    LAS bf16_t* Vb = (LAS bf16_t*)(X.lds + 34816);
    const bf16_t* DQ = (const bf16_t*)(ws + WS_DQ); const bf16_t* DK = (const bf16_t*)(ws + WS_DK); const bf16_t* DV = (const bf16_t*)(ws + WS_DV);
    const unsigned* mask = (const unsigned*)(ws + WS_MASK);
    const int qrow = b * SEQ + 256 * qb + 32 * wave + r32;
    const int NTL = 4 * qb + 4;
    const int myNT = 4 * qb + ((32 * wave + 31) >> 6) + 1;
    bf16x8 qf[8];
#pragma unroll
    for (int s = 0; s < 8; ++s) qf[s] = *(const bf16x8*)(DQ + (size_t)qrow * DM + head * DHD + 16 * s + 8 * hi);
    f32x16 ot[4];
#pragma unroll
    for (int d = 0; d < 4; ++d)
#pragma unroll
        for (int r = 0; r < 16; ++r) ot[d][r] = 0.f;
    float m_run = -1e30f, l_run = 0.f;
    const float C2 = 0.08838834764831845f * 1.4426950408889634f;
    u32x4 kreg0, kreg1, vreg0, vreg1;
#define ATT_ISSUE(kt_) do { \
        { const int id = tid, key = id >> 4, c16 = id & 15; kreg0 = *(const u32x4*)(DK + (size_t)(b * SEQ + 64 * (kt_) + key) * DM + head * DHD + 8 * c16); } \
        { const int id = tid + NT, key = id >> 4, c16 = id & 15; kreg1 = *(const u32x4*)(DK + (size_t)(b * SEQ + 64 * (kt_) + key) * DM + head * DHD + 8 * c16); } \
        { const int id = tid, dv = id >> 3, c16 = id & 7; vreg0 = *(const u32x4*)(DV + ((size_t)((b * NCH + (kt_)) * DH + head) * 128 + dv) * 64 + 8 * c16); } \
        { const int id = tid + NT, dv = id >> 3, c16 = id & 7; vreg1 = *(const u32x4*)(DV + ((size_t)((b * NCH + (kt_)) * DH + head) * 128 + dv) * 64 + 8 * c16); } } while (0)
#define ATT_COMMIT(buf_) do { \
        { const int id = tid, key = id >> 4, c16 = id & 15; *(LAS u32x4*)(Kb + (buf_) * 8704 + key * 136 + 8 * c16) = kreg0; } \
        { const int id = tid + NT, key = id >> 4, c16 = id & 15; *(LAS u32x4*)(Kb + (buf_) * 8704 + key * 136 + 8 * c16) = kreg1; } \
        { const int id = tid, dv = id >> 3, c16 = id & 7; *(LAS u32x4*)(Vb + (buf_) * 9216 + dv * 72 + 8 * c16) = vreg0; } \
        { const int id = tid + NT, dv = id >> 3, c16 = id & 7; *(LAS u32x4*)(Vb + (buf_) * 9216 + dv * 72 + 8 * c16) = vreg1; } } while (0)
    __syncthreads();
    ATT_ISSUE(0); ATT_COMMIT(0);
    __syncthreads();
    for (int kt = 0; kt < NTL; ++kt) {
        const int buf = kt & 1;
        if (kt + 1 < NTL) ATT_ISSUE(kt + 1);
        if (kt < myNT) {
            const u32x2 mw = *(const u32x2*)(mask + (size_t)qrow * 64 + 2 * kt);
            f32x16 p0, p1;
#pragma unroll
            for (int r = 0; r < 16; ++r) { p0[r] = 0.f; p1[r] = 0.f; }
            const LAS bf16_t* kb = Kb + buf * 8704;
#pragma unroll
            for (int s = 0; s < 8; ++s) { const bf16x8 a0 = *(const LAS bf16x8*)(kb + r32 * 136 + 16 * s + 8 * hi), a1 = *(const LAS bf16x8*)(kb + (32 + r32) * 136 + 16 * s + 8 * hi);
                p0 = MFMA32(a0, qf[s], p0); p1 = MFMA32(a1, qf[s], p1); }
            const unsigned lo = mw.x >> (4 * hi), hi_w = mw.y >> (4 * hi);
            float mx = -INFINITY;
#pragma unroll
            for (int r = 0; r < 16; ++r) { const int cb = (r & 3) + 8 * (r >> 2);
                p0[r] = ((lo >> cb) & 1u) ? p0[r] : -INFINITY; p1[r] = ((hi_w >> cb) & 1u) ? p1[r] : -INFINITY; mx = fmaxf(mx, fmaxf(p0[r], p1[r])); }
            mx = fmaxf(mx, __shfl_xor(mx, 32));
            const float m_new = fmaxf(m_run, mx);
            const float alpha = exp2f((m_run - m_new) * C2);
            const float mc = m_new * C2;
            float ls = 0.f;
#pragma unroll
            for (int r = 0; r < 16; ++r) { p0[r] = exp2f(fmaf(p0[r], C2, -mc)); p1[r] = exp2f(fmaf(p1[r], C2, -mc)); ls += p0[r] + p1[r]; }
            l_run = l_run * alpha + ls; m_run = m_new;
#pragma unroll
            for (int d = 0; d < 4; ++d)
#pragma unroll
                for (int r = 0; r < 16; ++r) ot[d][r] *= alpha;
            bf16x8 pb[4];
#pragma unroll
            for (int s = 0; s < 4; ++s) { u32x4 w;
                if (s < 2) { w.x = pg8::cvt_pk_bf16(p0[8 * s + 0], p0[8 * s + 1]); w.y = pg8::cvt_pk_bf16(p0[8 * s + 2], p0[8 * s + 3]); w.z = pg8::cvt_pk_bf16(p0[8 * s + 4], p0[8 * s + 5]); w.w = pg8::cvt_pk_bf16(p0[8 * s + 6], p0[8 * s + 7]); }
                else { const int s2 = s - 2; w.x = pg8::cvt_pk_bf16(p1[8 * s2 + 0], p1[8 * s2 + 1]); w.y = pg8::cvt_pk_bf16(p1[8 * s2 + 2], p1[8 * s2 + 3]); w.z = pg8::cvt_pk_bf16(p1[8 * s2 + 4], p1[8 * s2 + 5]); w.w = pg8::cvt_pk_bf16(p1[8 * s2 + 6], p1[8 * s2 + 7]); }
                pb[s] = __builtin_bit_cast(bf16x8, w); }
            const LAS bf16_t* vb = Vb + buf * 9216;
#pragma unroll
            for (int d = 0; d < 4; ++d)
#pragma unroll
                for (int s = 0; s < 4; ++s) { const LAS bf16_t* vp = vb + (32 * d + r32) * 72 + 16 * s + 4 * hi;
                    const u32x2 v0 = *(const LAS u32x2*)vp, v1 = *(const LAS u32x2*)(vp + 8);
                    const bf16x8 af = __builtin_bit_cast(bf16x8, (u32x4){v0.x, v0.y, v1.x, v1.y});
                    ot[d] = MFMA32(af, pb[s], ot[d]); }
        }
        if (kt + 1 < NTL) ATT_COMMIT(buf ^ 1);
        __syncthreads();
    }
    const float lt = l_run + __shfl_xor(l_run, 32);
    const float inv = 1.f / lt;
    bf16_t* ob = (bf16_t*)(ws + WS_OB) + (size_t)qrow * DM + head * DHD;
#pragma unroll
    for (int d = 0; d < 4; ++d)
#pragma unroll
        for (int g = 0; g < 4; ++g) { u32x2 w; w.x = pg8::cvt_pk_bf16(ot[d][4 * g] * inv, ot[d][4 * g + 1] * inv); w.y = pg8::cvt_pk_bf16(ot[d][4 * g + 2] * inv, ot[d][4 * g + 3] * inv);
            *(u32x2*)(ob + 32 * d + 8 * g + 4 * hi) = w; }
}

__device__ __forceinline__ void oa_norm_rows(const Ctx& X, const float* gng) {
    const int gw = X.bid * NW + X.wave, NGW = X.G * NW, lane = X.lane;
    const float* oa = (const float*)(X.ws + WS_OA); const bf16_t* ra = (const bf16_t*)(X.ws + WS_RA); bf16_t* oan = (bf16_t*)(X.ws + WS_H);
    for (int row = gw; row < MTOK; row += NGW) {
#pragma unroll
        for (int hh = 0; hh < GH; ++hh) {
            const size_t off = (size_t)row * DM + hh * GDV + 4 * lane;
            const f32x4 v0 = *(const f32x4*)(oa + off), v1 = *(const f32x4*)(oa + off + 256);
            float s = (v0[0] * v0[0] + v0[1] * v0[1]) + (v0[2] * v0[2] + v0[3] * v0[3]) + (v1[0] * v1[0] + v1[1] * v1[1]) + (v1[2] * v1[2] + v1[3] * v1[3]);
            const float rs = rsqrtf(wave_sum(s) * (1.f / GDV) + RMS_EPS);
            const f32x4 g0 = *(const f32x4*)(gng + hh * GDV + 4 * lane), g1 = *(const f32x4*)(gng + hh * GDV + 4 * lane + 256);
            const f32x4 r0 = pg8::bf4_to_f32(*(const u32x2*)(ra + off)), r1 = pg8::bf4_to_f32(*(const u32x2*)(ra + off + 256));
            const f32x4 y0 = v0 * rs * g0 * r0, y1 = v1 * rs * g1 * r1;
            *(u32x2*)(oan + off) = (u32x2){pk2(y0[0], y0[1]), pk2(y0[2], y0[3])}; *(u32x2*)(oan + off + 256) = (u32x2){pk2(y1[0], y1[1]), pk2(y1[2], y1[3])};
        }
    }
}

constexpr int NPHASE = 13;
__global__ void __launch_bounds__(NT, 2) fwd_kernel(Args args) {
    extern __shared__ __attribute__((aligned(16))) unsigned char lds_raw[];
    cg::grid_group grid = cg::this_grid();
    Ctx X;
    X.lds = (LAS unsigned char*)lds_raw; X.ws = args.ws;
    X.tid = threadIdx.x; X.lane = X.tid & 63; X.wave = __builtin_amdgcn_readfirstlane(X.tid >> 6);
    X.bid = blockIdx.x; X.G = gridDim.x;
    unsigned char* ws = args.ws;
    const int lo = args.ph_lo, hi = args.ph_hi;
    float* mod = (float*)(ws + WS_MOD);
#ifndef PH_ONLY
#define PH_ONLY -1
#endif
#define IN(k) ((PH_ONLY < 0 || PH_ONLY == (k)) && lo <= (k) && (k) < hi)
#define SEAM(k) do { if (IN(k) && IN((k) + 1)) grid.sync(); } while (0)

    if (IN(0)) p0_prologue(X, args);
    SEAM(0);
    if (IN(1)) norm_mod_rows(X, args.in[I_X], args.in[I_N1G], mod, 0, 1, (bf16_t*)(ws + WS_H));
    SEAM(1);
    if (IN(2)) {
        pg8::Gemm g{(const bf16_t*)(ws + WS_H), (const bf16_t*)(ws + WS_WIN), MTOK, INWP, DM}; pg8::StaticOrder S; S.init(MTOK, INWP, X.G, X.bid);
        pg8::EpiInProj E{ws};
        pg8::gemm_phase<pg8::EpiInProj, pg8::StaticOrder, true, true>(X.lds, g, S, E);
    }
    SEAM(2);
    if (IN(3)) {
        for (int u = X.bid; u < BATCH * NCH * GH; u += X.G) gla_prep_unit(X, args, u);
        dv_transpose(X);
        idx_prep(X);
    }
    SEAM(3);
    if (IN(4)) {
        if (X.G >= 64) {
            if (X.bid < 32) gla_scan_unit(X, X.bid);
            else for (int u = X.bid - 32; u < BATCH * 128; u += X.G - 32) idx_topk_unit(X, (BATCH * 128 - 1) - u);
        } else {
            for (int u = X.bid; u < 32; u += X.G) gla_scan_unit(X, u);
            for (int u = X.bid; u < BATCH * 128; u += X.G) idx_topk_unit(X, u);
        }
    }
    SEAM(4);
    if (IN(5)) {
        const int NU = BATCH * DH * 8;
        for (int i = 0; i * X.G < NU; ++i) {
            const int v = i * X.G + ((i & 1) ? (X.G - 1 - X.bid) : X.bid);
            if (v < NU) { const int qb = 7 - (v >> 6), bh = v & 63; dsa_attn_unit(X, bh >> 4, bh & 15, qb); }
        }
        oa_norm_rows(X, args.in[I_GNG]);
    }
    SEAM(5);
    if (IN(6)) {
        pg8::Gemm g{(const bf16_t*)(ws + WS_H), (const bf16_t*)(ws + WS_WBGA), MTOK, DM, DM}; pg8::StaticOrder S; S.init(MTOK, DM, X.G, X.bid);
        pg8::EpiScaleF32 E{(float*)(ws + WS_TMP), (const bf16_t*)(ws + WS_SGA)};
        pg8::gemm_phase<pg8::EpiScaleF32, pg8::StaticOrder, true, true>(X.lds, g, S, E);
    }
    SEAM(6);
    if (IN(7)) {
        pg8::Gemm g{(const bf16_t*)(ws + WS_OB), (const bf16_t*)(ws + WS_WBDSA), MTOK, DM, DM}; pg8::StaticOrder S; S.init(MTOK, DM, X.G, X.bid);
        pg8::EpiMerge E{(bf16_t*)(ws + WS_MERGED), (const float*)(ws + WS_TMP), (const bf16_t*)(ws + WS_SGB)};
        pg8::gemm_phase<pg8::EpiMerge, pg8::StaticOrder, true, true>(X.lds, g, S, E);
    }
    SEAM(7);
    if (IN(8)) {
        pg8::Gemm g{(const bf16_t*)(ws + WS_MERGED), (const bf16_t*)(ws + WS_WMO), MTOK, DM, DM}; pg8::StaticOrder S; S.init(MTOK, DM, X.G, X.bid);
        pg8::EpiResid E{args.in[I_X], (float*)(ws + WS_X1), mod + 2 * DM};
        pg8::gemm_phase<pg8::EpiResid, pg8::StaticOrder, true, true>(X.lds, g, S, E);
    }
    SEAM(8);
    if (IN(9)) norm_mod_rows(X, (const float*)(ws + WS_X1), args.in[I_N2G], mod, 3, 4, (bf16_t*)(ws + WS_H));
    SEAM(9);
    if (IN(10)) {
        pg8::Gemm g{(const bf16_t*)(ws + WS_H), (const bf16_t*)(ws + WS_WGU), MTOK, 2 * DFF, DM}; pg8::StaticOrder S; S.init(MTOK, 2 * DFF, X.G, X.bid);
        pg8::EpiSwiglu E{(bf16_t*)(ws + WS_ACT)};
        pg8::gemm_phase<pg8::EpiSwiglu, pg8::StaticOrder, true, true>(X.lds, g, S, E);
    }
    SEAM(10);
    if (IN(11)) {
        pg8::Gemm g{(const bf16_t*)(ws + WS_ACT), (const bf16_t*)(ws + WS_WDN), MTOK, DM, DFF}; pg8::StaticOrder S; S.init(MTOK, DM, X.G, X.bid);
        pg8::EpiResid E{(const float*)(ws + WS_X1), args.out, mod + 5 * DM};
        pg8::gemm_phase<pg8::EpiResid, pg8::StaticOrder, true, true>(X.lds, g, S, E);
    }
    SEAM(11);
    if (IN(12)) final_norm_rows(X, args.out, args.in[I_FNG]);
#undef IN
#undef SEAM
}


extern "C" void kernel_launch(void* const* d_in, const int* in_sizes, int n_in, void* d_out, int out_size, void* d_ws, size_t ws_size, hipStream_t stream) {
    static int grid = 0;
    if (grid == 0) {
        if (n_in != 17 || out_size != MTOK * DM || ws_size < WS_END) { fprintf(stderr, "kernel_launch: unexpected shapes (n_in %d out %d ws %zu need %zu)\n", n_in, out_size, ws_size, (size_t)WS_END); grid = -1; return; }
        int dev = 0, cus = 0, per_cu = 0;
        if (hipGetDevice(&dev) != hipSuccess || hipDeviceGetAttribute(&cus, hipDeviceAttributeMultiprocessorCount, dev) != hipSuccess) { grid = -1; return; }
        if (hipFuncSetAttribute((const void*)fwd_kernel, hipFuncAttributeMaxDynamicSharedMemorySize, LDS_BYTES) != hipSuccess) { grid = -1; return; }
        if (hipOccupancyMaxActiveBlocksPerMultiprocessor(&per_cu, (const void*)fwd_kernel, NT, LDS_BYTES) != hipSuccess || per_cu < 1) { fprintf(stderr, "kernel_launch: occupancy query says %d\n", per_cu); }
        (void)hipGetLastError();
        grid = cus;
    }
    if (grid < 0) return;
    (void)hipMemsetAsync((char*)d_ws + WS_CTL, 0, CTL_BYTES, stream);
    Args a{};
    for (int i = 0; i < 17; ++i) a.in[i] = (const float*)d_in[i];
    a.out = (float*)d_out; a.ws = (unsigned char*)d_ws; a.ph_lo = 0; a.ph_hi = (PH_STOP < NPHASE) ? PH_STOP : NPHASE;
    void* kargs[] = {&a};
    hipError_t e = hipLaunchCooperativeKernel((const void*)fwd_kernel, dim3(grid), dim3(NT), kargs, LDS_BYTES, stream);
    if (e != hipSuccess) fprintf(stderr, "kernel_launch: cooperative launch failed: %s (grid %d)\n", hipGetErrorString(e), grid);
#if DBG
    dbg_run(a, stream);
#endif
}
```

```cpp
#include <hip/hip_runtime.h>
#include <hip/hip_cooperative_groups.h>
#include <cstdio>
#include <cstdint>
namespace cg = cooperative_groups;

#ifndef DBG
#define DBG 0
#endif
#ifndef PH_STOP
#define PH_STOP 99
#endif

constexpr int BATCH = 4, SEQ = 2048, DM = 2048, MTOK = BATCH * SEQ;
constexpr int INW = 16984, INWP = 17152, DFF = 5632, NMOD = 6 * DM;
constexpr int GH = 4, GDK = 256, GDV = 512, GRANK = 16, NCH = SEQ / 64;
constexpr int DH = 16, DHD = 128, IH = 8, ID = 64, TOPK = 256;
constexpr int SMALLW = 768;
constexpr float RMS_EPS = 1e-6f;
constexpr int SRC_GQ = 0, SRC_GK = 1024, SRC_GV = 2048, SRC_GR = 4096, SRC_GLR = 6144, SRC_DQ = 6160, SRC_DK = 8208, SRC_DV = 10256,
              SRC_IQ = 12304, SRC_IK = 12816, SRC_IW = 12880, SRC_GA = 12888, SRC_GB = 14936;
enum { I_X = 0, I_C, I_POS, I_N1G, I_N2G, I_WADA, I_BADA, I_WIN, I_GUP, I_GBIAS, I_GNG, I_WBGA, I_WBDSA, I_WMO, I_WGU, I_WDN, I_FNG };

constexpr size_t MiB = 1u << 20;
constexpr size_t WS_CTL = 0, CTL_BYTES = 1 * MiB;
constexpr size_t WS_MOD = 65536;
constexpr size_t WS_DBG = 512 * 1024;
constexpr size_t WS_ROPED = 1 * MiB;
constexpr size_t WS_ROPEI = 2 * MiB;
constexpr size_t WS_IW = 2 * MiB + 512 * 1024;
constexpr size_t WS_GDEC = 3 * MiB;
constexpr size_t WS_MASK = 4 * MiB;
constexpr size_t WS_IK = 6 * MiB;
constexpr size_t WS_IQ = 7 * MiB;
constexpr size_t WS_ATTN = 15 * MiB;
constexpr size_t WS_WBGA = 20 * MiB, WS_WBDSA = 28 * MiB, WS_WMO = 36 * MiB, WS_WGU = 44 * MiB, WS_WDN = 88 * MiB;
constexpr size_t WS_WIN = 110 * MiB;
constexpr size_t WS_OA = 110 * MiB;
constexpr size_t WS_H = 177 * MiB;
constexpr size_t WS_QA = 209 * MiB, WS_KA = 225 * MiB;
constexpr size_t WS_VA = 241 * MiB;
constexpr size_t WS_RA = 273 * MiB;
constexpr size_t WS_DQ = 305 * MiB, WS_DK = 337 * MiB;
constexpr size_t WS_DV = 369 * MiB;
constexpr size_t WS_SGA = 401 * MiB, WS_SGB = 433 * MiB;
constexpr size_t WS_SMALL = 465 * MiB;
constexpr size_t WS_KTA = 489 * MiB;
constexpr size_t WS_MODP = 505 * MiB;
constexpr size_t WS_END = 508 * MiB;
constexpr size_t WS_OB = WS_QA;
constexpr size_t WS_TMP = WS_VA;
constexpr size_t WS_MERGED = WS_DQ;
constexpr size_t WS_X1 = WS_DK;
constexpr size_t WS_ACT = WS_QA;

#define LAS __attribute__((address_space(3)))
typedef unsigned short bf16_t;
typedef short bf16x8 __attribute__((ext_vector_type(8)));
typedef short bf16x4 __attribute__((ext_vector_type(4)));
typedef float f32x4 __attribute__((ext_vector_type(4)));
typedef float f32x16 __attribute__((ext_vector_type(16)));
typedef unsigned u32x4 __attribute__((ext_vector_type(4)));
typedef unsigned u32x2 __attribute__((ext_vector_type(2)));
constexpr int NT = 512, NW = 8;
constexpr int RING_BYTES = 131072;
constexpr int LDS_BYTES = 147456;

__device__ __forceinline__ float bf2f(unsigned v) { return __uint_as_float(v << 16); }
__device__ __forceinline__ unsigned f2bf(float f) { unsigned u = __float_as_uint(f); return (u + 0x7fffu + ((u >> 16) & 1u)) >> 16; }
__device__ __forceinline__ unsigned pk2(float lo, float hi) { return f2bf(lo) | (f2bf(hi) << 16); }
__device__ __forceinline__ float wave_sum(float v) {
#pragma unroll
    for (int o = 1; o < 64; o <<= 1) v += __shfl_xor(v, o);
    return v;
}
__device__ __forceinline__ float siluf(float v) { return v / (1.f + __expf(-v)); }
__device__ __forceinline__ float sigmf(float v) { return 1.f / (1.f + __expf(-v)); }
__device__ __forceinline__ int crow(int r, int hi) { return (r & 3) + 8 * (r >> 2) + 4 * hi; }

namespace pg8 {
#define PG8_LAS __attribute__((address_space(3)))
typedef unsigned short bf16_t;
typedef short bf16x8 __attribute__((ext_vector_type(8)));
typedef float f32x4 __attribute__((ext_vector_type(4)));
typedef unsigned u32x4 __attribute__((ext_vector_type(4)));
constexpr int BM = 256, BK = 64, HALF = 128, HTB = HALF * BK * 2  , STAGE_BYTES = 8 * HTB, NXCD = 8, WGM = 8;

__host__ __device__ __forceinline__ int lds_byte(int r, int c) { const int st = (r >> 4) * 2 + (c >> 5), rr = r & 15, cc = c & 31, ob = rr * 64 + cc * 2; return st * 1024 + (ob ^ (((ob >> 9) & 1) << 5)); }
__host__ __device__ __forceinline__ void stage_rc(int b, int& R, int& C) { const int st = b / 1024, sb = b % 1024, swz = sb ^ (((sb >> 9) & 1) << 5); R = (st >> 1) * 16 + swz / 64; C = (st & 1) * 32 + (swz % 64) / 2; }
__host__ __device__ __forceinline__ int perm32(int rho) { const int n = rho >> 4, i = rho & 15; return 8 * (i >> 2) + 4 * n + (i & 3); }

struct Unit { int pm, pn; };
struct Gemm { const bf16_t* A; const bf16_t* Bt; int M, N, K; };

struct StaticOrder {
    int nM, nN, nwg, G, c;
    __host__ __device__ void init(int M, int N, int G_, int c_) { nM = M / BM; nN = N / BM; nwg = nM * nN; G = G_; c = c_; }
    __host__ __device__ bool next(int i, Unit& u) const {
        const long L = (long)i * G + c; if (L >= nwg) return false;
        int wgid = (int)L; { const int q = nwg / NXCD, r = nwg % NXCD, xcd = wgid % NXCD, off = wgid / NXCD; wgid = (xcd < r ? xcd * (q + 1) : r * (q + 1) + (xcd - r) * q) + off; }
        const int nig = WGM * nN, gid = wgid / nig, fm = gid * WGM, gsz = (nM - fm) < WGM ? (nM - fm) : WGM;
        u.pm = fm + ((wgid % nig) % gsz); u.pn = (wgid % nig) / gsz; return true;
    }
    __device__ __forceinline__ void a_ready(const Unit&) const {}
    __device__ __forceinline__ void done(const Unit&) const {}
};


__device__ __forceinline__ unsigned cvt_pk_bf16(float lo, float hi) { unsigned r; asm volatile("v_cvt_pk_bf16_f32 %0, %1, %2" : "=v"(r) : "v"(lo), "v"(hi)); return r; }
__device__ __forceinline__ void store8bf(bf16_t* p, f32x4 v0, f32x4 v1) {
    u32x4 w; w.x = cvt_pk_bf16(v0[0], v0[1]); w.y = cvt_pk_bf16(v0[2], v0[3]); w.z = cvt_pk_bf16(v1[0], v1[1]); w.w = cvt_pk_bf16(v1[2], v1[3]); *(u32x4*)p = w;
}
__device__ __forceinline__ f32x4 silu4(f32x4 v) { f32x4 o; o[0] = v[0] / (1.f + __expf(-v[0])); o[1] = v[1] / (1.f + __expf(-v[1])); o[2] = v[2] / (1.f + __expf(-v[2])); o[3] = v[3] / (1.f + __expf(-v[3])); return o; }
__device__ __forceinline__ f32x4 sigm4(f32x4 v) { f32x4 o; o[0] = 1.f / (1.f + __expf(-v[0])); o[1] = 1.f / (1.f + __expf(-v[1])); o[2] = 1.f / (1.f + __expf(-v[2])); o[3] = 1.f / (1.f + __expf(-v[3])); return o; }
__device__ __forceinline__ f32x4 bf4_to_f32(u32x2 w) { f32x4 o; o[0] = __uint_as_float(w.x << 16); o[1] = __uint_as_float(w.x & 0xffff0000u); o[2] = __uint_as_float(w.y << 16); o[3] = __uint_as_float(w.y & 0xffff0000u); return o; }

struct EpiInProj {
    static constexpr bool PERM = true, AFTER_DRAIN = false;
    unsigned char* ws;
    __device__ __forceinline__ void operator()(const f32x4 (&acc)[2][2][4][2], const Unit& u, int wr, int wc, int fr, int fq) const {
        const int pn = u.pn, row0 = u.pm * BM + wr * 64 + fr, cl = wc * 32 + 8 * fq;
        if (pn >= 64) {
            float* base = (float*)(ws + WS_SMALL) + 256 * (pn - 64) + cl;
#pragma unroll
            for (int ai = 0; ai < 2; ++ai)
#pragma unroll
                for (int m = 0; m < 4; ++m) { const int r = row0 + ai * HALF + m * 16; float* rp = base + (size_t)r * SMALLW;
#pragma unroll
                    for (int bj = 0; bj < 2; ++bj) { *(f32x4*)(rp + bj * HALF) = acc[ai][bj][m][0]; *(f32x4*)(rp + bj * HALF + 4) = acc[ai][bj][m][1]; } asm volatile("" ::: "memory"); }
            return;
        }
        size_t wsoff; int A, B, C, E = HALF, op = 0;
        if (pn < 8) { wsoff = pn < 4 ? WS_QA : WS_KA; A = 4 * 64 * 256; B = 256; C = (pn & 3) * 64 * 256; }
        else if (pn < 16) { wsoff = WS_VA; A = 4 * 64 * 512; B = 512; C = ((pn - 8) >> 1) * 64 * 512 + 256 * ((pn - 8) & 1); }
        else if (pn < 24) { wsoff = WS_RA; A = 64 * DM; B = DM; C = 256 * (pn - 16); op = 1; }
        else if (pn < 40) { wsoff = pn < 32 ? WS_DQ : WS_DK; A = 64 * DM; B = DM; C = 256 * ((pn - 24) & 7); }
        else if (pn < 48) { wsoff = WS_DV; A = 16 * 64 * 128; B = 128; C = 2 * (pn - 40) * 64 * 128; E = 64 * 128; }
        else { wsoff = pn < 56 ? WS_SGA : WS_SGB; A = 64 * DM; B = DM; C = 256 * ((pn - 48) & 7); op = 2; }
        bf16_t* base = (bf16_t*)(ws + wsoff) + C + cl;
#pragma unroll
        for (int ai = 0; ai < 2; ++ai)
#pragma unroll
            for (int m = 0; m < 4; ++m) { const int r = row0 + ai * HALF + m * 16; bf16_t* rp = base + (size_t)(r >> 6) * A + (r & 63) * B;
#pragma unroll
                for (int bj = 0; bj < 2; ++bj) { f32x4 v0 = acc[ai][bj][m][0], v1 = acc[ai][bj][m][1];
                    if (op == 1) { v0 = silu4(v0); v1 = silu4(v1); }
                    else if (op == 2) { v0 = sigm4(v0); v1 = sigm4(v1); }
                    store8bf(rp + bj * E, v0, v1); }
                asm volatile("" ::: "memory"); }
    }
};

struct EpiScaleF32 {
    static constexpr bool PERM = false, AFTER_DRAIN = false;
    float* C; const bf16_t* G;
    __device__ __forceinline__ void operator()(const f32x4 (&acc)[2][2][4][2], const Unit& u, int wr, int wc, int fr, int fq) const {
        const int row0 = u.pm * BM + wr * 64 + fr, col0 = u.pn * BM + wc * 32 + 4 * fq;
#pragma unroll
        for (int ai = 0; ai < 2; ++ai)
#pragma unroll
            for (int m = 0; m < 4; ++m) { const size_t off = (size_t)(row0 + ai * HALF + m * 16) * DM + col0;
#pragma unroll
                for (int bj = 0; bj < 2; ++bj)
#pragma unroll
                    for (int n = 0; n < 2; ++n) { const f32x4 g = bf4_to_f32(*(const u32x2*)(G + off + bj * HALF + n * 16)); *(f32x4*)(C + off + bj * HALF + n * 16) = acc[ai][bj][m][n] * g; } }
    }
};
struct EpiMerge {
    static constexpr bool PERM = true, AFTER_DRAIN = false;
    bf16_t* O; const float* T; const bf16_t* G;
    __device__ __forceinline__ void operator()(const f32x4 (&acc)[2][2][4][2], const Unit& u, int wr, int wc, int fr, int fq) const {
        const int row0 = u.pm * BM + wr * 64 + fr, col0 = u.pn * BM + wc * 32 + 8 * fq;
#pragma unroll
        for (int ai = 0; ai < 2; ++ai)
#pragma unroll
            for (int m = 0; m < 4; ++m) { const size_t off = (size_t)(row0 + ai * HALF + m * 16) * DM + col0;
#pragma unroll
                for (int bj = 0; bj < 2; ++bj) { const u32x4 gw = *(const u32x4*)(G + off + bj * HALF);
                    const f32x4 g0 = bf4_to_f32((u32x2){gw.x, gw.y}), g1 = bf4_to_f32((u32x2){gw.z, gw.w});
                    const f32x4 t0 = *(const f32x4*)(T + off + bj * HALF), t1 = *(const f32x4*)(T + off + bj * HALF + 4);
                    store8bf(O + off + bj * HALF, t0 + acc[ai][bj][m][0] * g0, t1 + acc[ai][bj][m][1] * g1); } }
    }
};
struct EpiResid {
    static constexpr bool PERM = false, AFTER_DRAIN = false;
    const float* base; float* out; const float* gate;
    __device__ __forceinline__ void operator()(const f32x4 (&acc)[2][2][4][2], const Unit& u, int wr, int wc, int fr, int fq) const {
        const int row0 = u.pm * BM + wr * 64 + fr, col0 = u.pn * BM + wc * 32 + 4 * fq;
        const float* gb = gate + (size_t)((u.pm * BM) >> 11) * NMOD + col0;
        f32x4 gv[2][2];
#pragma unroll
        for (int bj = 0; bj < 2; ++bj)
#pragma unroll
            for (int n = 0; n < 2; ++n) gv[bj][n] = *(const f32x4*)(gb + bj * HALF + n * 16);
#pragma unroll
        for (int ai = 0; ai < 2; ++ai)
#pragma unroll
            for (int m = 0; m < 4; ++m) { const size_t off = (size_t)(row0 + ai * HALF + m * 16) * DM + col0;
#pragma unroll
                for (int bj = 0; bj < 2; ++bj)
#pragma unroll
                    for (int n = 0; n < 2; ++n) *(f32x4*)(out + off + bj * HALF + n * 16) = *(const f32x4*)(base + off + bj * HALF + n * 16) + gv[bj][n] * acc[ai][bj][m][n]; }
    }
};
struct EpiSwiglu {
    static constexpr bool PERM = true, AFTER_DRAIN = false;
    bf16_t* O;
    __device__ __forceinline__ void operator()(const f32x4 (&acc)[2][2][4][2], const Unit& u, int wr, int wc, int fr, int fq) const {
        const int row0 = u.pm * BM + wr * 64 + fr, col0 = u.pn * HALF + wc * 32 + 8 * fq;
#pragma unroll
        for (int ai = 0; ai < 2; ++ai)
#pragma unroll
            for (int m = 0; m < 4; ++m) { bf16_t* rp = O + (size_t)(row0 + ai * HALF + m * 16) * DFF + col0;
                store8bf(rp, silu4(acc[ai][0][m][0]) * acc[ai][1][m][0], silu4(acc[ai][0][m][1]) * acc[ai][1][m][1]); }
    }
};

template <class Epi, class Sched, bool ALIGN_EPI = false, bool SP2 = false>
__device__ __forceinline__ void gemm_phase(PG8_LAS unsigned char* lds, const Gemm g, const Sched& S, const Epi& E) {
    int tid_ = threadIdx.x; asm volatile("" : "+v"(tid_));
    const int tid = tid_, wid = __builtin_amdgcn_readfirstlane(tid >> 6), lane = tid & 63, wr = wid >> 2, wc = wid & 3, fr = lane & 15, fq = lane >> 4;
    const int K = g.K, nt = K / BK;
    unsigned voffA[2], voffB[2];
#pragma unroll
    for (int i = 0; i < 2; ++i) { int R, C; stage_rc(tid * 16 + i * 8192, R, C); const int Rb = Epi::PERM ? ((R & ~31) + perm32(R & 31)) : R;
        voffA[i] = (unsigned)(R * K + C) * 2u; voffB[i] = (unsigned)(Rb * K + C) * 2u; }
    const size_t kstep = (size_t)(BK * 2);
    const size_t hstep = (size_t)HALF * K * 2;
    const size_t tstep = 2 * hstep;
    const unsigned ldsw = (unsigned)wid * 1024u;
    const int aoff = lds_byte(wr * 64 + fr, fq * 8), boff = lds_byte(wc * 32 + fr, fq * 8);
#define PG8_SA(b, h) (((b) * 2 + (h)) * HTB)
#define PG8_SB(b, h) ((4 + (b) * 2 + (h)) * HTB)
#define PG8_STAGE(bufoff, gbase, voff) do { _Pragma("unroll") for (int _i = 0; _i < 2; ++_i) \
        __builtin_amdgcn_global_load_lds((const unsigned*)((const char*)(gbase) + (voff)[_i]), (PG8_LAS unsigned*)(lds + (bufoff) + ldsw + _i * 8192), 16, 0, 0); } while (0)
#define PG8_LDA(dst, b, h) do { _Pragma("unroll") for (int m = 0; m < 4; ++m) _Pragma("unroll") for (int k = 0; k < 2; ++k) dst[m][k] = *(const PG8_LAS bf16x8*)(lds + PG8_SA(b, h) + aoff + m * 2048 + k * 1024); } while (0)
#define PG8_LDB(dst, b, h) do { _Pragma("unroll") for (int n = 0; n < 2; ++n) _Pragma("unroll") for (int k = 0; k < 2; ++k) dst[n][k] = *(const PG8_LAS bf16x8*)(lds + PG8_SB(b, h) + boff + n * 2048 + k * 1024); } while (0)
#define PG8_MMA(ai, bj, At, Bt) do { __builtin_amdgcn_s_setprio(1); _Pragma("unroll") for (int m = 0; m < 4; ++m) _Pragma("unroll") for (int n = 0; n < 2; ++n) _Pragma("unroll") for (int k = 0; k < 2; ++k) \
        acc[ai][bj][m][n] = __builtin_amdgcn_mfma_f32_16x16x32_bf16(Bt[n][k], At[m][k], acc[ai][bj][m][n], 0, 0, 0); __builtin_amdgcn_s_setprio(0); } while (0)
#define PG8_WAIT_V(n) asm volatile("s_waitcnt vmcnt(" #n ")" ::: "memory")
#define PG8_WAIT_L(n) asm volatile("s_waitcnt lgkmcnt(" #n ")" ::: "memory")
#define PG8_BAR __builtin_amdgcn_s_barrier()
#define PG8_SCHED __builtin_amdgcn_sched_barrier(0)
    Unit cur, nxt; int ui = 0;
    if (!S.next(0, cur)) return;
    f32x4 acc[2][2][4][2];
#pragma unroll
    for (int a = 0; a < 2; ++a)
#pragma unroll
        for (int b = 0; b < 2; ++b)
#pragma unroll
            for (int m = 0; m < 4; ++m)
#pragma unroll
                for (int n = 0; n < 2; ++n) acc[a][b][m][n] = (f32x4){0.f, 0.f, 0.f, 0.f};
    bf16x8 At[4][2], B0[2][2], B1[2][2];
    const char* cA = (const char*)g.A + (size_t)cur.pm * tstep; const char* cB = (const char*)g.Bt + (size_t)cur.pn * tstep;
    S.a_ready(cur);
    if constexpr (SP2) {
        PG8_STAGE(PG8_SB(0, 0), cB, voffB); PG8_STAGE(PG8_SB(0, 1), cB + hstep, voffB); PG8_STAGE(PG8_SA(0, 0), cA, voffA); PG8_STAGE(PG8_SA(0, 1), cA + hstep, voffA);
        if (wr == 1) PG8_BAR;
        PG8_WAIT_V(2); PG8_BAR;
        PG8_STAGE(PG8_SB(1, 0), cB + kstep, voffB); PG8_STAGE(PG8_SA(1, 0), cA + kstep, voffA); PG8_STAGE(PG8_SB(1, 1), cB + hstep + kstep, voffB);
        PG8_WAIT_V(6); PG8_BAR;
    } else {
        PG8_STAGE(PG8_SB(0, 0), cB, voffB); PG8_STAGE(PG8_SA(0, 0), cA, voffA); PG8_STAGE(PG8_SB(0, 1), cB + hstep, voffB); PG8_STAGE(PG8_SA(0, 1), cA + hstep, voffA);
        if (wr == 1) PG8_BAR;
        PG8_WAIT_V(4); PG8_BAR;
        PG8_STAGE(PG8_SB(1, 0), cB + kstep, voffB); PG8_STAGE(PG8_SA(1, 0), cA + kstep, voffA); PG8_STAGE(PG8_SB(1, 1), cB + hstep + kstep, voffB);
        PG8_WAIT_V(6); PG8_BAR;
    }
    for (;;) {
        const bool has_next = S.next(ui + 1, nxt);
        const char* nA = has_next ? (const char*)g.A + (size_t)nxt.pm * tstep : cA; const char* nB = has_next ? (const char*)g.Bt + (size_t)nxt.pn * tstep : cB;
        for (int t = 0; t < nt; t += 2) {
            const bool last = (t == nt - 2);
            const char* a1 = cA + (size_t)(t + 1) * kstep;
            const char* a2 = last ? nA : cA + (size_t)(t + 2) * kstep; const char* b2 = last ? nB : cB + (size_t)(t + 2) * kstep;
            const char* a3 = a2 + kstep; const char* b3 = b2 + kstep;
            if (last && has_next) S.a_ready(nxt);
            if constexpr (SP2) {
            PG8_LDB(B0, 0, 0); PG8_LDB(B1, 0, 1); PG8_SCHED; PG8_LDA(At, 0, 0); PG8_STAGE(PG8_SA(1, 1), a1 + hstep, voffA);
            PG8_WAIT_V(8); PG8_WAIT_L(0); PG8_BAR; PG8_MMA(0, 0, At, B0); PG8_MMA(0, 1, At, B1); PG8_BAR; PG8_SCHED;
            PG8_LDA(At, 0, 1); PG8_STAGE(PG8_SB(0, 0), b2, voffB); PG8_STAGE(PG8_SB(0, 1), b2 + hstep, voffB); PG8_STAGE(PG8_SA(0, 0), a2, voffA);
            PG8_WAIT_V(8); PG8_WAIT_L(0); PG8_BAR; PG8_MMA(1, 0, At, B0); PG8_MMA(1, 1, At, B1); PG8_BAR; PG8_SCHED;
            PG8_LDB(B0, 1, 0); PG8_LDB(B1, 1, 1); PG8_SCHED; PG8_LDA(At, 1, 0); PG8_STAGE(PG8_SA(0, 1), a2 + hstep, voffA);
            PG8_WAIT_V(8); PG8_WAIT_L(0); PG8_BAR; PG8_MMA(0, 0, At, B0); PG8_MMA(0, 1, At, B1); PG8_BAR; PG8_SCHED;
            PG8_LDA(At, 1, 1); PG8_STAGE(PG8_SB(1, 0), b3, voffB); PG8_STAGE(PG8_SB(1, 1), b3 + hstep, voffB); PG8_STAGE(PG8_SA(1, 0), a3, voffA);
            PG8_WAIT_V(8); PG8_WAIT_L(0); PG8_BAR; PG8_MMA(1, 0, At, B0); PG8_MMA(1, 1, At, B1); PG8_BAR; PG8_SCHED;
            } else {
            PG8_LDB(B0, 0, 0); PG8_SCHED; PG8_LDA(At, 0, 0); PG8_STAGE(PG8_SA(1, 1), a1 + hstep, voffA);
            PG8_WAIT_L(8); PG8_BAR; PG8_WAIT_L(0); PG8_MMA(0, 0, At, B0); PG8_BAR; PG8_SCHED;
            PG8_LDB(B1, 0, 1); PG8_STAGE(PG8_SB(0, 0), b2, voffB);
            PG8_BAR; PG8_WAIT_L(0); PG8_MMA(0, 1, At, B1); PG8_BAR;
            PG8_LDA(At, 0, 1); PG8_STAGE(PG8_SA(0, 0), a2, voffA);
            PG8_BAR; PG8_WAIT_L(0); PG8_MMA(1, 0, At, B0); PG8_BAR; PG8_SCHED;
            PG8_STAGE(PG8_SB(0, 1), b2 + hstep, voffB);
            PG8_WAIT_V(6); PG8_BAR; PG8_MMA(1, 1, At, B1); PG8_BAR;
            PG8_LDB(B0, 1, 0); PG8_SCHED; PG8_LDA(At, 1, 0); PG8_STAGE(PG8_SA(0, 1), a2 + hstep, voffA);
            PG8_WAIT_L(8); PG8_BAR; PG8_WAIT_L(0); PG8_MMA(0, 0, At, B0); PG8_BAR; PG8_SCHED;
            PG8_LDB(B1, 1, 1); PG8_STAGE(PG8_SB(1, 0), b3, voffB);
            PG8_BAR; PG8_WAIT_L(0); PG8_MMA(0, 1, At, B1); PG8_BAR;
            PG8_LDA(At, 1, 1); PG8_STAGE(PG8_SA(1, 0), a3, voffA);
            PG8_BAR; PG8_WAIT_L(0); PG8_MMA(1, 0, At, B0); PG8_BAR; PG8_SCHED;
            PG8_STAGE(PG8_SB(1, 1), b3 + hstep, voffB);
            PG8_WAIT_V(6); PG8_BAR; PG8_MMA(1, 1, At, B1); PG8_BAR;
            }
        }
        if constexpr (ALIGN_EPI) { if (wr == 0) PG8_BAR; }
        if constexpr (!Epi::AFTER_DRAIN) { E(acc, cur, wr, wc, fr, fq); S.done(cur); }
        if (!has_next) break;
#pragma unroll
        for (int a = 0; a < 2; ++a)
#pragma unroll
            for (int b = 0; b < 2; ++b)
#pragma unroll
                for (int m = 0; m < 4; ++m)
#pragma unroll
                    for (int n = 0; n < 2; ++n) acc[a][b][m][n] = (f32x4){0.f, 0.f, 0.f, 0.f};
        cur = nxt; cA = nA; cB = nB; ++ui;
        if constexpr (ALIGN_EPI) { if (wr == 1) PG8_BAR; }
    }
    PG8_WAIT_V(0);
    if constexpr (!ALIGN_EPI) { if (wr == 0) PG8_BAR; }
    PG8_BAR;
    if constexpr (Epi::AFTER_DRAIN) { E.fused(acc, cur, wr, wc, fr, fq, lds, wid, lane); S.done(cur); }
#undef PG8_SA
#undef PG8_SB
#undef PG8_STAGE
#undef PG8_LDA
#undef PG8_LDB
#undef PG8_MMA
#undef PG8_WAIT_V
#undef PG8_WAIT_L
#undef PG8_BAR
#undef PG8_SCHED
}
}


struct Args { const float* in[17]; float* out; unsigned char* ws; int ph_lo, ph_hi; };

struct Ctx { LAS unsigned char* lds; unsigned char* ws; int tid, lane, wave, bid, G; };

#define LDS_WAIT() asm volatile("s_waitcnt lgkmcnt(0)" ::: "memory")
constexpr int LDS_PTAB = 147200;
__device__ __forceinline__ const float* INP(const Ctx& X, int i) {
    const volatile LAS unsigned* t = (const volatile LAS unsigned*)(X.lds + LDS_PTAB) + 2 * i;
    const unsigned lo = __builtin_amdgcn_readfirstlane(t[0]), hi = __builtin_amdgcn_readfirstlane(t[1]);
    return (const float*)(((unsigned long long)hi << 32) | lo);
}
#ifdef STAMP_A
#define STAMP(k) do { if (X.tid == 0) ((unsigned long long*)(X.ws + WS_DBG))[(k) * 256 + X.bid] = __builtin_amdgcn_s_memrealtime(); } while (0)
#else
#define STAMP(k) do { } while (0)
#endif
#define MFMA32(a, b, c) __builtin_amdgcn_mfma_f32_32x32x16_bf16((a), (b), (c), 0, 0, 0)
#define MFMA16(a, b, c) __builtin_amdgcn_mfma_f32_16x16x32_bf16((a), (b), (c), 0, 0, 0)

__device__ __forceinline__ int map_win(int n) {
    if (n < 1024) return SRC_GQ + n;
    if (n < 2048) return SRC_GK + (n - 1024);
    if (n < 4096) return SRC_GV + (n - 2048);
    if (n < 6144) return SRC_GR + (n - 4096);
    if (n < 8192) return SRC_DQ + (n - 6144);
    if (n < 10240) return SRC_DK + (n - 8192);
    if (n < 12288) return SRC_DV + (n - 10240);
    if (n < 14336) return SRC_GA + (n - 12288);
    if (n < 16384) return SRC_GB + (n - 14336);
    if (n < 16896) return SRC_IQ + (n - 16384);
    n -= 16896;
    if (n < 16) return SRC_GLR + n;
    if (n < 80) return SRC_IK + (n - 16);
    if (n < 88) return SRC_IW + (n - 80);
    return -1;
}
__device__ __forceinline__ int map_wgu(int n) { const int j = n >> 8, rr = n & 255; return rr < 128 ? 128 * j + rr : DFF + 128 * j + (rr - 128); }

__device__ __forceinline__ void transpose_item(const float* W, int N, bf16_t* WT, int K, LAS float* scr, int kb, int nb, int lane, int src) {
    const int k0 = 64 * kb, n0 = 32 * nb;
    const float* wp = W + (size_t)(k0 + (lane >> 5)) * N + (src >= 0 ? src : 0);
    float v[32];
#pragma unroll
    for (int i = 0; i < 32; ++i) v[i] = (src >= 0) ? wp[(size_t)(2 * i) * N] : 0.f;
#pragma unroll
    for (int i = 0; i < 32; ++i) scr[(2 * i + (lane >> 5)) * 33 + (lane & 31)] = v[i];
    LDS_WAIT();
    const int c = lane & 7;
#pragma unroll
    for (int j = 0; j < 4; ++j) { const int n = (lane >> 3) + 8 * j; const LAS float* s = scr + (8 * c) * 33 + n;
        u32x4 o; o.x = pk2(s[0 * 33], s[1 * 33]); o.y = pk2(s[2 * 33], s[3 * 33]); o.z = pk2(s[4 * 33], s[5 * 33]); o.w = pk2(s[6 * 33], s[7 * 33]);
        *(u32x4*)(WT + (size_t)(n0 + n) * K + k0 + 8 * c) = o; }
    LDS_WAIT();
}

template <bool DO_MOD>
__device__ __forceinline__ void p0_prologue(const Ctx& X, const Args& a) {
    unsigned char* ws = X.ws;
    if (DO_MOD) {
        LAS float* sc = (LAS float*)X.lds;
        LAS float* red = (LAS float*)(X.lds + 2048);
        float* part = (float*)(ws + WS_MODP);
        const float* wada = INP(X, I_WADA); const float* cvec = INP(X, I_C);
        const int rs = X.tid >> 7, ct = X.tid & 127;
        for (int u = X.bid; u < 384; u += X.G) {
            const int kc = u / 24, cb = u % 24, k0 = 128 * kc, col = cb * 512 + 4 * ct;
            { const float v = cvec[(X.tid >> 7) * DM + k0 + (X.tid & 127)]; sc[X.tid] = siluf(v); }
            __syncthreads();
            f32x4 acc[4];
#pragma unroll
            for (int b = 0; b < 4; ++b) acc[b] = (f32x4){0.f, 0.f, 0.f, 0.f};
#pragma unroll 1
            for (int hb = 0; hb < 4; ++hb) {
                f32x4 w[8];
#pragma unroll
                for (int kk = 0; kk < 8; ++kk) w[kk] = __builtin_nontemporal_load((const f32x4*)(wada + (size_t)(k0 + 32 * rs + 8 * hb + kk) * NMOD + col));
#pragma unroll
                for (int kk = 0; kk < 8; ++kk)
#pragma unroll
                    for (int b = 0; b < 4; ++b) acc[b] += w[kk] * sc[b * 128 + 32 * rs + 8 * hb + kk];
            }
#pragma unroll
            for (int b = 0; b < 4; ++b) *(LAS f32x4*)(red + (rs * 4 + b) * 512 + 4 * ct) = acc[b];
            __syncthreads();
            { const int b = rs; f32x4 t = *(const LAS f32x4*)(red + (0 * 4 + b) * 512 + 4 * ct);
#pragma unroll
              for (int r2 = 1; r2 < 4; ++r2) t += *(const LAS f32x4*)(red + (r2 * 4 + b) * 512 + 4 * ct);
              *(f32x4*)(part + ((size_t)kc * 4 + b) * NMOD + col) = t; }
            __syncthreads();
        }
    }
    STAMP(14);
    {
        const int* pos = (const int*)INP(X, I_POS);
        float2* rd = (float2*)(ws + WS_ROPED); float2* ri = (float2*)(ws + WS_ROPEI);
        for (int i = X.bid * NT + X.tid; i < MTOK * 24; i += X.G * NT) {
            int m, j; float ex; float2* dst;
            if (i < MTOK * 16) { m = i >> 4; j = i & 15; ex = (float)j * (1.0f / 16.0f); dst = rd + i; }
            else { const int i2 = i - MTOK * 16; m = i2 >> 3; j = i2 & 7; ex = (float)j * (1.0f / 8.0f); dst = ri + i2; }
            const float inv = exp2f(-ex * 18.931568569324174f);
            const float ang = (float)pos[m] * inv;
            double r = (double)ang * 0.15915494309189535; r -= rint(r);
            const float ar = (float)(r * 6.283185307179586);
            *dst = make_float2(__cosf(ar), __sinf(ar));
        }
    }
    STAMP(15);
    {
        LAS float* scr = (LAS float*)(X.lds + 1024 + X.wave * 8704);
        const int gw = X.bid * NW + X.wave, NGW = X.G * NW;
        constexpr int I_IN = 32 * (INWP / 32), I_SQ = 32 * 64, I_GU = 32 * (2 * DFF / 32), I_DN = (DFF / 64) * 64;
        constexpr int NITEMS = I_IN + 3 * I_SQ + I_GU + I_DN;
        for (int it = gw; it < NITEMS; it += NGW) {
            int r = it;
            if (r < I_IN) { const int nbk = INWP / 32, kb = r / nbk, nb = r % nbk; transpose_item(INP(X, I_WIN), INW, (bf16_t*)(ws + WS_WIN), DM, scr, kb, nb, X.lane, map_win(32 * nb + (X.lane & 31))); continue; } r -= I_IN;
            if (r < I_SQ) { const int kb = r / 64, nb = r % 64; transpose_item(INP(X, I_WBGA), DM, (bf16_t*)(ws + WS_WBGA), DM, scr, kb, nb, X.lane, 32 * nb + (X.lane & 31)); continue; } r -= I_SQ;
            if (r < I_SQ) { const int kb = r / 64, nb = r % 64; transpose_item(INP(X, I_WBDSA), DM, (bf16_t*)(ws + WS_WBDSA), DM, scr, kb, nb, X.lane, 32 * nb + (X.lane & 31)); continue; } r -= I_SQ;
            if (r < I_SQ) { const int kb = r / 64, nb = r % 64; transpose_item(INP(X, I_WMO), DM, (bf16_t*)(ws + WS_WMO), DM, scr, kb, nb, X.lane, 32 * nb + (X.lane & 31)); continue; } r -= I_SQ;
            if (r < I_GU) { const int nbk = 2 * DFF / 32, kb = r / nbk, nb = r % nbk; transpose_item(INP(X, I_WGU), 2 * DFF, (bf16_t*)(ws + WS_WGU), DM, scr, kb, nb, X.lane, map_wgu(32 * nb + (X.lane & 31))); continue; } r -= I_GU;
            { const int kb = r / 64, nb = r % 64; transpose_item(INP(X, I_WDN), DM, (bf16_t*)(ws + WS_WDN), DFF, scr, kb, nb, X.lane, 32 * nb + (X.lane & 31)); }
        }
    }
}

__device__ __forceinline__ void norm_mod_rows(const Ctx& X, const float* x, const float* gain, const float* mod, int i_sh, int i_sc, bf16_t* out) {
    const int gw = X.bid * NW + X.wave, NGW = X.G * NW;
    for (int row = gw; row < MTOK; row += NGW) {
        const int b = row >> 11;
        const f32x4* xr = (const f32x4*)(x + (size_t)row * DM) + X.lane;
        f32x4 v[8]; float s = 0.f;
#pragma unroll
        for (int j = 0; j < 8; ++j) { v[j] = xr[64 * j]; s += (v[j][0] * v[j][0] + v[j][1] * v[j][1]) + (v[j][2] * v[j][2] + v[j][3] * v[j][3]); }
        const float rs = rsqrtf(wave_sum(s) * (1.f / DM) + RMS_EPS);
        const f32x4* g4 = (const f32x4*)gain + X.lane;
        const f32x4* sh4 = (const f32x4*)(mod + (size_t)b * NMOD + i_sh * DM) + X.lane;
        const f32x4* sc4 = (const f32x4*)(mod + (size_t)b * NMOD + i_sc * DM) + X.lane;
        u32x2* o8 = (u32x2*)(out + (size_t)row * DM) + X.lane;
#pragma unroll
        for (int j = 0; j < 8; ++j) { const f32x4 y = v[j] * rs * g4[64 * j] * (sc4[64 * j] + 1.f) + sh4[64 * j]; u32x2 w; w.x = pk2(y[0], y[1]); w.y = pk2(y[2], y[3]); o8[64 * j] = w; }
    }
}
__device__ __forceinline__ void norm1_rows(const Ctx& X, const float* x, const float* gain, const float* bada, float* mod, bf16_t* out) {
    const float* part = (const float*)(X.ws + WS_MODP);
    for (int o = X.bid * NT + X.tid; o < 4 * NMOD; o += X.G * NT) { const int bb = o / NMOD, n = o % NMOD; float t = bada[n];
#pragma unroll
        for (int kc = 0; kc < 16; ++kc) t += part[((size_t)kc * 4 + bb) * NMOD + n];
        mod[o] = t; }
    const int nbp = X.G >> 2, b = (X.bid / nbp) < 3 ? (X.bid / nbp) : 3, lb = X.bid - b * nbp, nbb = (b == 3) ? (X.G - 3 * nbp) : nbp;
    LAS float* shs = (LAS float*)X.lds;
    for (int n = X.tid; n < 2 * DM; n += NT) { float t = bada[n];
#pragma unroll
        for (int kc = 0; kc < 16; ++kc) t += part[((size_t)kc * 4 + b) * NMOD + n];
        shs[n] = t; }
    __syncthreads();
    for (int rl = lb * NW + X.wave; rl < SEQ; rl += nbb * NW) {
        const int row = b * SEQ + rl;
        const f32x4* xr = (const f32x4*)(x + (size_t)row * DM) + X.lane;
        f32x4 v[8]; float s = 0.f;
#pragma unroll
        for (int j = 0; j < 8; ++j) { v[j] = xr[64 * j]; s += (v[j][0] * v[j][0] + v[j][1] * v[j][1]) + (v[j][2] * v[j][2] + v[j][3] * v[j][3]); }
        const float rs = rsqrtf(wave_sum(s) * (1.f / DM) + RMS_EPS);
        const f32x4* g4 = (const f32x4*)gain + X.lane;
        u32x2* o8 = (u32x2*)(out + (size_t)row * DM) + X.lane;
#pragma unroll
        for (int j = 0; j < 8; ++j) { const f32x4 sh = *(const LAS f32x4*)(shs + 4 * (X.lane + 64 * j)), sc = *(const LAS f32x4*)(shs + DM + 4 * (X.lane + 64 * j));
            const f32x4 y = v[j] * rs * g4[64 * j] * (sc + 1.f) + sh; u32x2 w; w.x = pk2(y[0], y[1]); w.y = pk2(y[2], y[3]); o8[64 * j] = w; }
    }
    __syncthreads();
}
__device__ __forceinline__ void final_norm_rows(const Ctx& X, float* x, const float* gain) {
    const int gw = X.bid * NW + X.wave, NGW = X.G * NW;
    for (int row = gw; row < MTOK; row += NGW) {
        f32x4* xr = (f32x4*)(x + (size_t)row * DM) + X.lane;
        f32x4 v[8]; float s = 0.f;
#pragma unroll
        for (int j = 0; j < 8; ++j) { v[j] = xr[64 * j]; s += (v[j][0] * v[j][0] + v[j][1] * v[j][1]) + (v[j][2] * v[j][2] + v[j][3] * v[j][3]); }
        const float rs = rsqrtf(wave_sum(s) * (1.f / DM) + RMS_EPS);
        const f32x4* g4 = (const f32x4*)gain + X.lane;
#pragma unroll
        for (int j = 0; j < 8; ++j) xr[64 * j] = v[j] * rs * g4[64 * j];
    }
}

__device__ __forceinline__ float log_sigmoid_f(float z) { return fminf(z, 0.f) - log1pf(expf(-fabsf(z))); }

__device__ __forceinline__ void gla_prep_unit(const Ctx& X, const Args& a, int u) {
    unsigned char* ws = X.ws; const int tid = X.tid, lane = X.lane, wave = X.wave;
    LAS bf16_t* qs = (LAS bf16_t*)X.lds;
    LAS bf16_t* ks = (LAS bf16_t*)(X.lds + 33792);
    LAS float* glr = (LAS float*)(X.lds + 67584);
    LAS float* tot = (LAS float*)(X.lds + 71680);
    const int h = u & 3, row0 = (u >> 2) * 64;
    bf16_t* qblk = (bf16_t*)(ws + WS_QA) + (size_t)u * 64 * 256;
    bf16_t* kblk = (bf16_t*)(ws + WS_KA) + (size_t)u * 64 * 256;
    const float* small = (const float*)(ws + WS_SMALL);
    for (int i = tid; i < 1024; i += NT) glr[i] = small[(size_t)(row0 + (i >> 4)) * SMALLW + 512 + (i & 15)];
#pragma unroll
    for (int i = 0; i < 4; ++i) { const int id = tid + NT * i, t = id >> 5, c16 = id & 31;
        *(LAS u32x4*)(qs + t * 264 + 8 * c16) = *(const u32x4*)(qblk + t * 256 + 8 * c16); *(LAS u32x4*)(ks + t * 264 + 8 * c16) = *(const u32x4*)(kblk + t * 256 + 8 * c16); }
    const int d = tid & 255, half = tid >> 8;
    float up[16];
#pragma unroll
    for (int r = 0; r < 16; ++r) up[r] = INP(X, I_GUP)[r * 1024 + h * 256 + d];
    const float bias = INP(X, I_GBIAS)[h * 256 + d];
    __syncthreads();
    float tsum = 0.f;
#pragma unroll 4
    for (int tt = 0; tt < 32; ++tt) { const int t = 32 * half + tt; float z = bias;
#pragma unroll
        for (int r = 0; r < 16; ++r) z += glr[t * 16 + r] * up[r];
        tsum += log_sigmoid_f(z) * 0.0625f; }
    if (half == 0) tot[d] = tsum;
    __syncthreads();
    float cum = half ? tot[d] : 0.f;
#pragma unroll 4
    for (int tt = 0; tt < 32; ++tt) { const int t = 32 * half + tt; float z = bias;
#pragma unroll
        for (int r = 0; r < 16; ++r) z += glr[t * 16 + r] * up[r];
        cum += log_sigmoid_f(z) * 0.0625f;
        const float qv = bf2f(qs[t * 264 + d]), kv = bf2f(ks[t * 264 + d]);
        qs[t * 264 + d] = (bf16_t)f2bf(qv * expf(cum) * 0.0625f); ks[t * 264 + d] = (bf16_t)f2bf(kv * expf(-cum)); }
    if (half == 1) ((float*)(ws + WS_GDEC))[(size_t)u * 256 + d] = expf(cum);
    __syncthreads();
#pragma unroll
    for (int i = 0; i < 4; ++i) { const int id = tid + NT * i, t = id >> 5, c16 = id & 31; *(u32x4*)(qblk + t * 256 + 8 * c16) = *(const LAS u32x4*)(qs + t * 264 + 8 * c16); }
    {
        u32x4* dst = (u32x4*)(kblk + d * 64 + 32 * half);
#pragma unroll
        for (int i = 0; i < 4; ++i) { unsigned e[8];
#pragma unroll
            for (int k = 0; k < 8; ++k) e[k] = ks[(32 * half + 8 * i + k) * 264 + d];
            dst[i] = (u32x4){e[0] | (e[1] << 16), e[2] | (e[3] << 16), e[4] | (e[5] << 16), e[6] | (e[7] << 16)}; }
    }
    if (wave < 4) {
        const int ti = wave >> 1, tj = wave & 1, r32 = lane & 31, hi = lane >> 5;
        f32x16 acc;
#pragma unroll
        for (int r = 0; r < 16; ++r) acc[r] = 0.f;
#pragma unroll
        for (int s = 0; s < 16; ++s) { const bf16x8 af = *(const LAS bf16x8*)(qs + (32 * ti + r32) * 264 + 16 * s + 8 * hi); const bf16x8 bf = *(const LAS bf16x8*)(ks + (32 * tj + r32) * 264 + 16 * s + 8 * hi); acc = MFMA32(af, bf, acc); }
        bf16_t* at = (bf16_t*)(ws + WS_ATTN) + (size_t)u * 4096;
#pragma unroll
        for (int r = 0; r < 16; ++r) { const int i = 32 * ti + crow(r, hi), j = 32 * tj + r32; at[i * 64 + j] = (bf16_t)f2bf(j <= i ? acc[r] : 0.f); }
    }
    __syncthreads();
    {
        LAS bf16_t* vs = (LAS bf16_t*)X.lds;
        bf16_t* vblk = (bf16_t*)(ws + WS_VA) + (size_t)u * 64 * 512;
#pragma unroll
        for (int i = 0; i < 8; ++i) { const int id = tid + NT * i, t = id >> 6, c16 = id & 63; *(LAS u32x4*)(vs + t * 520 + 8 * c16) = *(const u32x4*)(vblk + t * 512 + 8 * c16); }
        __syncthreads();
#pragma unroll
        for (int i = 0; i < 8; ++i) { const int id = tid + NT * i, tq = id & 7, dv = id >> 3; unsigned e[8];
#pragma unroll
            for (int k = 0; k < 8; ++k) e[k] = vs[(8 * tq + k) * 520 + dv];
            *(u32x4*)(vblk + dv * 64 + 8 * tq) = (u32x4){e[0] | (e[1] << 16), e[2] | (e[3] << 16), e[4] | (e[5] << 16), e[6] | (e[7] << 16)}; }
    }
    __syncthreads();
}

__device__ __forceinline__ void dv_transpose(const Ctx& X) {
    LAS bf16_t* scr = (LAS bf16_t*)(X.lds + X.wave * 17408);
    const int gw = X.bid * NW + X.wave, NGW = X.G * NW, lane = X.lane;
    for (int blk = gw; blk < BATCH * NCH * DH; blk += NGW) {
        bf16_t* p = (bf16_t*)(X.ws + WS_DV) + (size_t)blk * 64 * 128;
#pragma unroll
        for (int i = 0; i < 16; ++i) { const int id = lane + 64 * i, t = id >> 4, c16 = id & 15; *(LAS u32x4*)(scr + t * 136 + 8 * c16) = *(const u32x4*)(p + t * 128 + 8 * c16); }
        LDS_WAIT();
#pragma unroll
        for (int i = 0; i < 16; ++i) { const int id = lane + 64 * i, kq = id & 7, dd = id >> 3; unsigned e[8];
#pragma unroll
            for (int k = 0; k < 8; ++k) e[k] = scr[(8 * kq + k) * 136 + dd];
            *(u32x4*)(p + dd * 64 + 8 * kq) = (u32x4){e[0] | (e[1] << 16), e[2] | (e[3] << 16), e[4] | (e[5] << 16), e[6] | (e[7] << 16)}; }
        LDS_WAIT();
    }
}

__device__ __forceinline__ void idx_prep(const Ctx& X) {
    const int gw = X.bid * NW + X.wave, NGW = X.G * NW, lane = X.lane;
    const float* small = (const float*)(X.ws + WS_SMALL);
    const float2* ri = (const float2*)(X.ws + WS_ROPEI);
    for (int m = gw; m < MTOK; m += NGW) {
        const float* sr = small + (size_t)m * SMALLW;
        float2 cs[8];
#pragma unroll
        for (int e = 0; e < 8; ++e) cs[e] = ri[(size_t)m * 8 + e];
        {
            const int seg = lane & 7; float v[8];
            const f32x4 a0 = *(const f32x4*)(sr + 8 * lane), a1 = *(const f32x4*)(sr + 8 * lane + 4);
            v[0] = a0[0]; v[1] = a0[1]; v[2] = a0[2]; v[3] = a0[3]; v[4] = a1[0]; v[5] = a1[1]; v[6] = a1[2]; v[7] = a1[3];
#pragma unroll
            for (int e = 0; e < 8; ++e) { const float p = __shfl_xor(v[e], 1); if (seg == 0) v[e] = v[e] * cs[e].x - p * cs[e].y; else if (seg == 1) v[e] = p * cs[e].y + v[e] * cs[e].x; }
            *(u32x4*)((bf16_t*)(X.ws + WS_IQ) + (size_t)m * 512 + 8 * lane) = (u32x4){pk2(v[0], v[1]), pk2(v[2], v[3]), pk2(v[4], v[5]), pk2(v[6], v[7])};
        }
        {
            const int l7 = lane & 7; float v[8];
            const f32x4 a0 = *(const f32x4*)(sr + 528 + 8 * l7), a1 = *(const f32x4*)(sr + 528 + 8 * l7 + 4);
            v[0] = a0[0]; v[1] = a0[1]; v[2] = a0[2]; v[3] = a0[3]; v[4] = a1[0]; v[5] = a1[1]; v[6] = a1[2]; v[7] = a1[3];
#pragma unroll
            for (int e = 0; e < 8; ++e) { const float p = __shfl_xor(v[e], 1); if (l7 == 0) v[e] = v[e] * cs[e].x - p * cs[e].y; else if (l7 == 1) v[e] = p * cs[e].y + v[e] * cs[e].x; }
            if (lane < 8) *(u32x4*)((bf16_t*)(X.ws + WS_IK) + (size_t)m * 64 + 8 * lane) = (u32x4){pk2(v[0], v[1]), pk2(v[2], v[3]), pk2(v[4], v[5]), pk2(v[6], v[7])};
            if (lane < 8) ((float*)(X.ws + WS_IW))[(size_t)m * 8 + lane] = sr[592 + lane] * 0.044194173824159216f;
        }
    }
}

__device__ __forceinline__ void rope_qk(const Ctx& X) {
    const int gw = X.bid * NW + X.wave, NGW = X.G * NW, lane = X.lane, seg = lane & 3;
    const float sg = (seg < 2) ? -1.f : 1.f;
    for (int m = gw; m < MTOK; m += NGW) {
        const f32x4* cs = (const f32x4*)((const float2*)(X.ws + WS_ROPED) + (size_t)m * 16 + 8 * (seg & 1));
        const f32x4 c01 = cs[0], c23 = cs[1], c45 = cs[2], c67 = cs[3];
#pragma unroll
        for (int which = 0; which < 2; ++which) {
            bf16_t* p = (bf16_t*)(X.ws + (which ? WS_DK : WS_DQ)) + (size_t)m * DM + (lane >> 2) * DHD + 8 * seg;
            const u32x4 w = *(const u32x4*)p;
            float v[8] = {bf2f(w.x & 0xffffu), bf2f(w.x >> 16), bf2f(w.y & 0xffffu), bf2f(w.y >> 16), bf2f(w.z & 0xffffu), bf2f(w.z >> 16), bf2f(w.w & 0xffffu), bf2f(w.w >> 16)};
            float q[8];
#pragma unroll
            for (int e = 0; e < 8; ++e) q[e] = __shfl_xor(v[e], 2);
            v[0] = v[0] * c01[0] + sg * q[0] * c01[1]; v[1] = v[1] * c01[2] + sg * q[1] * c01[3]; v[2] = v[2] * c23[0] + sg * q[2] * c23[1]; v[3] = v[3] * c23[2] + sg * q[3] * c23[3];
            v[4] = v[4] * c45[0] + sg * q[4] * c45[1]; v[5] = v[5] * c45[2] + sg * q[5] * c45[3]; v[6] = v[6] * c67[0] + sg * q[6] * c67[1]; v[7] = v[7] * c67[2] + sg * q[7] * c67[3];
            *(u32x4*)p = (u32x4){pk2(v[0], v[1]), pk2(v[2], v[3]), pk2(v[4], v[5]), pk2(v[6], v[7])};
        }
    }
}

constexpr int LDS_MISC = 143360;
__device__ __forceinline__ void gla_scan_unit(const Ctx& X, int unit) {
    unsigned char* ws = X.ws; const int tid = X.tid, lane = X.lane, wave = X.wave, r32 = lane & 31, hi = lane >> 5;
    const int p = unit & 15, sl = unit >> 4, b = p >> 2, h = p & 3, j = wave & 1, g = wave >> 1;
    LAS bf16_t* qs = (LAS bf16_t*)X.lds;
    LAS bf16_t* kts = (LAS bf16_t*)(X.lds + 33792);
    LAS bf16_t* as_ = (LAS bf16_t*)(X.lds + 70656);
    LAS bf16_t* vts = (LAS bf16_t*)(X.lds + 79872);
    LAS float* gd = (LAS float*)(X.lds + 89088);
    LAS unsigned char* po = X.lds + 90112;
    f32x16 S[2];
#pragma unroll
    for (int k = 0; k < 2; ++k)
#pragma unroll
        for (int r = 0; r < 16; ++r) S[k][r] = 0.f;
    float* oa = (float*)(ws + WS_OA);
    u32x4 pq[4], pk[4], pa, pv; f32x4 pg = (f32x4){0.f, 0.f, 0.f, 0.f};
#define SCAN_ISSUE(c_) do { const int ub_ = (b * NCH + (c_)) * 4 + h; \
        const bf16_t* qblk_ = (const bf16_t*)(ws + WS_QA) + (size_t)ub_ * 64 * 256; const bf16_t* kblk_ = (const bf16_t*)(ws + WS_KA) + (size_t)ub_ * 64 * 256; \
        const bf16_t* vblk_ = (const bf16_t*)(ws + WS_VA) + (size_t)ub_ * 64 * 512 + (size_t)(64 * sl) * 64; const bf16_t* ablk_ = (const bf16_t*)(ws + WS_ATTN) + (size_t)ub_ * 4096; \
        _Pragma("unroll") for (int i_ = 0; i_ < 4; ++i_) { const int id_ = tid + NT * i_; pq[i_] = *(const u32x4*)(qblk_ + (id_ >> 5) * 256 + 8 * (id_ & 31)); pk[i_] = *(const u32x4*)(kblk_ + (id_ >> 3) * 64 + 8 * (id_ & 7)); } \
        pa = *(const u32x4*)(ablk_ + (tid >> 3) * 64 + 8 * (tid & 7)); pv = *(const u32x4*)(vblk_ + (tid >> 3) * 64 + 8 * (tid & 7)); \
        if (tid < 64) pg = *(const f32x4*)((const float*)(ws + WS_GDEC) + (size_t)ub_ * 256 + 4 * tid); } while (0)
#define SCAN_COMMIT() do { \
        _Pragma("unroll") for (int i_ = 0; i_ < 4; ++i_) { const int id_ = tid + NT * i_; *(LAS u32x4*)(qs + (id_ >> 5) * 264 + 8 * (id_ & 31)) = pq[i_]; *(LAS u32x4*)(kts + (id_ >> 3) * 72 + 8 * (id_ & 7)) = pk[i_]; } \
        *(LAS u32x4*)(as_ + (tid >> 3) * 72 + 8 * (tid & 7)) = pa; *(LAS u32x4*)(vts + (tid >> 3) * 72 + 8 * (tid & 7)) = pv; \
        if (tid < 64) *(LAS f32x4*)(gd + 4 * tid) = pg; } while (0)
    __syncthreads();
    SCAN_ISSUE(0); SCAN_COMMIT();
    __syncthreads();
    for (int c = 0; c < NCH; ++c) {
        if (c + 1 < NCH) SCAN_ISSUE(c + 1);
        bf16x8 bv[4];
#pragma unroll
        for (int s = 0; s < 4; ++s) bv[s] = *(const LAS bf16x8*)(vts + (32 * j + r32) * 72 + 16 * s + 8 * hi);
        f32x16 o[2];
#pragma unroll
        for (int tt = 0; tt < 2; ++tt)
#pragma unroll
            for (int r = 0; r < 16; ++r) o[tt][r] = 0.f;
        if (g == 0) {
#pragma unroll
            for (int tt = 0; tt < 2; ++tt)
#pragma unroll
                for (int s = 0; s < 4; ++s) { const bf16x8 af = *(const LAS bf16x8*)(as_ + (32 * tt + r32) * 72 + 16 * s + 8 * hi); o[tt] = MFMA32(af, bv[s], o[tt]); }
        }
#pragma unroll
        for (int kk = 0; kk < 2; ++kk)
#pragma unroll
            for (int s = 0; s < 2; ++s) {
                u32x4 sw; sw.x = pg8::cvt_pk_bf16(S[kk][8 * s + 0], S[kk][8 * s + 1]); sw.y = pg8::cvt_pk_bf16(S[kk][8 * s + 2], S[kk][8 * s + 3]);
                sw.z = pg8::cvt_pk_bf16(S[kk][8 * s + 4], S[kk][8 * s + 5]); sw.w = pg8::cvt_pk_bf16(S[kk][8 * s + 6], S[kk][8 * s + 7]);
                const bf16x8 bs = __builtin_bit_cast(bf16x8, sw);
#pragma unroll
                for (int tt = 0; tt < 2; ++tt) { const LAS bf16_t* qp = qs + (32 * tt + r32) * 264 + 64 * g + 32 * kk + 16 * s + 4 * hi;
                    const u32x2 lo = *(const LAS u32x2*)qp, hi2 = *(const LAS u32x2*)(qp + 8);
                    const bf16x8 af = __builtin_bit_cast(bf16x8, (u32x4){lo.x, lo.y, hi2.x, hi2.y});
                    o[tt] = MFMA32(af, bs, o[tt]); }
            }
#pragma unroll
        for (int kk = 0; kk < 2; ++kk) {
#pragma unroll
            for (int s = 0; s < 4; ++s) { const bf16x8 af = *(const LAS bf16x8*)(kts + (64 * g + 32 * kk + r32) * 72 + 16 * s + 8 * hi); S[kk] = MFMA32(af, bv[s], S[kk]); }
#pragma unroll
            for (int q4 = 0; q4 < 4; ++q4) { const f32x4 dv = *(const LAS f32x4*)(gd + 64 * g + 32 * kk + 8 * q4 + 4 * hi);
#pragma unroll
                for (int jj = 0; jj < 4; ++jj) S[kk][4 * q4 + jj] *= dv[jj]; }
        }
        if (g > 0) { LAS unsigned char* pw = po + ((g - 1) * 2 + j) * 8192;
#pragma unroll
            for (int tt = 0; tt < 2; ++tt)
#pragma unroll
                for (int q4 = 0; q4 < 4; ++q4) *(LAS f32x4*)(pw + ((tt * 4 + q4) * 64 + lane) * 16) = (f32x4){o[tt][4 * q4], o[tt][4 * q4 + 1], o[tt][4 * q4 + 2], o[tt][4 * q4 + 3]}; }
        __syncthreads();
        if (g == 0) {
#pragma unroll
            for (int gg = 0; gg < 3; ++gg) { const LAS unsigned char* pr = po + (gg * 2 + j) * 8192;
#pragma unroll
                for (int tt = 0; tt < 2; ++tt)
#pragma unroll
                    for (int q4 = 0; q4 < 4; ++q4) { const f32x4 t4 = *(const LAS f32x4*)(pr + ((tt * 4 + q4) * 64 + lane) * 16);
                        o[tt][4 * q4] += t4[0]; o[tt][4 * q4 + 1] += t4[1]; o[tt][4 * q4 + 2] += t4[2]; o[tt][4 * q4 + 3] += t4[3]; } }
#pragma unroll
            for (int tt = 0; tt < 2; ++tt)
#pragma unroll
                for (int r = 0; r < 16; ++r) oa[(size_t)(b * SEQ + c * 64 + 32 * tt + crow(r, hi)) * DM + h * GDV + 64 * sl + 32 * j + r32] = o[tt][r];
        }
        if (c + 1 < NCH) SCAN_COMMIT();
        __syncthreads();
    }
#undef SCAN_ISSUE
#undef SCAN_COMMIT
}

__device__ __forceinline__ unsigned fkey(float f) { const unsigned u = __float_as_uint(f); return (u & 0x80000000u) ? ~u : (u | 0x80000000u); }
__device__ __forceinline__ void idx_topk_unit(const Ctx& X, int unit) {
    unsigned char* ws = X.ws; const int lane = X.lane, wave = X.wave;
    const int b = unit >> 7, qb = unit & 127, q0 = 16 * qb;
    LAS float* sc = (LAS float*)X.lds;
    const bf16_t* IQ = (const bf16_t*)(ws + WS_IQ); const bf16_t* IK = (const bf16_t*)(ws + WS_IK); const float* IW = (const float*)(ws + WS_IW);
    const int l15 = lane & 15, l4 = lane >> 4;
    {
        bf16x8 bq[8][2]; float wq[8];
        const size_t mq = (size_t)(b * SEQ + q0 + l15);
#pragma unroll
        for (int hh = 0; hh < 8; ++hh) { wq[hh] = IW[mq * 8 + hh];
#pragma unroll
            for (int s = 0; s < 2; ++s) bq[hh][s] = *(const bf16x8*)(IQ + mq * 512 + hh * 64 + 32 * s + 8 * l4); }
        const int ntile = qb + 1;
        bf16x8 a0 = (bf16x8){0, 0, 0, 0, 0, 0, 0, 0}, a1 = a0;
        if (wave < ntile) { const size_t mk = (size_t)(b * SEQ + 16 * wave + l15); a0 = *(const bf16x8*)(IK + mk * 64 + 8 * l4); a1 = *(const bf16x8*)(IK + mk * 64 + 32 + 8 * l4); }
        for (int tile = wave; tile < ntile; tile += NW) {
            const int key0 = 16 * tile; const bf16x8 c0 = a0, c1 = a1;
            if (tile + NW < ntile) { const size_t mk = (size_t)(b * SEQ + key0 + 16 * NW + l15); a0 = *(const bf16x8*)(IK + mk * 64 + 8 * l4); a1 = *(const bf16x8*)(IK + mk * 64 + 32 + 8 * l4); }
            f32x4 s4 = (f32x4){0.f, 0.f, 0.f, 0.f};
#pragma unroll
            for (int hh = 0; hh < 8; ++hh) { f32x4 acc = (f32x4){0.f, 0.f, 0.f, 0.f}; acc = MFMA16(c0, bq[hh][0], acc); acc = MFMA16(c1, bq[hh][1], acc);
#pragma unroll
                for (int r = 0; r < 4; ++r) s4[r] += wq[hh] * fmaxf(acc[r], 0.f); }
            *(LAS f32x4*)(sc + l15 * 2048 + key0 + 4 * l4) = s4;
        }
    }
    __syncthreads();
    unsigned long long* mask = (unsigned long long*)(ws + WS_MASK);
    for (int qi = 0; qi < 2; ++qi) {
        const int q = 2 * wave + qi, t = q0 + q, n = t + 1;
        unsigned long long myw = 0ull;
        if (n <= TOPK) {
            const int lo = 64 * lane;
            if (lo + 63 <= t) myw = ~0ull; else if (lo <= t) myw = (~0ull) >> (63 - (t - lo));
        } else {
            unsigned u[32];
#pragma unroll
            for (int r = 0; r < 32; ++r) { const int key = 64 * r + lane; u[r] = (key <= t) ? fkey(sc[q * 2048 + (key <= t ? key : 0)]) : 0u; }
            unsigned T = 0u; bool exact = false;
            for (int bit = 31; bit >= 0; --bit) { const unsigned cand = T | (1u << bit); int c = 0;
#pragma unroll
                for (int r = 0; r < 32; ++r) c += (u[r] >= cand) ? 1 : 0;
                int cnt = 0;
#pragma unroll
                for (int bb = 0; bb < 6; ++bb) cnt += __popcll(__ballot((c >> bb) & 1)) << bb;
                if (cnt >= TOPK) T = cand;
                if (cnt == TOPK) { exact = true; break; } }
            int cg_ = 0;
#pragma unroll
            for (int r = 0; r < 32; ++r) cg_ += (u[r] > T) ? 1 : 0;
            int ngt = 0;
#pragma unroll
            for (int bb = 0; bb < 6; ++bb) ngt += __popcll(__ballot((cg_ >> bb) & 1)) << bb;
            const int need = exact ? (1 << 20) : (TOPK - ngt);
            int base = 0;
#pragma unroll
            for (int r = 0; r < 32; ++r) { const bool eq = (u[r] == T); const unsigned long long me = __ballot(eq);
                const int before = base + (int)__builtin_amdgcn_mbcnt_hi((unsigned)(me >> 32), __builtin_amdgcn_mbcnt_lo((unsigned)me, 0u));
                const unsigned long long w = __ballot((u[r] > T) || (eq && before < need));
                base += __popcll(me);
                if (lane == r) myw = w;
                __builtin_amdgcn_sched_barrier(0); }
        }
        if (lane < 32) mask[(size_t)(b * SEQ + t) * 32 + lane] = myw;
    }
    __syncthreads();
}

__device__ __forceinline__ void dsa_attn_unit(const Ctx& X, int b, int head, int qb) {
    unsigned char* ws = X.ws; const int tid = X.tid, lane = X.lane, wave = X.wave, r32 = lane & 31, hi = lane >> 5;
    LAS bf16_t* Kb = (LAS bf16_t*)X.lds;
    LAS bf16_t* Vb = (LAS bf16_t*)(X.lds + 34816);
    const bf16_t* DQ = (const bf16_t*)(ws + WS_DQ); const bf16_t* DK = (const bf16_t*)(ws + WS_DK); const bf16_t* DV = (const bf16_t*)(ws + WS_DV);
    const unsigned* mask = (const unsigned*)(ws + WS_MASK);
    const int qrow = b * SEQ + 256 * qb + 32 * wave + r32;
    const int NTL = 4 * qb + 4;
    const int myNT = 4 * qb + ((32 * wave + 31) >> 6) + 1;
    bf16x8 qf[8];
#pragma unroll
    for (int s = 0; s < 8; ++s) qf[s] = *(const bf16x8*)(DQ + (size_t)qrow * DM + head * DHD + 16 * s + 8 * hi);
    f32x16 ot[4];
#pragma unroll
    for (int d = 0; d < 4; ++d)
#pragma unroll
        for (int r = 0; r < 16; ++r) ot[d][r] = 0.f;
    float m_run = -1e30f, l_run = 0.f;
    const float C2 = 0.08838834764831845f * 1.4426950408889634f;
    u32x4 kreg0, kreg1, vreg0, vreg1;
#define ATT_ISSUE(kt_) do { \
        { const int id = tid, key = id >> 4, c16 = id & 15; kreg0 = *(const u32x4*)(DK + (size_t)(b * SEQ + 64 * (kt_) + key) * DM + head * DHD + 8 * c16); } \
        { const int id = tid + NT, key = id >> 4, c16 = id & 15; kreg1 = *(const u32x4*)(DK + (size_t)(b * SEQ + 64 * (kt_) + key) * DM + head * DHD + 8 * c16); } \
        { const int id = tid, dv = id >> 3, c16 = id & 7; vreg0 = *(const u32x4*)(DV + ((size_t)((b * NCH + (kt_)) * DH + head) * 128 + dv) * 64 + 8 * c16); } \
        { const int id = tid + NT, dv = id >> 3, c16 = id & 7; vreg1 = *(const u32x4*)(DV + ((size_t)((b * NCH + (kt_)) * DH + head) * 128 + dv) * 64 + 8 * c16); } } while (0)
#define ATT_COMMIT(buf_) do { \
        { const int id = tid, key = id >> 4, c16 = id & 15; *(LAS u32x4*)(Kb + (buf_) * 8704 + key * 136 + 8 * c16) = kreg0; } \
        { const int id = tid + NT, key = id >> 4, c16 = id & 15; *(LAS u32x4*)(Kb + (buf_) * 8704 + key * 136 + 8 * c16) = kreg1; } \
        { const int id = tid, dv = id >> 3, c16 = id & 7; *(LAS u32x4*)(Vb + (buf_) * 9216 + dv * 72 + 8 * c16) = vreg0; } \
        { const int id = tid + NT, dv = id >> 3, c16 = id & 7; *(LAS u32x4*)(Vb + (buf_) * 9216 + dv * 72 + 8 * c16) = vreg1; } } while (0)
    __syncthreads();
    ATT_ISSUE(0); ATT_COMMIT(0);
    __syncthreads();
    u32x2 mw_next = *(const u32x2*)(mask + (size_t)qrow * 64);
    for (int kt = 0; kt < NTL; ++kt) {
        const int buf = kt & 1;
        if (kt + 1 < NTL) ATT_ISSUE(kt + 1);
        if (kt < myNT) {
            const u32x2 mw = mw_next; if (kt + 1 < myNT) mw_next = *(const u32x2*)(mask + (size_t)qrow * 64 + 2 * (kt + 1));
            f32x16 p0, p1;
#pragma unroll
            for (int r = 0; r < 16; ++r) { p0[r] = 0.f; p1[r] = 0.f; }
            const LAS bf16_t* kb = Kb + buf * 8704;
#pragma unroll
            for (int s = 0; s < 8; ++s) { const bf16x8 a0 = *(const LAS bf16x8*)(kb + r32 * 136 + 16 * s + 8 * hi), a1 = *(const LAS bf16x8*)(kb + (32 + r32) * 136 + 16 * s + 8 * hi);
                p0 = MFMA32(a0, qf[s], p0); p1 = MFMA32(a1, qf[s], p1); }
            const unsigned lo = mw.x >> (4 * hi), hi_w = mw.y >> (4 * hi);
            float mx = -INFINITY;
#pragma unroll
            for (int r = 0; r < 16; ++r) { const int cb = (r & 3) + 8 * (r >> 2);
                p0[r] = ((lo >> cb) & 1u) ? p0[r] : -INFINITY; p1[r] = ((hi_w >> cb) & 1u) ? p1[r] : -INFINITY; mx = fmaxf(mx, fmaxf(p0[r], p1[r])); }
            mx = fmaxf(mx, __shfl_xor(mx, 32));
            const float m_new = fmaxf(m_run, mx);
            const float alpha = exp2f((m_run - m_new) * C2);
            const float mc = m_new * C2;
            float ls = 0.f;
#pragma unroll
            for (int r = 0; r < 16; ++r) { p0[r] = exp2f(fmaf(p0[r], C2, -mc)); p1[r] = exp2f(fmaf(p1[r], C2, -mc)); ls += p0[r] + p1[r]; }
            l_run = l_run * alpha + ls; m_run = m_new;
#pragma unroll
            for (int d = 0; d < 4; ++d)
#pragma unroll
                for (int r = 0; r < 16; ++r) ot[d][r] *= alpha;
            bf16x8 pb[4];
#pragma unroll
            for (int s = 0; s < 4; ++s) { u32x4 w;
                if (s < 2) { w.x = pg8::cvt_pk_bf16(p0[8 * s + 0], p0[8 * s + 1]); w.y = pg8::cvt_pk_bf16(p0[8 * s + 2], p0[8 * s + 3]); w.z = pg8::cvt_pk_bf16(p0[8 * s + 4], p0[8 * s + 5]); w.w = pg8::cvt_pk_bf16(p0[8 * s + 6], p0[8 * s + 7]); }
                else { const int s2 = s - 2; w.x = pg8::cvt_pk_bf16(p1[8 * s2 + 0], p1[8 * s2 + 1]); w.y = pg8::cvt_pk_bf16(p1[8 * s2 + 2], p1[8 * s2 + 3]); w.z = pg8::cvt_pk_bf16(p1[8 * s2 + 4], p1[8 * s2 + 5]); w.w = pg8::cvt_pk_bf16(p1[8 * s2 + 6], p1[8 * s2 + 7]); }
                pb[s] = __builtin_bit_cast(bf16x8, w); }
            const LAS bf16_t* vb = Vb + buf * 9216;
#pragma unroll
            for (int d = 0; d < 4; ++d)
#pragma unroll
                for (int s = 0; s < 4; ++s) { const LAS bf16_t* vp = vb + (32 * d + r32) * 72 + 16 * s + 4 * hi;
                    const u32x2 v0 = *(const LAS u32x2*)vp, v1 = *(const LAS u32x2*)(vp + 8);
                    const bf16x8 af = __builtin_bit_cast(bf16x8, (u32x4){v0.x, v0.y, v1.x, v1.y});
                    ot[d] = MFMA32(af, pb[s], ot[d]); }
        }
        if (kt + 1 < NTL) ATT_COMMIT(buf ^ 1);
        __syncthreads();
    }
    const float lt = l_run + __shfl_xor(l_run, 32);
    const float inv = 1.f / lt;
    bf16_t* ob = (bf16_t*)(ws + WS_OB) + (size_t)qrow * DM + head * DHD;
#pragma unroll
    for (int d = 0; d < 4; ++d)
#pragma unroll
        for (int g = 0; g < 4; ++g) { u32x2 w; w.x = pg8::cvt_pk_bf16(ot[d][4 * g] * inv, ot[d][4 * g + 1] * inv); w.y = pg8::cvt_pk_bf16(ot[d][4 * g + 2] * inv, ot[d][4 * g + 3] * inv);
            *(u32x2*)(ob + 32 * d + 8 * g + 4 * hi) = w; }
}

__device__ __forceinline__ void oa_norm_rows(const Ctx& X, const float* gng) {
    const int gw = X.bid * NW + X.wave, NGW = X.G * NW, lane = X.lane;
    const float* oa = (const float*)(X.ws + WS_OA); const bf16_t* ra = (const bf16_t*)(X.ws + WS_RA); bf16_t* oan = (bf16_t*)(X.ws + WS_H);
    for (int row = gw; row < MTOK; row += NGW) {
#pragma unroll
        for (int hh = 0; hh < GH; ++hh) {
            const size_t off = (size_t)row * DM + hh * GDV + 4 * lane;
            const f32x4 v0 = *(const f32x4*)(oa + off), v1 = *(const f32x4*)(oa + off + 256);
            float s = (v0[0] * v0[0] + v0[1] * v0[1]) + (v0[2] * v0[2] + v0[3] * v0[3]) + (v1[0] * v1[0] + v1[1] * v1[1]) + (v1[2] * v1[2] + v1[3] * v1[3]);
            const float rs = rsqrtf(wave_sum(s) * (1.f / GDV) + RMS_EPS);
            const f32x4 g0 = *(const f32x4*)(gng + hh * GDV + 4 * lane), g1 = *(const f32x4*)(gng + hh * GDV + 4 * lane + 256);
            const f32x4 r0 = pg8::bf4_to_f32(*(const u32x2*)(ra + off)), r1 = pg8::bf4_to_f32(*(const u32x2*)(ra + off + 256));
            const f32x4 y0 = v0 * rs * g0 * r0, y1 = v1 * rs * g1 * r1;
            *(u32x2*)(oan + off) = (u32x2){pk2(y0[0], y0[1]), pk2(y0[2], y0[3])}; *(u32x2*)(oan + off + 256) = (u32x2){pk2(y1[0], y1[1]), pk2(y1[2], y1[3])};
        }
    }
}


constexpr int NPHASE = 13;

__global__ void __launch_bounds__(NT, 2) fwd_kernel(Args args) {
    extern __shared__ __attribute__((aligned(16))) unsigned char lds_raw[];
    cg::grid_group grid = cg::this_grid();
    Ctx X;
    X.lds = (LAS unsigned char*)lds_raw; X.ws = args.ws;
    X.tid = threadIdx.x; X.lane = X.tid & 63; X.wave = __builtin_amdgcn_readfirstlane(X.tid >> 6);
    X.bid = blockIdx.x; X.G = gridDim.x;
    if (X.tid < 18) { const float* pv_ = (X.tid < 17) ? args.in[X.tid < 17 ? X.tid : 0] : (const float*)args.out; *(LAS unsigned long long*)(X.lds + LDS_PTAB + 8 * X.tid) = (unsigned long long)pv_; }
    __syncthreads();
    unsigned char* ws = args.ws;
#define mod ((float*)(ws + WS_MOD))
    const int lo = args.ph_lo, hi = args.ph_hi;
    STAMP(13);
#ifdef EXTRA_SYNCS
    for (int es_ = 0; es_ < EXTRA_SYNCS; ++es_) grid.sync();
#endif
#ifndef PH_ONLY
#define PH_ONLY -1
#endif
#ifndef PH_MASK
#define PH_MASK 0x1fff
#endif
#define IN(k) ((PH_ONLY < 0 || PH_ONLY == (k)) && ((PH_MASK >> (k)) & 1) && lo <= (k) && (k) < hi)
#define LAUNDER() do { int t_ = threadIdx.x; asm volatile("" : "+v"(t_)); X.tid = t_; X.lane = t_ & 63; X.wave = __builtin_amdgcn_readfirstlane(t_ >> 6); \
        unsigned char* w_ = args.ws; asm volatile("" : "+s"(w_)); ws = w_; X.ws = w_; } while (0)
#define SEAM(k) do { STAMP(k); if (IN(k) && IN((k) + 1)) grid.sync(); } while (0)

    if (IN(0)) {
    { LAUNDER(); p0_prologue<true>(X, args); }
    }
    SEAM(0);
    if (IN(1)) {
    { LAUNDER(); norm1_rows(X, INP(X, I_X), INP(X, I_N1G), INP(X, I_BADA), mod, (bf16_t*)(ws + WS_H)); }
    }
    SEAM(1);
    if (IN(2)) {
    { LAUNDER();
        pg8::Gemm g{(const bf16_t*)(ws + WS_H), (const bf16_t*)(ws + WS_WIN), MTOK, INWP, DM}; pg8::StaticOrder S; S.init(MTOK, INWP, X.G, X.bid);
        pg8::EpiInProj E{ws};
        pg8::gemm_phase<pg8::EpiInProj, pg8::StaticOrder, true, true>(X.lds, g, S, E);
    }
    }
    SEAM(2);
    if (IN(3)) {
    { LAUNDER();
        for (int u = X.bid; u < BATCH * NCH * GH; u += X.G) gla_prep_unit(X, args, u);
        dv_transpose(X);
        idx_prep(X);
        rope_qk(X);
    }
    }
    SEAM(3);
    if (IN(4)) {
    { LAUNDER();
        if (X.bid < 128) { const int xx = X.bid & 7, mm = X.bid >> 3; gla_scan_unit(X, (mm & 7) * 16 + xx + 8 * (mm >> 3)); }
        {
            unsigned* qctr = (unsigned*)(ws + WS_CTL) + 64;
            volatile LAS unsigned* qsh = (volatile LAS unsigned*)(X.lds + LDS_MISC);
            for (;;) {
                __syncthreads();
                if (X.tid == 0) qsh[0] = atomicAdd(qctr, 1u);
                __syncthreads();
                const unsigned uq = qsh[0];
                if (uq >= (unsigned)(BATCH * 128)) break;
                idx_topk_unit(X, (int)((uq & 3u) * 128u + (127u - (uq >> 2))));
            }
        }
    }
    }
    SEAM(4);
    if (IN(5)) {
    { LAUNDER();
        const int NU = BATCH * DH * 8;
        for (int i = 0; i * X.G < NU; ++i) {
            const int v = i * X.G + ((i & 1) ? (X.G - 1 - X.bid) : X.bid);
            if (v < NU) { const int qb = 7 - (v >> 6), bh = v & 63; dsa_attn_unit(X, bh >> 4, bh & 15, qb); }
        }
        oa_norm_rows(X, INP(X, I_GNG));
    }
    }
    SEAM(5);
    if (IN(6)) {
    { LAUNDER();
        pg8::Gemm g{(const bf16_t*)(ws + WS_H), (const bf16_t*)(ws + WS_WBGA), MTOK, DM, DM}; pg8::StaticOrder S; S.init(MTOK, DM, X.G, X.bid);
        pg8::EpiScaleF32 E{(float*)(ws + WS_TMP), (const bf16_t*)(ws + WS_SGA)};
        pg8::gemm_phase<pg8::EpiScaleF32, pg8::StaticOrder, true, true>(X.lds, g, S, E);
    }
    }
    SEAM(6);
    if (IN(7)) {
    { LAUNDER();
        pg8::Gemm g{(const bf16_t*)(ws + WS_OB), (const bf16_t*)(ws + WS_WBDSA), MTOK, DM, DM}; pg8::StaticOrder S; S.init(MTOK, DM, X.G, X.bid);
        pg8::EpiMerge E{(bf16_t*)(ws + WS_MERGED), (const float*)(ws + WS_TMP), (const bf16_t*)(ws + WS_SGB)};
        pg8::gemm_phase<pg8::EpiMerge, pg8::StaticOrder, true, true>(X.lds, g, S, E);
    }
    }
    SEAM(7);
    if (IN(8)) {
    { LAUNDER();
        pg8::Gemm g{(const bf16_t*)(ws + WS_MERGED), (const bf16_t*)(ws + WS_WMO), MTOK, DM, DM}; pg8::StaticOrder S; S.init(MTOK, DM, X.G, X.bid);
        pg8::EpiResid E{INP(X, I_X), (float*)(ws + WS_X1), mod + 2 * DM};
        pg8::gemm_phase<pg8::EpiResid, pg8::StaticOrder, true, true>(X.lds, g, S, E);
    }
    }
    SEAM(8);
    if (IN(9)) {
    { LAUNDER(); norm_mod_rows(X, (const float*)(ws + WS_X1), INP(X, I_N2G), mod, 3, 4, (bf16_t*)(ws + WS_H)); }
    }
    SEAM(9);
    if (IN(10)) {
    { LAUNDER();
        pg8::Gemm g{(const bf16_t*)(ws + WS_H), (const bf16_t*)(ws + WS_WGU), MTOK, 2 * DFF, DM}; pg8::StaticOrder S; S.init(MTOK, 2 * DFF, X.G, X.bid);
        pg8::EpiSwiglu E{(bf16_t*)(ws + WS_ACT)};
        pg8::gemm_phase<pg8::EpiSwiglu, pg8::StaticOrder, true, true>(X.lds, g, S, E);
    }
    }
    SEAM(10);
    if (IN(11)) {
    { LAUNDER();
        pg8::Gemm g{(const bf16_t*)(ws + WS_ACT), (const bf16_t*)(ws + WS_WDN), MTOK, DM, DFF}; pg8::StaticOrder S; S.init(MTOK, DM, X.G, X.bid);
        pg8::EpiResid E{(const float*)(ws + WS_X1), (float*)INP(X, 17), mod + 5 * DM};
        pg8::gemm_phase<pg8::EpiResid, pg8::StaticOrder, true, true>(X.lds, g, S, E);
    }
    }
    SEAM(11);
    if (IN(12)) {
    { LAUNDER(); final_norm_rows(X, (float*)INP(X, 17), INP(X, I_FNG)); }
    }
#ifdef STAMP_A
    {
        STAMP(12);
        __threadfence(); grid.sync();
        if (X.bid == 0 && X.tid == 0) {
            const unsigned long long* ts = (const unsigned long long*)(ws + WS_DBG);
            unsigned long long e1 = 0, e0 = 0, mn = ~0ull;
            for (int b = 0; b < X.G; ++b) { const unsigned long long v = __hip_atomic_load(ts + STAMP_A * 256 + b, __ATOMIC_RELAXED, __HIP_MEMORY_SCOPE_AGENT); if (v) { e1 = v > e1 ? v : e1; mn = v < mn ? v : mn; } }
            for (int b = 0; b < X.G; ++b) { const unsigned long long v = __hip_atomic_load(ts + STAMP_B * 256 + b, __ATOMIC_RELAXED, __HIP_MEMORY_SCOPE_AGENT); e0 = v > e0 ? v : e0; }
#if STAMP_MODE == 1
            e1 = mn;
#endif
            const unsigned long long dur = (e1 > e0) ? (e1 - e0) : 0ull;
            const unsigned long long t0 = __builtin_amdgcn_s_memrealtime();
            while (__builtin_amdgcn_s_memrealtime() - t0 < 4ull * dur) __builtin_amdgcn_s_sleep(8);
        }
    }
#endif
#undef IN
#undef SEAM
#undef mod
}


extern "C" void kernel_launch(void* const* d_in, const int* in_sizes, int n_in, void* d_out, int out_size, void* d_ws, size_t ws_size, hipStream_t stream) {
    static int grid = 0;
    if (grid == 0) {
        if (n_in != 17 || out_size != MTOK * DM || ws_size < WS_END) { fprintf(stderr, "kernel_launch: unexpected shapes (n_in %d out %d ws %zu need %zu)\n", n_in, out_size, ws_size, (size_t)WS_END); grid = -1; return; }
        int dev = 0, cus = 0, per_cu = 0;
        if (hipGetDevice(&dev) != hipSuccess || hipDeviceGetAttribute(&cus, hipDeviceAttributeMultiprocessorCount, dev) != hipSuccess) { grid = -1; return; }
        if (hipFuncSetAttribute((const void*)fwd_kernel, hipFuncAttributeMaxDynamicSharedMemorySize, LDS_BYTES) != hipSuccess) { grid = -1; return; }
        if (hipOccupancyMaxActiveBlocksPerMultiprocessor(&per_cu, (const void*)fwd_kernel, NT, LDS_BYTES) != hipSuccess || per_cu < 1) { fprintf(stderr, "kernel_launch: occupancy query says %d\n", per_cu); }
        (void)hipGetLastError();
        grid = cus;
    }
    if (grid < 0) return;
    (void)hipMemsetAsync((char*)d_ws + WS_CTL, 0, CTL_BYTES, stream);
    Args a{};
    for (int i = 0; i < 17; ++i) a.in[i] = (const float*)d_in[i];
    a.out = (float*)d_out; a.ws = (unsigned char*)d_ws; a.ph_lo = 0; a.ph_hi = (PH_STOP < NPHASE) ? PH_STOP : NPHASE;
    void* kargs[] = {&a};
    hipError_t e = hipLaunchCooperativeKernel((const void*)fwd_kernel, dim3(grid), dim3(NT), kargs, LDS_BYTES, stream);
    if (e != hipSuccess) fprintf(stderr, "kernel_launch: cooperative launch failed: %s (grid %d)\n", hipGetErrorString(e), grid);
#if DBG
    dbg_run(a, stream);
#endif
}
```

```cpp
#include <hip/hip_runtime.h>
#include <hip/hip_cooperative_groups.h>
#include <cstdio>
#include <cstdint>
namespace cg = cooperative_groups;

#ifndef DBG
#define DBG 0
#endif
#ifndef PH_STOP
#define PH_STOP 99
#endif

constexpr int BATCH = 4, SEQ = 2048, DM = 2048, MTOK = BATCH * SEQ;
constexpr int INW = 16984, INWP = 17152, DFF = 5632, NMOD = 6 * DM;
constexpr int GH = 4, GDK = 256, GDV = 512, GRANK = 16, NCH = SEQ / 64;
constexpr int DH = 16, DHD = 128, IH = 8, ID = 64, TOPK = 256;
constexpr int SMALLW = 768;
constexpr float RMS_EPS = 1e-6f;
constexpr int SRC_GQ = 0, SRC_GK = 1024, SRC_GV = 2048, SRC_GR = 4096, SRC_GLR = 6144, SRC_DQ = 6160, SRC_DK = 8208, SRC_DV = 10256,
              SRC_IQ = 12304, SRC_IK = 12816, SRC_IW = 12880, SRC_GA = 12888, SRC_GB = 14936;
enum { I_X = 0, I_C, I_POS, I_N1G, I_N2G, I_WADA, I_BADA, I_WIN, I_GUP, I_GBIAS, I_GNG, I_WBGA, I_WBDSA, I_WMO, I_WGU, I_WDN, I_FNG };

constexpr size_t MiB = 1u << 20;
constexpr size_t WS_CTL = 0, CTL_BYTES = 1 * MiB;
constexpr size_t WS_MOD = 65536;
constexpr size_t WS_DBG = 512 * 1024;
constexpr size_t WS_ROPED = 1 * MiB;
constexpr size_t WS_ROPEI = 2 * MiB;
constexpr size_t WS_IW = 2 * MiB + 512 * 1024;
constexpr size_t WS_GDEC = 3 * MiB;
constexpr size_t WS_MASK = 4 * MiB;
constexpr size_t WS_IK = 6 * MiB;
constexpr size_t WS_IQ = 7 * MiB;
constexpr size_t WS_ATTN = 15 * MiB;
constexpr size_t WS_WBGA = 20 * MiB, WS_WBDSA = 28 * MiB, WS_WMO = 36 * MiB, WS_WGU = 44 * MiB, WS_WDN = 88 * MiB;
constexpr size_t WS_WIN = 110 * MiB;
constexpr size_t WS_OA = 110 * MiB;
constexpr size_t WS_H = 177 * MiB;
constexpr size_t WS_QA = 209 * MiB, WS_KA = 225 * MiB;
constexpr size_t WS_VA = 241 * MiB;
constexpr size_t WS_RA = 273 * MiB;
constexpr size_t WS_DQ = 305 * MiB, WS_DK = 337 * MiB;
constexpr size_t WS_DV = 369 * MiB;
constexpr size_t WS_SGA = 401 * MiB, WS_SGB = 433 * MiB;
constexpr size_t WS_SMALL = 465 * MiB;
constexpr size_t WS_KTA = 489 * MiB;
constexpr size_t WS_MODP = 505 * MiB;
constexpr size_t WS_END = 512 * MiB;
constexpr size_t WS_OB = WS_QA;
constexpr size_t WS_TMP = WS_VA;
constexpr size_t WS_MERGED = WS_DQ;
constexpr size_t WS_X1 = WS_DK;
constexpr size_t WS_ACT = WS_QA;

#define LAS __attribute__((address_space(3)))
typedef unsigned short bf16_t;
typedef short bf16x8 __attribute__((ext_vector_type(8)));
typedef short bf16x4 __attribute__((ext_vector_type(4)));
typedef float f32x4 __attribute__((ext_vector_type(4)));
typedef float f32x16 __attribute__((ext_vector_type(16)));
typedef unsigned u32x4 __attribute__((ext_vector_type(4)));
typedef unsigned u32x2 __attribute__((ext_vector_type(2)));
constexpr int NT = 512, NW = 8;
constexpr int RING_BYTES = 131072;
constexpr int LDS_BYTES = 147456;

__device__ __forceinline__ float bf2f(unsigned v) { return __uint_as_float(v << 16); }
__device__ __forceinline__ unsigned f2bf(float f) { unsigned u = __float_as_uint(f); return (u + 0x7fffu + ((u >> 16) & 1u)) >> 16; }
__device__ __forceinline__ unsigned pk2(float lo, float hi) { return f2bf(lo) | (f2bf(hi) << 16); }
__device__ __forceinline__ float wave_sum(float v) {
#pragma unroll
    for (int o = 1; o < 64; o <<= 1) v += __shfl_xor(v, o);
    return v;
}
__device__ __forceinline__ float siluf(float v) { return v / (1.f + __expf(-v)); }
__device__ __forceinline__ float sigmf(float v) { return 1.f / (1.f + __expf(-v)); }
__device__ __forceinline__ int crow(int r, int hi) { return (r & 3) + 8 * (r >> 2) + 4 * hi; }

namespace pg8 {
#define PG8_LAS __attribute__((address_space(3)))
typedef unsigned short bf16_t;
typedef short bf16x8 __attribute__((ext_vector_type(8)));
typedef float f32x4 __attribute__((ext_vector_type(4)));
typedef unsigned u32x4 __attribute__((ext_vector_type(4)));
constexpr int BM = 256, BK = 64, HALF = 128, HTB = HALF * BK * 2  , STAGE_BYTES = 8 * HTB, NXCD = 8, WGM = 8;

__host__ __device__ __forceinline__ int lds_byte(int r, int c) { const int st = (r >> 4) * 2 + (c >> 5), rr = r & 15, cc = c & 31, ob = rr * 64 + cc * 2; return st * 1024 + (ob ^ (((ob >> 9) & 1) << 5)); }
__host__ __device__ __forceinline__ void stage_rc(int b, int& R, int& C) { const int st = b / 1024, sb = b % 1024, swz = sb ^ (((sb >> 9) & 1) << 5); R = (st >> 1) * 16 + swz / 64; C = (st & 1) * 32 + (swz % 64) / 2; }
__host__ __device__ __forceinline__ int perm32(int rho) { const int n = rho >> 4, i = rho & 15; return 8 * (i >> 2) + 4 * n + (i & 3); }

struct Unit { int pm, pn; };
struct Gemm { const bf16_t* A; const bf16_t* Bt; int M, N, K; };

struct StaticOrder {
    int nM, nN, nwg, G, c;
    __host__ __device__ void init(int M, int N, int G_, int c_) { nM = M / BM; nN = N / BM; nwg = nM * nN; G = G_; c = c_; }
    __host__ __device__ bool next(int i, Unit& u) const {
        const long L = (long)i * G + c; if (L >= nwg) return false;
        int wgid = (int)L; { const int q = nwg / NXCD, r = nwg % NXCD, xcd = wgid % NXCD, off = wgid / NXCD; wgid = (xcd < r ? xcd * (q + 1) : r * (q + 1) + (xcd - r) * q) + off; }
        const int nig = WGM * nN, gid = wgid / nig, fm = gid * WGM, gsz = (nM - fm) < WGM ? (nM - fm) : WGM;
        u.pm = fm + ((wgid % nig) % gsz); u.pn = (wgid % nig) / gsz; return true;
    }
    __device__ __forceinline__ void a_ready(const Unit&) const {}
    __device__ __forceinline__ void done(const Unit&) const {}
};


__device__ __forceinline__ unsigned cvt_pk_bf16(float lo, float hi) { unsigned r; asm volatile("v_cvt_pk_bf16_f32 %0, %1, %2" : "=v"(r) : "v"(lo), "v"(hi)); return r; }
__device__ __forceinline__ void store8bf(bf16_t* p, f32x4 v0, f32x4 v1) {
    u32x4 w; w.x = cvt_pk_bf16(v0[0], v0[1]); w.y = cvt_pk_bf16(v0[2], v0[3]); w.z = cvt_pk_bf16(v1[0], v1[1]); w.w = cvt_pk_bf16(v1[2], v1[3]); *(u32x4*)p = w;
}
__device__ __forceinline__ f32x4 silu4(f32x4 v) { f32x4 o; o[0] = v[0] / (1.f + __expf(-v[0])); o[1] = v[1] / (1.f + __expf(-v[1])); o[2] = v[2] / (1.f + __expf(-v[2])); o[3] = v[3] / (1.f + __expf(-v[3])); return o; }
__device__ __forceinline__ f32x4 sigm4(f32x4 v) { f32x4 o; o[0] = 1.f / (1.f + __expf(-v[0])); o[1] = 1.f / (1.f + __expf(-v[1])); o[2] = 1.f / (1.f + __expf(-v[2])); o[3] = 1.f / (1.f + __expf(-v[3])); return o; }
__device__ __forceinline__ f32x4 bf4_to_f32(u32x2 w) { f32x4 o; o[0] = __uint_as_float(w.x << 16); o[1] = __uint_as_float(w.x & 0xffff0000u); o[2] = __uint_as_float(w.y << 16); o[3] = __uint_as_float(w.y & 0xffff0000u); return o; }

struct EpiInProj {
    static constexpr bool PERM = true, AFTER_DRAIN = false;
    unsigned char* ws;
    __device__ __forceinline__ void operator()(const f32x4 (&acc)[2][2][4][2], const Unit& u, int wr, int wc, int fr, int fq) const {
        const int pn = u.pn, row0 = u.pm * BM + wr * 64 + fr, cl = wc * 32 + 8 * fq;
        if (pn >= 64) {
            float* base = (float*)(ws + WS_SMALL) + 256 * (pn - 64) + cl;
#pragma unroll
            for (int ai = 0; ai < 2; ++ai)
#pragma unroll
                for (int m = 0; m < 4; ++m) { const int r = row0 + ai * HALF + m * 16; float* rp = base + (size_t)r * SMALLW;
#pragma unroll
                    for (int bj = 0; bj < 2; ++bj) { *(f32x4*)(rp + bj * HALF) = acc[ai][bj][m][0]; *(f32x4*)(rp + bj * HALF + 4) = acc[ai][bj][m][1]; } asm volatile("" ::: "memory"); }
            return;
        }
        size_t wsoff; int A, B, C, E = HALF, op = 0;
        if (pn < 8) { wsoff = pn < 4 ? WS_QA : WS_KA; A = 4 * 64 * 256; B = 256; C = (pn & 3) * 64 * 256; }
        else if (pn < 16) { wsoff = WS_VA; A = 4 * 64 * 512; B = 512; C = ((pn - 8) >> 1) * 64 * 512 + 256 * ((pn - 8) & 1); }
        else if (pn < 24) { wsoff = WS_RA; A = 64 * DM; B = DM; C = 256 * (pn - 16); op = 1; }
        else if (pn < 40) { wsoff = pn < 32 ? WS_DQ : WS_DK; A = 64 * DM; B = DM; C = 256 * ((pn - 24) & 7); }
        else if (pn < 48) { wsoff = WS_DV; A = 16 * 64 * 128; B = 128; C = 2 * (pn - 40) * 64 * 128; E = 64 * 128; }
        else { wsoff = pn < 56 ? WS_SGA : WS_SGB; A = 64 * DM; B = DM; C = 256 * ((pn - 48) & 7); op = 2; }
        bf16_t* base = (bf16_t*)(ws + wsoff) + C + cl;
#pragma unroll
        for (int ai = 0; ai < 2; ++ai)
#pragma unroll
            for (int m = 0; m < 4; ++m) { const int r = row0 + ai * HALF + m * 16; bf16_t* rp = base + (size_t)(r >> 6) * A + (r & 63) * B;
#pragma unroll
                for (int bj = 0; bj < 2; ++bj) { f32x4 v0 = acc[ai][bj][m][0], v1 = acc[ai][bj][m][1];
                    if (op == 1) { v0 = silu4(v0); v1 = silu4(v1); }
                    else if (op == 2) { v0 = sigm4(v0); v1 = sigm4(v1); }
                    store8bf(rp + bj * E, v0, v1); }
                asm volatile("" ::: "memory"); }
    }
};

struct EpiScaleF32 {
    static constexpr bool PERM = false, AFTER_DRAIN = false;
    float* C; const bf16_t* G;
    __device__ __forceinline__ void operator()(const f32x4 (&acc)[2][2][4][2], const Unit& u, int wr, int wc, int fr, int fq) const {
        const int row0 = u.pm * BM + wr * 64 + fr, col0 = u.pn * BM + wc * 32 + 4 * fq;
#pragma unroll
        for (int ai = 0; ai < 2; ++ai)
#pragma unroll
            for (int m = 0; m < 4; ++m) { const size_t off = (size_t)(row0 + ai * HALF + m * 16) * DM + col0;
#pragma unroll
                for (int bj = 0; bj < 2; ++bj)
#pragma unroll
                    for (int n = 0; n < 2; ++n) { const f32x4 g = bf4_to_f32(*(const u32x2*)(G + off + bj * HALF + n * 16)); *(f32x4*)(C + off + bj * HALF + n * 16) = acc[ai][bj][m][n] * g; } }
    }
};
struct EpiMerge {
    static constexpr bool PERM = true, AFTER_DRAIN = false;
    bf16_t* O; const float* T; const bf16_t* G;
    __device__ __forceinline__ void operator()(const f32x4 (&acc)[2][2][4][2], const Unit& u, int wr, int wc, int fr, int fq) const {
        const int row0 = u.pm * BM + wr * 64 + fr, col0 = u.pn * BM + wc * 32 + 8 * fq;
#pragma unroll
        for (int ai = 0; ai < 2; ++ai)
#pragma unroll
            for (int m = 0; m < 4; ++m) { const size_t off = (size_t)(row0 + ai * HALF + m * 16) * DM + col0;
#pragma unroll
                for (int bj = 0; bj < 2; ++bj) { const u32x4 gw = *(const u32x4*)(G + off + bj * HALF);
                    const f32x4 g0 = bf4_to_f32((u32x2){gw.x, gw.y}), g1 = bf4_to_f32((u32x2){gw.z, gw.w});
                    const f32x4 t0 = *(const f32x4*)(T + off + bj * HALF), t1 = *(const f32x4*)(T + off + bj * HALF + 4);
                    store8bf(O + off + bj * HALF, t0 + acc[ai][bj][m][0] * g0, t1 + acc[ai][bj][m][1] * g1); } }
    }
};
struct EpiResid {
    static constexpr bool PERM = false, AFTER_DRAIN = false;
    const float* base; float* out; const float* gate;
    __device__ __forceinline__ void operator()(const f32x4 (&acc)[2][2][4][2], const Unit& u, int wr, int wc, int fr, int fq) const {
        const int row0 = u.pm * BM + wr * 64 + fr, col0 = u.pn * BM + wc * 32 + 4 * fq;
        const float* gb = gate + (size_t)((u.pm * BM) >> 11) * NMOD + col0;
        f32x4 gv[2][2];
#pragma unroll
        for (int bj = 0; bj < 2; ++bj)
#pragma unroll
            for (int n = 0; n < 2; ++n) gv[bj][n] = *(const f32x4*)(gb + bj * HALF + n * 16);
#pragma unroll
        for (int ai = 0; ai < 2; ++ai)
#pragma unroll
            for (int m = 0; m < 4; ++m) { const size_t off = (size_t)(row0 + ai * HALF + m * 16) * DM + col0;
#pragma unroll
                for (int bj = 0; bj < 2; ++bj)
#pragma unroll
                    for (int n = 0; n < 2; ++n) *(f32x4*)(out + off + bj * HALF + n * 16) = *(const f32x4*)(base + off + bj * HALF + n * 16) + gv[bj][n] * acc[ai][bj][m][n]; }
    }
};
struct EpiSwiglu {
    static constexpr bool PERM = true, AFTER_DRAIN = false;
    bf16_t* O;
    __device__ __forceinline__ void operator()(const f32x4 (&acc)[2][2][4][2], const Unit& u, int wr, int wc, int fr, int fq) const {
        const int row0 = u.pm * BM + wr * 64 + fr, col0 = u.pn * HALF + wc * 32 + 8 * fq;
#pragma unroll
        for (int ai = 0; ai < 2; ++ai)
#pragma unroll
            for (int m = 0; m < 4; ++m) { bf16_t* rp = O + (size_t)(row0 + ai * HALF + m * 16) * DFF + col0;
                store8bf(rp, silu4(acc[ai][0][m][0]) * acc[ai][1][m][0], silu4(acc[ai][0][m][1]) * acc[ai][1][m][1]); }
    }
};

template <class Epi, class Sched, bool ALIGN_EPI = false, bool SP2 = false>
__device__ __forceinline__ void gemm_phase(PG8_LAS unsigned char* lds, const Gemm g, const Sched& S, const Epi& E) {
    int tid_ = threadIdx.x; asm volatile("" : "+v"(tid_));
    const int tid = tid_, wid = __builtin_amdgcn_readfirstlane(tid >> 6), lane = tid & 63, wr = wid >> 2, wc = wid & 3, fr = lane & 15, fq = lane >> 4;
    const int K = g.K, nt = K / BK;
    unsigned voffA[2], voffB[2];
#pragma unroll
    for (int i = 0; i < 2; ++i) { int R, C; stage_rc(tid * 16 + i * 8192, R, C); const int Rb = Epi::PERM ? ((R & ~31) + perm32(R & 31)) : R;
        voffA[i] = (unsigned)(R * K + C) * 2u; voffB[i] = (unsigned)(Rb * K + C) * 2u; }
    const size_t kstep = (size_t)(BK * 2);
    const size_t hstep = (size_t)HALF * K * 2;
    const size_t tstep = 2 * hstep;
    const unsigned ldsw = (unsigned)wid * 1024u;
    const int aoff = lds_byte(wr * 64 + fr, fq * 8), boff = lds_byte(wc * 32 + fr, fq * 8);
#define PG8_SA(b, h) (((b) * 2 + (h)) * HTB)
#define PG8_SB(b, h) ((4 + (b) * 2 + (h)) * HTB)
#define PG8_STAGE(bufoff, gbase, voff) do { _Pragma("unroll") for (int _i = 0; _i < 2; ++_i) \
        __builtin_amdgcn_global_load_lds((const unsigned*)((const char*)(gbase) + (voff)[_i]), (PG8_LAS unsigned*)(lds + (bufoff) + ldsw + _i * 8192), 16, 0, 0); } while (0)
#define PG8_LDA(dst, b, h) do { _Pragma("unroll") for (int m = 0; m < 4; ++m) _Pragma("unroll") for (int k = 0; k < 2; ++k) dst[m][k] = *(const PG8_LAS bf16x8*)(lds + PG8_SA(b, h) + aoff + m * 2048 + k * 1024); } while (0)
#define PG8_LDB(dst, b, h) do { _Pragma("unroll") for (int n = 0; n < 2; ++n) _Pragma("unroll") for (int k = 0; k < 2; ++k) dst[n][k] = *(const PG8_LAS bf16x8*)(lds + PG8_SB(b, h) + boff + n * 2048 + k * 1024); } while (0)
#define PG8_MMA(ai, bj, At, Bt) do { __builtin_amdgcn_s_setprio(1); _Pragma("unroll") for (int m = 0; m < 4; ++m) _Pragma("unroll") for (int n = 0; n < 2; ++n) _Pragma("unroll") for (int k = 0; k < 2; ++k) \
        acc[ai][bj][m][n] = __builtin_amdgcn_mfma_f32_16x16x32_bf16(Bt[n][k], At[m][k], acc[ai][bj][m][n], 0, 0, 0); __builtin_amdgcn_s_setprio(0); } while (0)
#define PG8_WAIT_V(n) asm volatile("s_waitcnt vmcnt(" #n ")" ::: "memory")
#define PG8_WAIT_L(n) asm volatile("s_waitcnt lgkmcnt(" #n ")" ::: "memory")
#define PG8_BAR __builtin_amdgcn_s_barrier()
#define PG8_SCHED __builtin_amdgcn_sched_barrier(0)
    Unit cur, nxt; int ui = 0;
    if (!S.next(0, cur)) return;
    f32x4 acc[2][2][4][2];
#pragma unroll
    for (int a = 0; a < 2; ++a)
#pragma unroll
        for (int b = 0; b < 2; ++b)
#pragma unroll
            for (int m = 0; m < 4; ++m)
#pragma unroll
                for (int n = 0; n < 2; ++n) acc[a][b][m][n] = (f32x4){0.f, 0.f, 0.f, 0.f};
    bf16x8 At[4][2], B0[2][2], B1[2][2];
    const char* cA = (const char*)g.A + (size_t)cur.pm * tstep; const char* cB = (const char*)g.Bt + (size_t)cur.pn * tstep;
    S.a_ready(cur);
    if constexpr (SP2) {
        PG8_STAGE(PG8_SB(0, 0), cB, voffB); PG8_STAGE(PG8_SB(0, 1), cB + hstep, voffB); PG8_STAGE(PG8_SA(0, 0), cA, voffA); PG8_STAGE(PG8_SA(0, 1), cA + hstep, voffA);
        if (wr == 1) PG8_BAR;
        PG8_WAIT_V(2); PG8_BAR;
        PG8_STAGE(PG8_SB(1, 0), cB + kstep, voffB); PG8_STAGE(PG8_SA(1, 0), cA + kstep, voffA); PG8_STAGE(PG8_SB(1, 1), cB + hstep + kstep, voffB);
        PG8_WAIT_V(6); PG8_BAR;
    } else {
        PG8_STAGE(PG8_SB(0, 0), cB, voffB); PG8_STAGE(PG8_SA(0, 0), cA, voffA); PG8_STAGE(PG8_SB(0, 1), cB + hstep, voffB); PG8_STAGE(PG8_SA(0, 1), cA + hstep, voffA);
        if (wr == 1) PG8_BAR;
        PG8_WAIT_V(4); PG8_BAR;
        PG8_STAGE(PG8_SB(1, 0), cB + kstep, voffB); PG8_STAGE(PG8_SA(1, 0), cA + kstep, voffA); PG8_STAGE(PG8_SB(1, 1), cB + hstep + kstep, voffB);
        PG8_WAIT_V(6); PG8_BAR;
    }
    for (;;) {
        const bool has_next = S.next(ui + 1, nxt);
        const char* nA = has_next ? (const char*)g.A + (size_t)nxt.pm * tstep : cA; const char* nB = has_next ? (const char*)g.Bt + (size_t)nxt.pn * tstep : cB;
        for (int t = 0; t < nt; t += 2) {
            const bool last = (t == nt - 2);
            const char* a1 = cA + (size_t)(t + 1) * kstep;
            const char* a2 = last ? nA : cA + (size_t)(t + 2) * kstep; const char* b2 = last ? nB : cB + (size_t)(t + 2) * kstep;
            const char* a3 = a2 + kstep; const char* b3 = b2 + kstep;
            if (last && has_next) S.a_ready(nxt);
            if constexpr (SP2) {
            PG8_LDB(B0, 0, 0); PG8_LDB(B1, 0, 1); PG8_SCHED; PG8_LDA(At, 0, 0); PG8_STAGE(PG8_SA(1, 1), a1 + hstep, voffA);
            PG8_WAIT_V(8); PG8_WAIT_L(0); PG8_BAR; PG8_MMA(0, 0, At, B0); PG8_MMA(0, 1, At, B1); PG8_BAR; PG8_SCHED;
            PG8_LDA(At, 0, 1); PG8_STAGE(PG8_SB(0, 0), b2, voffB); PG8_STAGE(PG8_SB(0, 1), b2 + hstep, voffB); PG8_STAGE(PG8_SA(0, 0), a2, voffA);
            PG8_WAIT_V(8); PG8_WAIT_L(0); PG8_BAR; PG8_MMA(1, 0, At, B0); PG8_MMA(1, 1, At, B1); PG8_BAR; PG8_SCHED;
            PG8_LDB(B0, 1, 0); PG8_LDB(B1, 1, 1); PG8_SCHED; PG8_LDA(At, 1, 0); PG8_STAGE(PG8_SA(0, 1), a2 + hstep, voffA);
            PG8_WAIT_V(8); PG8_WAIT_L(0); PG8_BAR; PG8_MMA(0, 0, At, B0); PG8_MMA(0, 1, At, B1); PG8_BAR; PG8_SCHED;
            PG8_LDA(At, 1, 1); PG8_STAGE(PG8_SB(1, 0), b3, voffB); PG8_STAGE(PG8_SB(1, 1), b3 + hstep, voffB); PG8_STAGE(PG8_SA(1, 0), a3, voffA);
            PG8_WAIT_V(8); PG8_WAIT_L(0); PG8_BAR; PG8_MMA(1, 0, At, B0); PG8_MMA(1, 1, At, B1); PG8_BAR; PG8_SCHED;
            } else {
            PG8_LDB(B0, 0, 0); PG8_SCHED; PG8_LDA(At, 0, 0); PG8_STAGE(PG8_SA(1, 1), a1 + hstep, voffA);
            PG8_WAIT_L(8); PG8_BAR; PG8_WAIT_L(0); PG8_MMA(0, 0, At, B0); PG8_BAR; PG8_SCHED;
            PG8_LDB(B1, 0, 1); PG8_STAGE(PG8_SB(0, 0), b2, voffB);
            PG8_BAR; PG8_WAIT_L(0); PG8_MMA(0, 1, At, B1); PG8_BAR;
            PG8_LDA(At, 0, 1); PG8_STAGE(PG8_SA(0, 0), a2, voffA);
            PG8_BAR; PG8_WAIT_L(0); PG8_MMA(1, 0, At, B0); PG8_BAR; PG8_SCHED;
            PG8_STAGE(PG8_SB(0, 1), b2 + hstep, voffB);
            PG8_WAIT_V(6); PG8_BAR; PG8_MMA(1, 1, At, B1); PG8_BAR;
            PG8_LDB(B0, 1, 0); PG8_SCHED; PG8_LDA(At, 1, 0); PG8_STAGE(PG8_SA(0, 1), a2 + hstep, voffA);
            PG8_WAIT_L(8); PG8_BAR; PG8_WAIT_L(0); PG8_MMA(0, 0, At, B0); PG8_BAR; PG8_SCHED;
            PG8_LDB(B1, 1, 1); PG8_STAGE(PG8_SB(1, 0), b3, voffB);
            PG8_BAR; PG8_WAIT_L(0); PG8_MMA(0, 1, At, B1); PG8_BAR;
            PG8_LDA(At, 1, 1); PG8_STAGE(PG8_SA(1, 0), a3, voffA);
            PG8_BAR; PG8_WAIT_L(0); PG8_MMA(1, 0, At, B0); PG8_BAR; PG8_SCHED;
            PG8_STAGE(PG8_SB(1, 1), b3 + hstep, voffB);
            PG8_WAIT_V(6); PG8_BAR; PG8_MMA(1, 1, At, B1); PG8_BAR;
            }
        }
        if constexpr (ALIGN_EPI) { if (wr == 0) PG8_BAR; }
        if constexpr (!Epi::AFTER_DRAIN) { E(acc, cur, wr, wc, fr, fq); S.done(cur); }
        if (!has_next) break;
#pragma unroll
        for (int a = 0; a < 2; ++a)
#pragma unroll
            for (int b = 0; b < 2; ++b)
#pragma unroll
                for (int m = 0; m < 4; ++m)
#pragma unroll
                    for (int n = 0; n < 2; ++n) acc[a][b][m][n] = (f32x4){0.f, 0.f, 0.f, 0.f};
        cur = nxt; cA = nA; cB = nB; ++ui;
        if constexpr (ALIGN_EPI) { if (wr == 1) PG8_BAR; }
    }
    PG8_WAIT_V(0);
    if constexpr (!ALIGN_EPI) { if (wr == 0) PG8_BAR; }
    PG8_BAR;
    if constexpr (Epi::AFTER_DRAIN) { E.fused(acc, cur, wr, wc, fr, fq, lds, wid, lane); S.done(cur); }
#undef PG8_SA
#undef PG8_SB
#undef PG8_STAGE
#undef PG8_LDA
#undef PG8_LDB
#undef PG8_MMA
#undef PG8_WAIT_V
#undef PG8_WAIT_L
#undef PG8_BAR
#undef PG8_SCHED
}
}

#define XB_TMO      128
#define XB_XCNT(j)  (256  + 64 * (j))
#define XB_XSUB(j)  (1280 + 64 * (j))
#define XB_XGEN(j)  (2304 + 64 * (j))
#define XB_TOP      3328
#define XB_TOPGEN   3392
#define XCD_BAR_WORDS 3456
#define XB_SPIN_CAP (1u << 18)

__device__ __forceinline__ unsigned xb_ld(unsigned* p)              { return __hip_atomic_load(p, __ATOMIC_RELAXED, __HIP_MEMORY_SCOPE_AGENT); }
__device__ __forceinline__ unsigned xb_add(unsigned* p, unsigned v) { return __hip_atomic_fetch_add(p, v, __ATOMIC_RELAXED, __HIP_MEMORY_SCOPE_AGENT); }
__device__ __forceinline__ unsigned xb_xcc_id() { return (unsigned)__builtin_amdgcn_s_getreg((3 << 11) | 20) & 0xFu; }
#define XB_SPIN(cond, bar) do { unsigned _sp = 0; while (cond) { __builtin_amdgcn_s_sleep(1); \
    if ((++_sp & 255u) == 0u) { if (xb_ld(&(bar)[XB_TMO])) break; if (_sp > XB_SPIN_CAP) { atomicAdd(&(bar)[XB_TMO], 1u); break; } } } } while (0)

struct XcdBarrier {
    unsigned* bar; unsigned x;
    volatile LAS unsigned* st;
};

__device__ __forceinline__ XcdBarrier xcd_barrier_post(unsigned* bar, volatile LAS unsigned* st) {
    XcdBarrier b; b.bar = bar; b.x = xb_xcc_id(); b.st = st;
    if (threadIdx.x == 0) (void)xb_add(&bar[XB_XCNT(b.x)], 1u);
    return b;
}
__device__ __forceinline__ void xcd_barrier_complete(unsigned* bar, unsigned x, unsigned& nloc, unsigned& nx) {
    const unsigned G = gridDim.x * gridDim.y * gridDim.z;
    unsigned sum, cnt, mine, sp = 0u;
    for (;;) {
        sum = 0u; cnt = 0u; mine = 0u;
#pragma unroll
        for (unsigned j = 0; j < 16; ++j) { const unsigned c = xb_ld(&bar[XB_XCNT(j)]); sum += c; cnt += (c > 0u) ? 1u : 0u; mine = (j == x) ? c : mine; }
        if (sum == G) break;
        __builtin_amdgcn_s_sleep(1);
        if ((++sp & 255u) == 0u) { if (xb_ld(&bar[XB_TMO])) break; if (sp > XB_SPIN_CAP) { atomicAdd(&bar[XB_TMO], 1u); break; } }
    }
    nloc = mine > 0u ? mine : 1u; nx = cnt > 0u ? cnt : 1u;
}

__device__ __forceinline__ void xcd_barrier(const XcdBarrier& b) {
    asm volatile("s_waitcnt vmcnt(0)" ::: "memory");
    __syncthreads();
    if (threadIdx.x == 0) {
        unsigned* bar = b.bar;
        __builtin_amdgcn_s_waitcnt(0);
        unsigned nloc = b.st[0], nx = b.st[1];
        if (nloc == 0u) { xcd_barrier_complete(bar, b.x, nloc, nx); b.st[0] = nloc; b.st[1] = nx; }
        const unsigned old = xb_add(&bar[XB_XSUB(b.x)], 1u);
        const unsigned gen = old / nloc;
        if (old + 1u == (gen + 1u) * nloc) {
            __builtin_amdgcn_fence(__ATOMIC_RELEASE, "agent");
            asm volatile("s_waitcnt vmcnt(0)" ::: "memory");
            const unsigned og = xb_add(&bar[XB_TOP], 1u);
            const unsigned tg = og / nx;
            if (og + 1u == (tg + 1u) * nx) xb_add(&bar[XB_TOPGEN], 1u);
            else XB_SPIN(xb_ld(&bar[XB_TOPGEN]) == tg, bar);
            __builtin_amdgcn_fence(__ATOMIC_ACQUIRE, "agent");
            xb_add(&bar[XB_XGEN(b.x)], 1u);
            asm volatile("s_waitcnt vmcnt(0)" ::: "memory");
        } else {
            XB_SPIN(xb_ld(&bar[XB_XGEN(b.x)]) == gen, bar);
            __builtin_amdgcn_fence(__ATOMIC_ACQUIRE, "agent");
            asm volatile("s_waitcnt vmcnt(0)" ::: "memory");
        }
    }
    __syncthreads();
}


struct Args { const float* in[17]; float* out; unsigned char* ws; int ph_lo, ph_hi; };

struct Ctx { LAS unsigned char* lds; unsigned char* ws; int tid, lane, wave, bid, G; };

#define LDS_WAIT() asm volatile("s_waitcnt lgkmcnt(0)" ::: "memory")
constexpr int LDS_PTAB = 147200;
__device__ __forceinline__ const float* INP(const Ctx& X, int i) {
    const volatile LAS unsigned* t = (const volatile LAS unsigned*)(X.lds + LDS_PTAB) + 2 * i;
    const unsigned lo = __builtin_amdgcn_readfirstlane(t[0]), hi = __builtin_amdgcn_readfirstlane(t[1]);
    return (const float*)(((unsigned long long)hi << 32) | lo);
}
#ifdef STAMP_A
#define STAMP(k) do { if (X.tid == 0) ((unsigned long long*)(X.ws + WS_DBG))[(k) * 256 + X.bid] = __builtin_amdgcn_s_memrealtime(); } while (0)
#else
#define STAMP(k) do { } while (0)
#endif
#define MFMA32(a, b, c) __builtin_amdgcn_mfma_f32_32x32x16_bf16((a), (b), (c), 0, 0, 0)
#define MFMA16(a, b, c) __builtin_amdgcn_mfma_f32_16x16x32_bf16((a), (b), (c), 0, 0, 0)

__device__ __forceinline__ int map_win(int n) {
    if (n < 1024) return SRC_GQ + n;
    if (n < 2048) return SRC_GK + (n - 1024);
    if (n < 4096) return SRC_GV + (n - 2048);
    if (n < 6144) return SRC_GR + (n - 4096);
    if (n < 8192) return SRC_DQ + (n - 6144);
    if (n < 10240) return SRC_DK + (n - 8192);
    if (n < 12288) return SRC_DV + (n - 10240);
    if (n < 14336) return SRC_GA + (n - 12288);
    if (n < 16384) return SRC_GB + (n - 14336);
    if (n < 16896) return SRC_IQ + (n - 16384);
    n -= 16896;
    if (n < 16) return SRC_GLR + n;
    if (n < 80) return SRC_IK + (n - 16);
    if (n < 88) return SRC_IW + (n - 80);
    return -1;
}
__device__ __forceinline__ int map_wgu(int n) { const int j = n >> 8, rr = n & 255; return rr < 128 ? 128 * j + rr : DFF + 128 * j + (rr - 128); }

__device__ __forceinline__ void transpose_item(const float* W, int N, bf16_t* WT, int K, LAS float* scr, int kb, int nb, int lane, int src) {
    const int k0 = 64 * kb, n0 = 32 * nb;
    const float* wp = W + (size_t)(k0 + (lane >> 5)) * N + (src >= 0 ? src : 0);
    float v[32];
#pragma unroll
    for (int i = 0; i < 32; ++i) v[i] = (src >= 0) ? wp[(size_t)(2 * i) * N] : 0.f;
#pragma unroll
    for (int i = 0; i < 32; ++i) scr[(2 * i + (lane >> 5)) * 33 + (lane & 31)] = v[i];
    LDS_WAIT();
    const int c = lane & 7;
#pragma unroll
    for (int j = 0; j < 4; ++j) { const int n = (lane >> 3) + 8 * j; const LAS float* s = scr + (8 * c) * 33 + n;
        u32x4 o; o.x = pk2(s[0 * 33], s[1 * 33]); o.y = pk2(s[2 * 33], s[3 * 33]); o.z = pk2(s[4 * 33], s[5 * 33]); o.w = pk2(s[6 * 33], s[7 * 33]);
        *(u32x4*)(WT + (size_t)(n0 + n) * K + k0 + 8 * c) = o; }
    LDS_WAIT();
}

#define TR_ISSUE(v_, W_, N_, kb_, src_) do { const float* wp_ = (W_) + (size_t)(64 * (kb_) + (lane >> 5)) * (N_) + ((src_) >= 0 ? (src_) : 0); \
        _Pragma("unroll") for (int i_ = 0; i_ < 32; ++i_) v_[i_] = ((src_) >= 0) ? __builtin_nontemporal_load(wp_ + (size_t)(2 * i_) * (N_)) : 0.f; } while (0)
#define TR_FINISH(v_, WT_, K_, kb_, nb_) do { \
        _Pragma("unroll") for (int i_ = 0; i_ < 32; ++i_) scr[(2 * i_ + (lane >> 5)) * 33 + (lane & 31)] = v_[i_]; \
        LDS_WAIT(); const int c_ = lane & 7; \
        _Pragma("unroll") for (int j_ = 0; j_ < 4; ++j_) { const int n_ = (lane >> 3) + 8 * j_; const LAS float* s_ = scr + (8 * c_) * 33 + n_; \
            u32x4 o_; o_.x = pk2(s_[0 * 33], s_[1 * 33]); o_.y = pk2(s_[2 * 33], s_[3 * 33]); o_.z = pk2(s_[4 * 33], s_[5 * 33]); o_.w = pk2(s_[6 * 33], s_[7 * 33]); \
            *(u32x4*)((WT_) + (size_t)(32 * (nb_) + n_) * (K_) + 64 * (kb_) + 8 * c_) = o_; } \
        LDS_WAIT(); } while (0)

struct TrItem { const float* W; bf16_t* WT; int N, K, kb, nb, src; };
__device__ __forceinline__ TrItem tr_decode(const Ctx& X, int it, int l31) {
    constexpr int I_IN = 32 * (INWP / 32), I_SQ = 32 * 64, I_GU = 32 * (2 * DFF / 32);
    unsigned char* ws = X.ws; TrItem t; int r = it;
    if (r < I_IN) { const int nbk = INWP / 32; t.kb = r / nbk; t.nb = r % nbk; t.W = INP(X, I_WIN); t.N = INW; t.WT = (bf16_t*)(ws + WS_WIN); t.K = DM; t.src = map_win(32 * t.nb + l31); return t; } r -= I_IN;
    if (r < 3 * I_SQ) { const int q = r / I_SQ; r -= q * I_SQ; t.kb = r / 64; t.nb = r % 64; t.W = INP(X, q == 0 ? I_WBGA : (q == 1 ? I_WBDSA : I_WMO)); t.N = DM; t.WT = (bf16_t*)(ws + (q == 0 ? WS_WBGA : (q == 1 ? WS_WBDSA : WS_WMO))); t.K = DM; t.src = 32 * t.nb + l31; return t; } r -= 3 * I_SQ;
    if (r < I_GU) { const int nbk = 2 * DFF / 32; t.kb = r / nbk; t.nb = r % nbk; t.W = INP(X, I_WGU); t.N = 2 * DFF; t.WT = (bf16_t*)(ws + WS_WGU); t.K = DM; t.src = map_wgu(32 * t.nb + l31); return t; } r -= I_GU;
    t.kb = r / 64; t.nb = r % 64; t.W = INP(X, I_WDN); t.N = DM; t.WT = (bf16_t*)(ws + WS_WDN); t.K = DFF; t.src = 32 * t.nb + l31; return t;
}

template <bool DO_MOD>
__device__ __forceinline__ void p0_prologue(const Ctx& X) {
    unsigned char* ws = X.ws; const int lane = X.lane;
    const int gw = X.bid * NW + X.wave, NGW = X.G * NW;
    constexpr int NGV = 32 * 48;
    if (DO_MOD) for (int it = gw; it < NGV; it += NGW) {
        const int kc = it / 48, cb = it % 48, k0 = 64 * kc, col = cb * 256 + 4 * lane;
        const float* wada = INP(X, I_WADA); const float* cvec = INP(X, I_C);
        float scb[4];
#pragma unroll
        for (int b = 0; b < 4; ++b) scb[b] = siluf(cvec[b * DM + k0 + lane]);
        f32x4 acc[4];
#pragma unroll
        for (int b = 0; b < 4; ++b) acc[b] = (f32x4){0.f, 0.f, 0.f, 0.f};
#pragma unroll
        for (int hb = 0; hb < 4; ++hb) {
            f32x4 w[16];
#pragma unroll
            for (int kk = 0; kk < 16; ++kk) w[kk] = __builtin_nontemporal_load((const f32x4*)(wada + (size_t)(k0 + 16 * hb + kk) * NMOD + col));
#pragma unroll
            for (int kk = 0; kk < 16; ++kk)
#pragma unroll
                for (int b = 0; b < 4; ++b) acc[b] += w[kk] * __builtin_bit_cast(float, __builtin_amdgcn_readlane(__builtin_bit_cast(int, scb[b]), 16 * hb + kk));
            asm volatile("" ::: "memory");
        }
        float* part = (float*)(ws + WS_MODP);
#pragma unroll
        for (int b = 0; b < 4; ++b) *(f32x4*)(part + ((size_t)kc * 4 + b) * NMOD + col) = acc[b];
    }
    STAMP(14);
    {
        const int* pos = (const int*)INP(X, I_POS);
        float2* rd = (float2*)(ws + WS_ROPED); float2* ri = (float2*)(ws + WS_ROPEI);
        for (int i = X.bid * NT + X.tid; i < MTOK * 24; i += X.G * NT) {
            int m, j; float ex; float2* dst;
            if (i < MTOK * 16) { m = i >> 4; j = i & 15; ex = (float)j * (1.0f / 16.0f); dst = rd + i; }
            else { const int i2 = i - MTOK * 16; m = i2 >> 3; j = i2 & 7; ex = (float)j * (1.0f / 8.0f); dst = ri + i2; }
            const float inv = exp2f(-ex * 18.931568569324174f);
            const float ang = (float)pos[m] * inv;
            double r = (double)ang * 0.15915494309189535; r -= rint(r);
            const float ar = (float)(r * 6.283185307179586);
            *dst = make_float2(__cosf(ar), __sinf(ar));
        }
    }
    STAMP(15);
    {
        LAS float* scr = (LAS float*)(X.lds + 1024 + X.wave * 8704);
        constexpr int NITEMS = 32 * (INWP / 32) + 3 * 32 * 64 + 32 * (2 * DFF / 32) + (DFF / 64) * 64;
        const int nx = (NGW > NGV) ? (NGW - NGV) : 0, NEXTRA = (DO_MOD && 8 * nx < NITEMS) ? 8 * nx : 0;
        const int nmine_x = (DO_MOD && gw >= NGV && NEXTRA) ? 8 : 0;
        auto item_of = [&](int k) -> int { if (k < nmine_x) return (gw - NGV) * 8 + k; const int it = NEXTRA + gw + (k - nmine_x) * NGW; return it < NITEMS ? it : -1; };
        float va[32], vb[32];
        int k = 0, ia = item_of(0);
        TrItem A, B; A.kb = 0; B.kb = 0;
        if (ia >= 0) { A = tr_decode(X, ia, lane & 31); TR_ISSUE(va, A.W, A.N, A.kb, A.src); }
        while (ia >= 0) {
            const int ib = item_of(k + 1);
            if (ib >= 0) { B = tr_decode(X, ib, lane & 31); TR_ISSUE(vb, B.W, B.N, B.kb, B.src); }
            TR_FINISH(va, A.WT, A.K, A.kb, A.nb);
            if (ib < 0) break;
            const int ic = item_of(k + 2);
            if (ic >= 0) { A = tr_decode(X, ic, lane & 31); TR_ISSUE(va, A.W, A.N, A.kb, A.src); }
            TR_FINISH(vb, B.WT, B.K, B.kb, B.nb);
            ia = ic; k += 2;
        }
    }
}

__device__ __forceinline__ void norm_mod_rows(const Ctx& X, const float* x, const float* gain, const float* mod, int i_sh, int i_sc, bf16_t* out) {
    const int gw = X.bid * NW + X.wave, NGW = X.G * NW;
    for (int row = gw; row < MTOK; row += NGW) {
        const int b = row >> 11;
        const f32x4* xr = (const f32x4*)(x + (size_t)row * DM) + X.lane;
        f32x4 v[8]; float s = 0.f;
#pragma unroll
        for (int j = 0; j < 8; ++j) { v[j] = xr[64 * j]; s += (v[j][0] * v[j][0] + v[j][1] * v[j][1]) + (v[j][2] * v[j][2] + v[j][3] * v[j][3]); }
        const float rs = rsqrtf(wave_sum(s) * (1.f / DM) + RMS_EPS);
        const f32x4* g4 = (const f32x4*)gain + X.lane;
        const f32x4* sh4 = (const f32x4*)(mod + (size_t)b * NMOD + i_sh * DM) + X.lane;
        const f32x4* sc4 = (const f32x4*)(mod + (size_t)b * NMOD + i_sc * DM) + X.lane;
        u32x2* o8 = (u32x2*)(out + (size_t)row * DM) + X.lane;
#pragma unroll
        for (int j = 0; j < 8; ++j) { const f32x4 y = v[j] * rs * g4[64 * j] * (sc4[64 * j] + 1.f) + sh4[64 * j]; u32x2 w; w.x = pk2(y[0], y[1]); w.y = pk2(y[2], y[3]); o8[64 * j] = w; }
    }
}
__device__ __forceinline__ void norm1_rows(const Ctx& X, const float* x, const float* gain, const float* bada, float* mod, bf16_t* out) {
    const float* part = (const float*)(X.ws + WS_MODP);
    for (int o = X.bid * NT + X.tid; o < 4 * NMOD; o += X.G * NT) { const int bb = o / NMOD, n = o % NMOD; float t = bada[n];
#pragma unroll
        for (int kc = 0; kc < 32; ++kc) t += part[((size_t)kc * 4 + bb) * NMOD + n];
        mod[o] = t; }
    const int nbp = X.G >> 2, b = (X.bid / nbp) < 3 ? (X.bid / nbp) : 3, lb = X.bid - b * nbp, nbb = (b == 3) ? (X.G - 3 * nbp) : nbp;
    LAS float* shs = (LAS float*)X.lds;
    for (int n = X.tid; n < 2 * DM; n += NT) { float t = bada[n];
#pragma unroll
        for (int kc = 0; kc < 32; ++kc) t += part[((size_t)kc * 4 + b) * NMOD + n];
        shs[n] = t; }
    __syncthreads();
    for (int rl = lb * NW + X.wave; rl < SEQ; rl += nbb * NW) {
        const int row = b * SEQ + rl;
        const f32x4* xr = (const f32x4*)(x + (size_t)row * DM) + X.lane;
        f32x4 v[8]; float s = 0.f;
#pragma unroll
        for (int j = 0; j < 8; ++j) { v[j] = xr[64 * j]; s += (v[j][0] * v[j][0] + v[j][1] * v[j][1]) + (v[j][2] * v[j][2] + v[j][3] * v[j][3]); }
        const float rs = rsqrtf(wave_sum(s) * (1.f / DM) + RMS_EPS);
        const f32x4* g4 = (const f32x4*)gain + X.lane;
        u32x2* o8 = (u32x2*)(out + (size_t)row * DM) + X.lane;
#pragma unroll
        for (int j = 0; j < 8; ++j) { const f32x4 sh = *(const LAS f32x4*)(shs + 4 * (X.lane + 64 * j)), sc = *(const LAS f32x4*)(shs + DM + 4 * (X.lane + 64 * j));
            const f32x4 y = v[j] * rs * g4[64 * j] * (sc + 1.f) + sh; u32x2 w; w.x = pk2(y[0], y[1]); w.y = pk2(y[2], y[3]); o8[64 * j] = w; }
    }
    __syncthreads();
}
__device__ __forceinline__ void final_norm_rows(const Ctx& X, float* x, const float* gain) {
    const int gw = X.bid * NW + X.wave, NGW = X.G * NW;
    for (int row = gw; row < MTOK; row += NGW) {
        f32x4* xr = (f32x4*)(x + (size_t)row * DM) + X.lane;
        f32x4 v[8]; float s = 0.f;
#pragma unroll
        for (int j = 0; j < 8; ++j) { v[j] = xr[64 * j]; s += (v[j][0] * v[j][0] + v[j][1] * v[j][1]) + (v[j][2] * v[j][2] + v[j][3] * v[j][3]); }
        const float rs = rsqrtf(wave_sum(s) * (1.f / DM) + RMS_EPS);
        const f32x4* g4 = (const f32x4*)gain + X.lane;
#pragma unroll
        for (int j = 0; j < 8; ++j) xr[64 * j] = v[j] * rs * g4[64 * j];
    }
}

__device__ __forceinline__ float log_sigmoid_f(float z) { return fminf(z, 0.f) - __logf(1.f + __expf(-fabsf(z))); }

__device__ __forceinline__ void gla_prep_unit(const Ctx& X, const Args& a, int u) {
    unsigned char* ws = X.ws; const int tid = X.tid, lane = X.lane, wave = X.wave;
    LAS bf16_t* qs = (LAS bf16_t*)X.lds;
    LAS bf16_t* ks = (LAS bf16_t*)(X.lds + 33792);
    LAS float* glr = (LAS float*)(X.lds + 67584);
    LAS float* tot = (LAS float*)(X.lds + 71680);
    const int h = u & 3, row0 = (u >> 2) * 64;
    bf16_t* qblk = (bf16_t*)(ws + WS_QA) + (size_t)u * 64 * 256;
    bf16_t* kblk = (bf16_t*)(ws + WS_KA) + (size_t)u * 64 * 256;
    const float* small = (const float*)(ws + WS_SMALL);
    for (int i = tid; i < 1024; i += NT) glr[i] = small[(size_t)(row0 + (i >> 4)) * SMALLW + 512 + (i & 15)];
#pragma unroll
    for (int i = 0; i < 4; ++i) { const int id = tid + NT * i, t = id >> 5, c16 = id & 31;
        *(LAS u32x4*)(qs + t * 264 + 8 * c16) = *(const u32x4*)(qblk + t * 256 + 8 * c16); *(LAS u32x4*)(ks + t * 264 + 8 * c16) = *(const u32x4*)(kblk + t * 256 + 8 * c16); }
    const int d = tid & 255, half = tid >> 8;
    float up[16];
#pragma unroll
    for (int r = 0; r < 16; ++r) up[r] = INP(X, I_GUP)[r * 1024 + h * 256 + d];
    const float bias = INP(X, I_GBIAS)[h * 256 + d];
    __syncthreads();
    float lg[32]; float tsum = 0.f;
#pragma unroll
    for (int tt = 0; tt < 32; ++tt) { const int t = 32 * half + tt; float z = bias;
        const LAS f32x4* gp = (const LAS f32x4*)(glr + t * 16);
#pragma unroll
        for (int r4 = 0; r4 < 4; ++r4) { const f32x4 g4 = gp[r4]; z += g4[0] * up[4 * r4] + g4[1] * up[4 * r4 + 1] + g4[2] * up[4 * r4 + 2] + g4[3] * up[4 * r4 + 3]; }
        tsum += log_sigmoid_f(z) * 0.0625f; lg[tt] = tsum; }
    if (half == 0) tot[d] = tsum;
    __syncthreads();
    const float cum0 = half ? tot[d] : 0.f; float cum = cum0;
#pragma unroll
    for (int tt = 0; tt < 32; ++tt) { const int t = 32 * half + tt; cum = cum0 + lg[tt];
        const float qv = bf2f(qs[t * 264 + d]), kv = bf2f(ks[t * 264 + d]); const float e = __expf(cum);
        qs[t * 264 + d] = (bf16_t)f2bf(qv * e * 0.0625f); ks[t * 264 + d] = (bf16_t)f2bf(kv * __frcp_rn(e)); }
    if (half == 1) ((float*)(ws + WS_GDEC))[(size_t)u * 256 + d] = expf(cum);
    __syncthreads();
#pragma unroll
    for (int i = 0; i < 4; ++i) { const int id = tid + NT * i, t = id >> 5, c16 = id & 31; *(u32x4*)(qblk + t * 256 + 8 * c16) = *(const LAS u32x4*)(qs + t * 264 + 8 * c16); }
    {
        u32x4* dst = (u32x4*)(kblk + d * 64 + 32 * half);
#pragma unroll
        for (int i = 0; i < 4; ++i) { unsigned e[8];
#pragma unroll
            for (int k = 0; k < 8; ++k) e[k] = ks[(32 * half + 8 * i + k) * 264 + d];
            dst[i] = (u32x4){e[0] | (e[1] << 16), e[2] | (e[3] << 16), e[4] | (e[5] << 16), e[6] | (e[7] << 16)}; }
    }
    if (wave < 4) {
        const int ti = wave >> 1, tj = wave & 1, r32 = lane & 31, hi = lane >> 5;
        f32x16 acc;
#pragma unroll
        for (int r = 0; r < 16; ++r) acc[r] = 0.f;
#pragma unroll
        for (int s = 0; s < 16; ++s) { const bf16x8 af = *(const LAS bf16x8*)(qs + (32 * ti + r32) * 264 + 16 * s + 8 * hi); const bf16x8 bf = *(const LAS bf16x8*)(ks + (32 * tj + r32) * 264 + 16 * s + 8 * hi); acc = MFMA32(af, bf, acc); }
        bf16_t* at = (bf16_t*)(ws + WS_ATTN) + (size_t)u * 4096;
#pragma unroll
        for (int r = 0; r < 16; ++r) { const int i = 32 * ti + crow(r, hi), j = 32 * tj + r32; at[i * 64 + j] = (bf16_t)f2bf(j <= i ? acc[r] : 0.f); }
    }
    __syncthreads();
    {
        LAS bf16_t* vs = (LAS bf16_t*)X.lds;
        bf16_t* vblk = (bf16_t*)(ws + WS_VA) + (size_t)u * 64 * 512;
#pragma unroll
        for (int i = 0; i < 8; ++i) { const int id = tid + NT * i, t = id >> 6, c16 = id & 63; *(LAS u32x4*)(vs + t * 520 + 8 * c16) = *(const u32x4*)(vblk + t * 512 + 8 * c16); }
        __syncthreads();
#pragma unroll
        for (int i = 0; i < 8; ++i) { const int id = tid + NT * i, tq = id & 7, dv = id >> 3; unsigned e[8];
#pragma unroll
            for (int k = 0; k < 8; ++k) e[k] = vs[(8 * tq + k) * 520 + dv];
            *(u32x4*)(vblk + dv * 64 + 8 * tq) = (u32x4){e[0] | (e[1] << 16), e[2] | (e[3] << 16), e[4] | (e[5] << 16), e[6] | (e[7] << 16)}; }
    }
    __syncthreads();
}

__device__ __forceinline__ void dv_transpose(const Ctx& X) {
    LAS bf16_t* scr = (LAS bf16_t*)(X.lds + X.wave * 17408);
    const int gw = X.bid * NW + X.wave, NGW = X.G * NW, lane = X.lane;
    for (int blk = gw; blk < BATCH * NCH * DH; blk += NGW) {
        bf16_t* p = (bf16_t*)(X.ws + WS_DV) + (size_t)blk * 64 * 128;
#pragma unroll
        for (int i = 0; i < 16; ++i) { const int id = lane + 64 * i, t = id >> 4, c16 = id & 15; *(LAS u32x4*)(scr + t * 136 + 8 * c16) = *(const u32x4*)(p + t * 128 + 8 * c16); }
        LDS_WAIT();
#pragma unroll
        for (int i = 0; i < 16; ++i) { const int id = lane + 64 * i, kq = id & 7, dd = id >> 3; unsigned e[8];
#pragma unroll
            for (int k = 0; k < 8; ++k) e[k] = scr[(8 * kq + k) * 136 + dd];
            *(u32x4*)(p + dd * 64 + 8 * kq) = (u32x4){e[0] | (e[1] << 16), e[2] | (e[3] << 16), e[4] | (e[5] << 16), e[6] | (e[7] << 16)}; }
        LDS_WAIT();
    }
}

__device__ __forceinline__ void idx_prep(const Ctx& X) {
    const int gw = X.bid * NW + X.wave, NGW = X.G * NW, lane = X.lane;
    const float* small = (const float*)(X.ws + WS_SMALL);
    const float2* ri = (const float2*)(X.ws + WS_ROPEI);
    for (int m = gw; m < MTOK; m += NGW) {
        const float* sr = small + (size_t)m * SMALLW;
        float2 cs[8];
#pragma unroll
        for (int e = 0; e < 8; ++e) cs[e] = ri[(size_t)m * 8 + e];
        {
            const int seg = lane & 7; float v[8];
            const f32x4 a0 = *(const f32x4*)(sr + 8 * lane), a1 = *(const f32x4*)(sr + 8 * lane + 4);
            v[0] = a0[0]; v[1] = a0[1]; v[2] = a0[2]; v[3] = a0[3]; v[4] = a1[0]; v[5] = a1[1]; v[6] = a1[2]; v[7] = a1[3];
#pragma unroll
            for (int e = 0; e < 8; ++e) { const float p = __shfl_xor(v[e], 1); if (seg == 0) v[e] = v[e] * cs[e].x - p * cs[e].y; else if (seg == 1) v[e] = p * cs[e].y + v[e] * cs[e].x; }
            *(u32x4*)((bf16_t*)(X.ws + WS_IQ) + (size_t)m * 512 + 8 * lane) = (u32x4){pk2(v[0], v[1]), pk2(v[2], v[3]), pk2(v[4], v[5]), pk2(v[6], v[7])};
        }
        {
            const int l7 = lane & 7; float v[8];
            const f32x4 a0 = *(const f32x4*)(sr + 528 + 8 * l7), a1 = *(const f32x4*)(sr + 528 + 8 * l7 + 4);
            v[0] = a0[0]; v[1] = a0[1]; v[2] = a0[2]; v[3] = a0[3]; v[4] = a1[0]; v[5] = a1[1]; v[6] = a1[2]; v[7] = a1[3];
#pragma unroll
            for (int e = 0; e < 8; ++e) { const float p = __shfl_xor(v[e], 1); if (l7 == 0) v[e] = v[e] * cs[e].x - p * cs[e].y; else if (l7 == 1) v[e] = p * cs[e].y + v[e] * cs[e].x; }
            if (lane < 8) *(u32x4*)((bf16_t*)(X.ws + WS_IK) + (size_t)m * 64 + 8 * lane) = (u32x4){pk2(v[0], v[1]), pk2(v[2], v[3]), pk2(v[4], v[5]), pk2(v[6], v[7])};
            if (lane < 8) ((float*)(X.ws + WS_IW))[(size_t)m * 8 + lane] = sr[592 + lane] * 0.044194173824159216f;
        }
    }
}

__device__ __forceinline__ void rope_qk(const Ctx& X) {
    const int gw = X.bid * NW + X.wave, NGW = X.G * NW, lane = X.lane, seg = lane & 3;
    const float sg = (seg < 2) ? -1.f : 1.f;
    for (int m = gw; m < MTOK; m += NGW) {
        const f32x4* cs = (const f32x4*)((const float2*)(X.ws + WS_ROPED) + (size_t)m * 16 + 8 * (seg & 1));
        const f32x4 c01 = cs[0], c23 = cs[1], c45 = cs[2], c67 = cs[3];
#pragma unroll
        for (int which = 0; which < 2; ++which) {
            bf16_t* p = (bf16_t*)(X.ws + (which ? WS_DK : WS_DQ)) + (size_t)m * DM + (lane >> 2) * DHD + 8 * seg;
            const u32x4 w = *(const u32x4*)p;
            float v[8] = {bf2f(w.x & 0xffffu), bf2f(w.x >> 16), bf2f(w.y & 0xffffu), bf2f(w.y >> 16), bf2f(w.z & 0xffffu), bf2f(w.z >> 16), bf2f(w.w & 0xffffu), bf2f(w.w >> 16)};
            float q[8];
#pragma unroll
            for (int e = 0; e < 8; ++e) q[e] = __shfl_xor(v[e], 2);
            v[0] = v[0] * c01[0] + sg * q[0] * c01[1]; v[1] = v[1] * c01[2] + sg * q[1] * c01[3]; v[2] = v[2] * c23[0] + sg * q[2] * c23[1]; v[3] = v[3] * c23[2] + sg * q[3] * c23[3];
            v[4] = v[4] * c45[0] + sg * q[4] * c45[1]; v[5] = v[5] * c45[2] + sg * q[5] * c45[3]; v[6] = v[6] * c67[0] + sg * q[6] * c67[1]; v[7] = v[7] * c67[2] + sg * q[7] * c67[3];
            *(u32x4*)p = (u32x4){pk2(v[0], v[1]), pk2(v[2], v[3]), pk2(v[4], v[5]), pk2(v[6], v[7])};
        }
    }
}

constexpr int LDS_MISC = 143360;
__device__ __forceinline__ void gla_scan_unit(const Ctx& X, int unit) {
    unsigned char* ws = X.ws; const int tid = X.tid, lane = X.lane, wave = X.wave, r32 = lane & 31, hi = lane >> 5;
    const int p = unit & 15, sl = unit >> 4, b = p >> 2, h = p & 3, j = wave & 1, g = wave >> 1;
    LAS bf16_t* qs = (LAS bf16_t*)X.lds;
    LAS bf16_t* kts = (LAS bf16_t*)(X.lds + 33792);
    LAS bf16_t* as_ = (LAS bf16_t*)(X.lds + 70656);
    LAS bf16_t* vts = (LAS bf16_t*)(X.lds + 79872);
    LAS float* gd = (LAS float*)(X.lds + 89088);
    LAS unsigned char* po = X.lds + 90112;
    f32x16 S[2];
#pragma unroll
    for (int k = 0; k < 2; ++k)
#pragma unroll
        for (int r = 0; r < 16; ++r) S[k][r] = 0.f;
    float* oa = (float*)(ws + WS_OA);
    u32x4 pqA[4], pkA[4], paA, pvA; f32x4 pgA = (f32x4){0.f, 0.f, 0.f, 0.f};
#define SCAN_ISSUE(c_, pq, pk, pa, pv, pg) do { const int ub_ = (b * NCH + (c_)) * 4 + h; \
        const bf16_t* qblk_ = (const bf16_t*)(ws + WS_QA) + (size_t)ub_ * 64 * 256; const bf16_t* kblk_ = (const bf16_t*)(ws + WS_KA) + (size_t)ub_ * 64 * 256; \
        const bf16_t* vblk_ = (const bf16_t*)(ws + WS_VA) + (size_t)ub_ * 64 * 512 + (size_t)(64 * sl) * 64; const bf16_t* ablk_ = (const bf16_t*)(ws + WS_ATTN) + (size_t)ub_ * 4096; \
        _Pragma("unroll") for (int i_ = 0; i_ < 4; ++i_) { const int id_ = tid + NT * i_; pq[i_] = *(const u32x4*)(qblk_ + (id_ >> 5) * 256 + 8 * (id_ & 31)); pk[i_] = *(const u32x4*)(kblk_ + (id_ >> 3) * 64 + 8 * (id_ & 7)); } \
        pa = *(const u32x4*)(ablk_ + (tid >> 3) * 64 + 8 * (tid & 7)); pv = *(const u32x4*)(vblk_ + (tid >> 3) * 64 + 8 * (tid & 7)); \
        if (tid < 64) pg = *(const f32x4*)((const float*)(ws + WS_GDEC) + (size_t)ub_ * 256 + 4 * tid); } while (0)
#define SCAN_COMMIT(pq, pk, pa, pv, pg) do { \
        _Pragma("unroll") for (int i_ = 0; i_ < 4; ++i_) { const int id_ = tid + NT * i_; *(LAS u32x4*)(qs + (id_ >> 5) * 264 + 8 * (id_ & 31)) = pq[i_]; *(LAS u32x4*)(kts + (id_ >> 3) * 72 + 8 * (id_ & 7)) = pk[i_]; } \
        *(LAS u32x4*)(as_ + (tid >> 3) * 72 + 8 * (tid & 7)) = pa; *(LAS u32x4*)(vts + (tid >> 3) * 72 + 8 * (tid & 7)) = pv; \
        if (tid < 64) *(LAS f32x4*)(gd + 4 * tid) = pg; } while (0)
#define SCAN_BAR() do { asm volatile("s_waitcnt lgkmcnt(0)" ::: "memory"); __builtin_amdgcn_s_barrier(); asm volatile("" ::: "memory"); } while (0)
#define SCAN_STEP(c_, ISSUE_, COMMIT_) do { \
        ISSUE_; \
        bf16x8 bv[4]; \
        _Pragma("unroll") for (int s = 0; s < 4; ++s) bv[s] = *(const LAS bf16x8*)(vts + (32 * j + r32) * 72 + 16 * s + 8 * hi); \
        f32x16 o[2]; \
        _Pragma("unroll") for (int tt = 0; tt < 2; ++tt) _Pragma("unroll") for (int r = 0; r < 16; ++r) o[tt][r] = 0.f; \
        if (g == 0) { \
            _Pragma("unroll") for (int tt = 0; tt < 2; ++tt) _Pragma("unroll") for (int s = 0; s < 4; ++s) { const bf16x8 af = *(const LAS bf16x8*)(as_ + (32 * tt + r32) * 72 + 16 * s + 8 * hi); o[tt] = MFMA32(af, bv[s], o[tt]); } } \
        _Pragma("unroll") for (int kk = 0; kk < 2; ++kk) _Pragma("unroll") for (int s = 0; s < 2; ++s) { \
                u32x4 sw; sw.x = pg8::cvt_pk_bf16(S[kk][8 * s + 0], S[kk][8 * s + 1]); sw.y = pg8::cvt_pk_bf16(S[kk][8 * s + 2], S[kk][8 * s + 3]); \
                sw.z = pg8::cvt_pk_bf16(S[kk][8 * s + 4], S[kk][8 * s + 5]); sw.w = pg8::cvt_pk_bf16(S[kk][8 * s + 6], S[kk][8 * s + 7]); \
                const bf16x8 bs = __builtin_bit_cast(bf16x8, sw); \
                _Pragma("unroll") for (int tt = 0; tt < 2; ++tt) { const LAS bf16_t* qp = qs + (32 * tt + r32) * 264 + 64 * g + 32 * kk + 16 * s + 4 * hi; \
                    const u32x2 lo = *(const LAS u32x2*)qp, hi2 = *(const LAS u32x2*)(qp + 8); \
                    const bf16x8 af = __builtin_bit_cast(bf16x8, (u32x4){lo.x, lo.y, hi2.x, hi2.y}); \
                    o[tt] = MFMA32(af, bs, o[tt]); } } \
        _Pragma("unroll") for (int kk = 0; kk < 2; ++kk) { \
            _Pragma("unroll") for (int s = 0; s < 4; ++s) { const bf16x8 af = *(const LAS bf16x8*)(kts + (64 * g + 32 * kk + r32) * 72 + 16 * s + 8 * hi); S[kk] = MFMA32(af, bv[s], S[kk]); } \
            _Pragma("unroll") for (int q4 = 0; q4 < 4; ++q4) { const f32x4 dv = *(const LAS f32x4*)(gd + 64 * g + 32 * kk + 8 * q4 + 4 * hi); \
                _Pragma("unroll") for (int jj = 0; jj < 4; ++jj) S[kk][4 * q4 + jj] *= dv[jj]; } } \
        if (g > 0) { LAS unsigned char* pw = po + ((g - 1) * 2 + j) * 8192; \
            _Pragma("unroll") for (int tt = 0; tt < 2; ++tt) _Pragma("unroll") for (int q4 = 0; q4 < 4; ++q4) \
                *(LAS f32x4*)(pw + ((tt * 4 + q4) * 64 + lane) * 16) = (f32x4){o[tt][4 * q4], o[tt][4 * q4 + 1], o[tt][4 * q4 + 2], o[tt][4 * q4 + 3]}; } \
        SCAN_BAR(); \
        if (g == 0) { \
            _Pragma("unroll") for (int gg = 0; gg < 3; ++gg) { const LAS unsigned char* pr = po + (gg * 2 + j) * 8192; \
                _Pragma("unroll") for (int tt = 0; tt < 2; ++tt) _Pragma("unroll") for (int q4 = 0; q4 < 4; ++q4) { const f32x4 t4 = *(const LAS f32x4*)(pr + ((tt * 4 + q4) * 64 + lane) * 16); \
                        o[tt][4 * q4] += t4[0]; o[tt][4 * q4 + 1] += t4[1]; o[tt][4 * q4 + 2] += t4[2]; o[tt][4 * q4 + 3] += t4[3]; } } \
            _Pragma("unroll") for (int tt = 0; tt < 2; ++tt) _Pragma("unroll") for (int r = 0; r < 16; ++r) \
                oa[(size_t)(b * SEQ + (c_) * 64 + 32 * tt + crow(r, hi)) * DM + h * GDV + 64 * sl + 32 * j + r32] = o[tt][r]; } \
        COMMIT_; \
        SCAN_BAR(); } while (0)
    __syncthreads();
    SCAN_ISSUE(0, pqA, pkA, paA, pvA, pgA); SCAN_COMMIT(pqA, pkA, paA, pvA, pgA);
    __syncthreads();
    for (int c = 0; c < NCH; ++c) {
        SCAN_STEP(c, do { if (c + 1 < NCH) SCAN_ISSUE(c + 1, pqA, pkA, paA, pvA, pgA); } while (0), do { if (c + 1 < NCH) SCAN_COMMIT(pqA, pkA, paA, pvA, pgA); } while (0));
    }
    __syncthreads();
#undef SCAN_ISSUE
#undef SCAN_COMMIT
#undef SCAN_STEP
#undef SCAN_BAR
}

__device__ __forceinline__ unsigned fkey(float f) { const unsigned u = __float_as_uint(f); return (u & 0x80000000u) ? ~u : (u | 0x80000000u); }
__device__ __forceinline__ void idx_topk_unit(const Ctx& X, int unit) {
    unsigned char* ws = X.ws; const int lane = X.lane, wave = X.wave;
    const int b = unit >> 7, qb = unit & 127, q0 = 16 * qb;
    LAS float* sc = (LAS float*)X.lds;
    const bf16_t* IQ = (const bf16_t*)(ws + WS_IQ); const bf16_t* IK = (const bf16_t*)(ws + WS_IK); const float* IW = (const float*)(ws + WS_IW);
    const int l15 = lane & 15, l4 = lane >> 4;
    {
        bf16x8 bq[8][2]; float wq[8];
        const size_t mq = (size_t)(b * SEQ + q0 + l15);
#pragma unroll
        for (int hh = 0; hh < 8; ++hh) { wq[hh] = IW[mq * 8 + hh];
#pragma unroll
            for (int s = 0; s < 2; ++s) bq[hh][s] = *(const bf16x8*)(IQ + mq * 512 + hh * 64 + 32 * s + 8 * l4); }
        const int ntile = qb + 1;
        bf16x8 a0 = (bf16x8){0, 0, 0, 0, 0, 0, 0, 0}, a1 = a0;
        if (wave < ntile) { const size_t mk = (size_t)(b * SEQ + 16 * wave + l15); a0 = *(const bf16x8*)(IK + mk * 64 + 8 * l4); a1 = *(const bf16x8*)(IK + mk * 64 + 32 + 8 * l4); }
        for (int tile = wave; tile < ntile; tile += NW) {
            const int key0 = 16 * tile; const bf16x8 c0 = a0, c1 = a1;
            if (tile + NW < ntile) { const size_t mk = (size_t)(b * SEQ + key0 + 16 * NW + l15); a0 = *(const bf16x8*)(IK + mk * 64 + 8 * l4); a1 = *(const bf16x8*)(IK + mk * 64 + 32 + 8 * l4); }
            f32x4 s4 = (f32x4){0.f, 0.f, 0.f, 0.f};
#pragma unroll
            for (int hh = 0; hh < 8; ++hh) { f32x4 acc = (f32x4){0.f, 0.f, 0.f, 0.f}; acc = MFMA16(c0, bq[hh][0], acc); acc = MFMA16(c1, bq[hh][1], acc);
#pragma unroll
                for (int r = 0; r < 4; ++r) s4[r] += wq[hh] * fmaxf(acc[r], 0.f); }
            *(LAS f32x4*)(sc + l15 * 2048 + key0 + 4 * l4) = s4;
        }
    }
    __syncthreads();
    unsigned long long* mask = (unsigned long long*)(ws + WS_MASK);
    for (int qi = 0; qi < 2; ++qi) {
        const int q = 2 * wave + qi, t = q0 + q, n = t + 1;
        unsigned long long myw = 0ull;
        if (n <= TOPK) {
            const int lo = 64 * lane;
            if (lo + 63 <= t) myw = ~0ull; else if (lo <= t) myw = (~0ull) >> (63 - (t - lo));
        } else {
            unsigned u[32];
#pragma unroll
            for (int r = 0; r < 32; ++r) { const int key = 64 * r + lane; u[r] = (key <= t) ? fkey(sc[q * 2048 + (key <= t ? key : 0)]) : 0u; }
            unsigned T = 0u; bool exact = false;
            for (int bit = 31; bit >= 0; --bit) { const unsigned cand = T | (1u << bit); int c0 = 0, c1 = 0, c2 = 0, c3 = 0;
#pragma unroll
                for (int r = 0; r < 32; r += 4) { c0 += (u[r] >= cand) ? 1 : 0; c1 += (u[r + 1] >= cand) ? 1 : 0; c2 += (u[r + 2] >= cand) ? 1 : 0; c3 += (u[r + 3] >= cand) ? 1 : 0; }
                const int c = (c0 + c1) + (c2 + c3);
                int cnt = 0;
#pragma unroll
                for (int bb = 0; bb < 6; ++bb) cnt += __popcll(__ballot((c >> bb) & 1)) << bb;
                if (cnt >= TOPK) T = cand;
                if (cnt == TOPK) { exact = true; break; } }
            int cg_ = 0;
#pragma unroll
            for (int r = 0; r < 32; ++r) cg_ += (u[r] > T) ? 1 : 0;
            int ngt = 0;
#pragma unroll
            for (int bb = 0; bb < 6; ++bb) ngt += __popcll(__ballot((cg_ >> bb) & 1)) << bb;
            const int need = exact ? (1 << 20) : (TOPK - ngt);
            int base = 0;
#pragma unroll
            for (int r = 0; r < 32; ++r) { const bool eq = (u[r] == T); const unsigned long long me = __ballot(eq);
                const int before = base + (int)__builtin_amdgcn_mbcnt_hi((unsigned)(me >> 32), __builtin_amdgcn_mbcnt_lo((unsigned)me, 0u));
                const unsigned long long w = __ballot((u[r] > T) || (eq && before < need));
                base += __popcll(me);
                if (lane == r) myw = w;
                __builtin_amdgcn_sched_barrier(0); }
        }
        if (lane < 32) mask[(size_t)(b * SEQ + t) * 32 + lane] = myw;
    }
    __syncthreads();
}

__device__ __forceinline__ void dsa_attn_unit(const Ctx& X, int b, int head, int qb) {
    unsigned char* ws = X.ws; const int tid = X.tid, lane = X.lane, wave = X.wave, r32 = lane & 31, hi = lane >> 5;
    LAS bf16_t* Kb = (LAS bf16_t*)X.lds;
    LAS bf16_t* Vb = (LAS bf16_t*)(X.lds + 34816);
    const bf16_t* DQ = (const bf16_t*)(ws + WS_DQ); const bf16_t* DK = (const bf16_t*)(ws + WS_DK); const bf16_t* DV = (const bf16_t*)(ws + WS_DV);
    const unsigned* mask = (const unsigned*)(ws + WS_MASK);
    const int qrow = b * SEQ + 256 * qb + 32 * wave + r32;
    const int NTL = 4 * qb + 4;
    const int myNT = 4 * qb + ((32 * wave + 31) >> 6) + 1;
    bf16x8 qf[8];
#pragma unroll
    for (int s = 0; s < 8; ++s) qf[s] = *(const bf16x8*)(DQ + (size_t)qrow * DM + head * DHD + 16 * s + 8 * hi);
    f32x16 ot[4];
#pragma unroll
    for (int d = 0; d < 4; ++d)
#pragma unroll
        for (int r = 0; r < 16; ++r) ot[d][r] = 0.f;
    float m_run = -1e30f, l_run = 0.f;
    const float C2 = 0.08838834764831845f * 1.4426950408889634f;
    u32x4 kreg0, kreg1, vreg0, vreg1;
#define ATT_ISSUE(kt_) do { \
        { const int id = tid, key = id >> 4, c16 = id & 15; kreg0 = *(const u32x4*)(DK + (size_t)(b * SEQ + 64 * (kt_) + key) * DM + head * DHD + 8 * c16); } \
        { const int id = tid + NT, key = id >> 4, c16 = id & 15; kreg1 = *(const u32x4*)(DK + (size_t)(b * SEQ + 64 * (kt_) + key) * DM + head * DHD + 8 * c16); } \
        { const int id = tid, dv = id >> 3, c16 = id & 7; vreg0 = *(const u32x4*)(DV + ((size_t)((b * NCH + (kt_)) * DH + head) * 128 + dv) * 64 + 8 * c16); } \
        { const int id = tid + NT, dv = id >> 3, c16 = id & 7; vreg1 = *(const u32x4*)(DV + ((size_t)((b * NCH + (kt_)) * DH + head) * 128 + dv) * 64 + 8 * c16); } } while (0)
#define ATT_COMMIT(buf_) do { \
        { const int id = tid, key = id >> 4, c16 = id & 15; *(LAS u32x4*)(Kb + (buf_) * 8704 + key * 136 + 8 * c16) = kreg0; } \
        { const int id = tid + NT, key = id >> 4, c16 = id & 15; *(LAS u32x4*)(Kb + (buf_) * 8704 + key * 136 + 8 * c16) = kreg1; } \
        { const int id = tid, dv = id >> 3, c16 = id & 7; *(LAS u32x4*)(Vb + (buf_) * 9216 + dv * 72 + 8 * c16) = vreg0; } \
        { const int id = tid + NT, dv = id >> 3, c16 = id & 7; *(LAS u32x4*)(Vb + (buf_) * 9216 + dv * 72 + 8 * c16) = vreg1; } } while (0)
    __syncthreads();
    ATT_ISSUE(0); ATT_COMMIT(0);
    __syncthreads();
    u32x2 mw_next = *(const u32x2*)(mask + (size_t)qrow * 64);
    for (int kt = 0; kt < NTL; ++kt) {
        const int buf = kt & 1;
        if (kt + 1 < NTL) ATT_ISSUE(kt + 1);
        if (kt < myNT) {
            const u32x2 mw = mw_next; if (kt + 1 < myNT) mw_next = *(const u32x2*)(mask + (size_t)qrow * 64 + 2 * (kt + 1));
            f32x16 p0, p1;
#pragma unroll
            for (int r = 0; r < 16; ++r) { p0[r] = 0.f; p1[r] = 0.f; }
            const LAS bf16_t* kb = Kb + buf * 8704;
#pragma unroll
            for (int s = 0; s < 8; ++s) { const bf16x8 a0 = *(const LAS bf16x8*)(kb + r32 * 136 + 16 * s + 8 * hi), a1 = *(const LAS bf16x8*)(kb + (32 + r32) * 136 + 16 * s + 8 * hi);
                p0 = MFMA32(a0, qf[s], p0); p1 = MFMA32(a1, qf[s], p1); }
            const unsigned lo = mw.x >> (4 * hi), hi_w = mw.y >> (4 * hi);
            float mx = -INFINITY;
#pragma unroll
            for (int r = 0; r < 16; ++r) { const int cb = (r & 3) + 8 * (r >> 2);
                p0[r] = ((lo >> cb) & 1u) ? p0[r] : -INFINITY; p1[r] = ((hi_w >> cb) & 1u) ? p1[r] : -INFINITY; mx = fmaxf(mx, fmaxf(p0[r], p1[r])); }
            mx = fmaxf(mx, __shfl_xor(mx, 32));
            const float m_new = fmaxf(m_run, mx);
            const float alpha = exp2f((m_run - m_new) * C2);
            const float mc = m_new * C2;
            float ls = 0.f;
#pragma unroll
            for (int r = 0; r < 16; ++r) { p0[r] = exp2f(fmaf(p0[r], C2, -mc)); p1[r] = exp2f(fmaf(p1[r], C2, -mc)); ls += p0[r] + p1[r]; }
            l_run = l_run * alpha + ls; m_run = m_new;
#pragma unroll
            for (int d = 0; d < 4; ++d)
#pragma unroll
                for (int r = 0; r < 16; ++r) ot[d][r] *= alpha;
            bf16x8 pb[4];
#pragma unroll
            for (int s = 0; s < 4; ++s) { u32x4 w;
                if (s < 2) { w.x = pg8::cvt_pk_bf16(p0[8 * s + 0], p0[8 * s + 1]); w.y = pg8::cvt_pk_bf16(p0[8 * s + 2], p0[8 * s + 3]); w.z = pg8::cvt_pk_bf16(p0[8 * s + 4], p0[8 * s + 5]); w.w = pg8::cvt_pk_bf16(p0[8 * s + 6], p0[8 * s + 7]); }
                else { const int s2 = s - 2; w.x = pg8::cvt_pk_bf16(p1[8 * s2 + 0], p1[8 * s2 + 1]); w.y = pg8::cvt_pk_bf16(p1[8 * s2 + 2], p1[8 * s2 + 3]); w.z = pg8::cvt_pk_bf16(p1[8 * s2 + 4], p1[8 * s2 + 5]); w.w = pg8::cvt_pk_bf16(p1[8 * s2 + 6], p1[8 * s2 + 7]); }
                pb[s] = __builtin_bit_cast(bf16x8, w); }
            const LAS bf16_t* vb = Vb + buf * 9216;
#pragma unroll
            for (int d = 0; d < 4; ++d)
#pragma unroll
                for (int s = 0; s < 4; ++s) { const LAS bf16_t* vp = vb + (32 * d + r32) * 72 + 16 * s + 4 * hi;
                    const u32x2 v0 = *(const LAS u32x2*)vp, v1 = *(const LAS u32x2*)(vp + 8);
                    const bf16x8 af = __builtin_bit_cast(bf16x8, (u32x4){v0.x, v0.y, v1.x, v1.y});
                    ot[d] = MFMA32(af, pb[s], ot[d]); }
        }
        if (kt + 1 < NTL) ATT_COMMIT(buf ^ 1);
        __syncthreads();
    }
    const float lt = l_run + __shfl_xor(l_run, 32);
    const float inv = 1.f / lt;
    bf16_t* ob = (bf16_t*)(ws + WS_OB) + (size_t)qrow * DM + head * DHD;
#pragma unroll
    for (int d = 0; d < 4; ++d)
#pragma unroll
        for (int g = 0; g < 4; ++g) { u32x2 w; w.x = pg8::cvt_pk_bf16(ot[d][4 * g] * inv, ot[d][4 * g + 1] * inv); w.y = pg8::cvt_pk_bf16(ot[d][4 * g + 2] * inv, ot[d][4 * g + 3] * inv);
            *(u32x2*)(ob + 32 * d + 8 * g + 4 * hi) = w; }
}

__device__ __forceinline__ void oa_norm_rows(const Ctx& X, const float* gng) {
    const int gw = X.bid * NW + X.wave, NGW = X.G * NW, lane = X.lane;
    const float* oa = (const float*)(X.ws + WS_OA); const bf16_t* ra = (const bf16_t*)(X.ws + WS_RA); bf16_t* oan = (bf16_t*)(X.ws + WS_H);
    for (int row = gw; row < MTOK; row += NGW) {
#pragma unroll
        for (int hh = 0; hh < GH; ++hh) {
            const size_t off = (size_t)row * DM + hh * GDV + 4 * lane;
            const f32x4 v0 = *(const f32x4*)(oa + off), v1 = *(const f32x4*)(oa + off + 256);
            float s = (v0[0] * v0[0] + v0[1] * v0[1]) + (v0[2] * v0[2] + v0[3] * v0[3]) + (v1[0] * v1[0] + v1[1] * v1[1]) + (v1[2] * v1[2] + v1[3] * v1[3]);
            const float rs = rsqrtf(wave_sum(s) * (1.f / GDV) + RMS_EPS);
            const f32x4 g0 = *(const f32x4*)(gng + hh * GDV + 4 * lane), g1 = *(const f32x4*)(gng + hh * GDV + 4 * lane + 256);
            const f32x4 r0 = pg8::bf4_to_f32(*(const u32x2*)(ra + off)), r1 = pg8::bf4_to_f32(*(const u32x2*)(ra + off + 256));
            const f32x4 y0 = v0 * rs * g0 * r0, y1 = v1 * rs * g1 * r1;
            *(u32x2*)(oan + off) = (u32x2){pk2(y0[0], y0[1]), pk2(y0[2], y0[3])}; *(u32x2*)(oan + off + 256) = (u32x2){pk2(y1[0], y1[1]), pk2(y1[2], y1[3])};
        }
    }
}


constexpr int NPHASE = 13;

__global__ void __launch_bounds__(NT, 2) fwd_kernel(Args args) {
    extern __shared__ __attribute__((aligned(16))) unsigned char lds_raw[];
    cg::grid_group grid = cg::this_grid();
    Ctx X;
    X.lds = (LAS unsigned char*)lds_raw; X.ws = args.ws;
    X.tid = threadIdx.x; X.lane = X.tid & 63; X.wave = __builtin_amdgcn_readfirstlane(X.tid >> 6);
    X.bid = blockIdx.x; X.G = gridDim.x;
    if (X.tid < 18) { const float* pv_ = (X.tid < 17) ? args.in[X.tid < 17 ? X.tid : 0] : (const float*)args.out; *(LAS unsigned long long*)(X.lds + LDS_PTAB + 8 * X.tid) = (unsigned long long)pv_; }
    if (X.tid < 2) ((volatile LAS unsigned*)(X.lds + LDS_PTAB + 160))[X.tid] = 0u;
    __syncthreads();
    XcdBarrier xbar = xcd_barrier_post((unsigned*)(args.ws + WS_CTL) + 4096, (volatile LAS unsigned*)(X.lds + LDS_PTAB + 160));
    unsigned char* ws = args.ws;
#define mod ((float*)(ws + WS_MOD))
    const int lo = args.ph_lo, hi = args.ph_hi;
    STAMP(13);
#ifdef EXTRA_SYNCS
    for (int es_ = 0; es_ < EXTRA_SYNCS; ++es_) grid.sync();
#endif
#ifndef PH_ONLY
#define PH_ONLY -1
#endif
#ifndef PH_MASK
#define PH_MASK 0x1fff
#endif
#define IN(k) ((PH_ONLY < 0 || PH_ONLY == (k)) && ((PH_MASK >> (k)) & 1) && lo <= (k) && (k) < hi)
#define LAUNDER() do { int t_ = threadIdx.x; asm volatile("" : "+v"(t_)); X.tid = t_; X.lane = t_ & 63; X.wave = __builtin_amdgcn_readfirstlane(t_ >> 6); \
        unsigned char* w_ = args.ws; asm volatile("" : "+s"(w_)); ws = w_; X.ws = w_; } while (0)
#ifndef USE_CG_SYNC
#define GSYNC(k) do { if ((k) == 0) grid.sync(); else xcd_barrier(xbar); } while (0)
#else
#define GSYNC(k) grid.sync()
#endif
#define SEAM(k) do { STAMP(k); if (IN(k) && IN((k) + 1)) GSYNC(k); } while (0)

    if (IN(0)) {
    { LAUNDER(); p0_prologue<true>(X); }
    }
    SEAM(0);
    if (IN(1)) {
    { LAUNDER(); norm1_rows(X, INP(X, I_X), INP(X, I_N1G), INP(X, I_BADA), mod, (bf16_t*)(ws + WS_H)); }
    }
    SEAM(1);
    if (IN(2)) {
    { LAUNDER();
        pg8::Gemm g{(const bf16_t*)(ws + WS_H), (const bf16_t*)(ws + WS_WIN), MTOK, INWP, DM}; pg8::StaticOrder S; S.init(MTOK, INWP, X.G, X.bid);
        pg8::EpiInProj E{ws};
        pg8::gemm_phase<pg8::EpiInProj, pg8::StaticOrder, true, true>(X.lds, g, S, E);
    }
    }
    SEAM(2);
    if (IN(3)) {
    { LAUNDER();
        for (int u = X.bid; u < BATCH * NCH * GH; u += X.G) gla_prep_unit(X, args, u);
        dv_transpose(X);
        idx_prep(X);
        rope_qk(X);
    }
    }
    SEAM(3);
    if (IN(4)) {
    { LAUNDER();
        if (X.bid < 128) { const int xx = X.bid & 7, mm = X.bid >> 3; gla_scan_unit(X, (mm & 7) * 16 + xx + 8 * (mm >> 3)); STAMP(16); }
        {
            unsigned* qctr = (unsigned*)(ws + WS_CTL) + 64;
            volatile LAS unsigned* qsh = (volatile LAS unsigned*)(X.lds + LDS_MISC);
            for (;;) {
                __syncthreads();
                if (X.tid == 0) qsh[0] = atomicAdd(qctr, 1u);
                __syncthreads();
                const unsigned uq = qsh[0];
                if (uq >= (unsigned)(BATCH * 128)) break;
                idx_topk_unit(X, (int)((uq & 3u) * 128u + (127u - (uq >> 2))));
            }
        }
    }
    }
    SEAM(4);
    if (IN(5)) {
    { LAUNDER();
        const int NU = BATCH * DH * 8;
        for (int i = 0; i * X.G < NU; ++i) {
            const int v = i * X.G + ((i & 1) ? (X.G - 1 - X.bid) : X.bid);
            if (v < NU) { const int qb = 7 - (v >> 6), bh = v & 63; dsa_attn_unit(X, bh >> 4, bh & 15, qb); }
        }
        oa_norm_rows(X, INP(X, I_GNG));
    }
    }
    SEAM(5);
    if (IN(6)) {
    { LAUNDER();
        pg8::Gemm g{(const bf16_t*)(ws + WS_H), (const bf16_t*)(ws + WS_WBGA), MTOK, DM, DM}; pg8::StaticOrder S; S.init(MTOK, DM, X.G, X.bid);
        pg8::EpiScaleF32 E{(float*)(ws + WS_TMP), (const bf16_t*)(ws + WS_SGA)};
        pg8::gemm_phase<pg8::EpiScaleF32, pg8::StaticOrder, true, true>(X.lds, g, S, E);
    }
    }
    SEAM(6);
    if (IN(7)) {
    { LAUNDER();
        pg8::Gemm g{(const bf16_t*)(ws + WS_OB), (const bf16_t*)(ws + WS_WBDSA), MTOK, DM, DM}; pg8::StaticOrder S; S.init(MTOK, DM, X.G, X.bid);
        pg8::EpiMerge E{(bf16_t*)(ws + WS_MERGED), (const float*)(ws + WS_TMP), (const bf16_t*)(ws + WS_SGB)};
        pg8::gemm_phase<pg8::EpiMerge, pg8::StaticOrder, true, true>(X.lds, g, S, E);
    }
    }
    SEAM(7);
    if (IN(8)) {
    { LAUNDER();
        pg8::Gemm g{(const bf16_t*)(ws + WS_MERGED), (const bf16_t*)(ws + WS_WMO), MTOK, DM, DM}; pg8::StaticOrder S; S.init(MTOK, DM, X.G, X.bid);
        pg8::EpiResid E{INP(X, I_X), (float*)(ws + WS_X1), mod + 2 * DM};
        pg8::gemm_phase<pg8::EpiResid, pg8::StaticOrder, true, true>(X.lds, g, S, E);
    }
    }
    SEAM(8);
    if (IN(9)) {
    { LAUNDER(); norm_mod_rows(X, (const float*)(ws + WS_X1), INP(X, I_N2G), mod, 3, 4, (bf16_t*)(ws + WS_H)); }
    }
    SEAM(9);
    if (IN(10)) {
    { LAUNDER();
        pg8::Gemm g{(const bf16_t*)(ws + WS_H), (const bf16_t*)(ws + WS_WGU), MTOK, 2 * DFF, DM}; pg8::StaticOrder S; S.init(MTOK, 2 * DFF, X.G, X.bid);
        pg8::EpiSwiglu E{(bf16_t*)(ws + WS_ACT)};
        pg8::gemm_phase<pg8::EpiSwiglu, pg8::StaticOrder, true, true>(X.lds, g, S, E);
    }
    }
    SEAM(10);
    if (IN(11)) {
    { LAUNDER();
        pg8::Gemm g{(const bf16_t*)(ws + WS_ACT), (const bf16_t*)(ws + WS_WDN), MTOK, DM, DFF}; pg8::StaticOrder S; S.init(MTOK, DM, X.G, X.bid);
        pg8::EpiResid E{(const float*)(ws + WS_X1), (float*)INP(X, 17), mod + 5 * DM};
        pg8::gemm_phase<pg8::EpiResid, pg8::StaticOrder, true, true>(X.lds, g, S, E);
    }
    }
    SEAM(11);
    if (IN(12)) {
    { LAUNDER(); final_norm_rows(X, (float*)INP(X, 17), INP(X, I_FNG)); }
    }
#ifdef STAMP_A
    {
        STAMP(12);
        __threadfence(); grid.sync();
        if (X.bid == 0 && X.tid == 0) {
            const unsigned long long* ts = (const unsigned long long*)(ws + WS_DBG);
            unsigned long long e1 = 0, e0 = 0, mn = ~0ull;
            for (int b = 0; b < X.G; ++b) { const unsigned long long v = __hip_atomic_load(ts + STAMP_A * 256 + b, __ATOMIC_RELAXED, __HIP_MEMORY_SCOPE_AGENT); if (v) { e1 = v > e1 ? v : e1; mn = v < mn ? v : mn; } }
            for (int b = 0; b < X.G; ++b) { const unsigned long long v = __hip_atomic_load(ts + STAMP_B * 256 + b, __ATOMIC_RELAXED, __HIP_MEMORY_SCOPE_AGENT); e0 = v > e0 ? v : e0; }
#if STAMP_MODE == 1
            e1 = mn;
#endif
            const unsigned long long dur = (e1 > e0) ? (e1 - e0) : 0ull;
            const unsigned long long t0 = __builtin_amdgcn_s_memrealtime();
            while (__builtin_amdgcn_s_memrealtime() - t0 < 4ull * dur) __builtin_amdgcn_s_sleep(8);
        }
    }
#endif
#undef IN
#undef SEAM
#undef mod
}


extern "C" void kernel_launch(void* const* d_in, const int* in_sizes, int n_in, void* d_out, int out_size, void* d_ws, size_t ws_size, hipStream_t stream) {
    static int grid = 0;
    if (grid == 0) {
        if (n_in != 17 || out_size != MTOK * DM || ws_size < WS_END) { fprintf(stderr, "kernel_launch: unexpected shapes (n_in %d out %d ws %zu need %zu)\n", n_in, out_size, ws_size, (size_t)WS_END); grid = -1; return; }
        int dev = 0, cus = 0, per_cu = 0;
        if (hipGetDevice(&dev) != hipSuccess || hipDeviceGetAttribute(&cus, hipDeviceAttributeMultiprocessorCount, dev) != hipSuccess) { grid = -1; return; }
        if (hipFuncSetAttribute((const void*)fwd_kernel, hipFuncAttributeMaxDynamicSharedMemorySize, LDS_BYTES) != hipSuccess) { grid = -1; return; }
        if (hipOccupancyMaxActiveBlocksPerMultiprocessor(&per_cu, (const void*)fwd_kernel, NT, LDS_BYTES) != hipSuccess || per_cu < 1) { fprintf(stderr, "kernel_launch: occupancy query says %d\n", per_cu); }
        (void)hipGetLastError();
        grid = cus;
    }
    if (grid < 0) return;
    (void)hipMemsetAsync((char*)d_ws + WS_CTL, 0, CTL_BYTES, stream);
    Args a{};
    for (int i = 0; i < 17; ++i) a.in[i] = (const float*)d_in[i];
    a.out = (float*)d_out; a.ws = (unsigned char*)d_ws; a.ph_lo = 0; a.ph_hi = (PH_STOP < NPHASE) ? PH_STOP : NPHASE;
    void* kargs[] = {&a};
    hipError_t e = hipLaunchCooperativeKernel((const void*)fwd_kernel, dim3(grid), dim3(NT), kargs, LDS_BYTES, stream);
    if (e != hipSuccess) fprintf(stderr, "kernel_launch: cooperative launch failed: %s (grid %d)\n", hipGetErrorString(e), grid);
#if DBG
    dbg_run(a, stream);
#endif
}
```

```cpp
#include <hip/hip_runtime.h>
#include <hip/hip_cooperative_groups.h>
#include <cstdio>
#include <cstdint>
namespace cg = cooperative_groups;

#ifndef DBG
#define DBG 0
#endif
#ifndef PH_STOP
#define PH_STOP 99
#endif

constexpr int BATCH = 4, SEQ = 2048, DM = 2048, MTOK = BATCH * SEQ;
constexpr int INW = 16984, INWP = 17152, DFF = 5632, NMOD = 6 * DM;
constexpr int GH = 4, GDK = 256, GDV = 512, GRANK = 16, NCH = SEQ / 64;
constexpr int DH = 16, DHD = 128, IH = 8, ID = 64, TOPK = 256;
constexpr int SMALLW = 768;
constexpr float RMS_EPS = 1e-6f;
constexpr int SRC_GQ = 0, SRC_GK = 1024, SRC_GV = 2048, SRC_GR = 4096, SRC_GLR = 6144, SRC_DQ = 6160, SRC_DK = 8208, SRC_DV = 10256,
              SRC_IQ = 12304, SRC_IK = 12816, SRC_IW = 12880, SRC_GA = 12888, SRC_GB = 14936;
enum { I_X = 0, I_C, I_POS, I_N1G, I_N2G, I_WADA, I_BADA, I_WIN, I_GUP, I_GBIAS, I_GNG, I_WBGA, I_WBDSA, I_WMO, I_WGU, I_WDN, I_FNG };

constexpr size_t MiB = 1u << 20;
constexpr size_t WS_CTL = 0, CTL_BYTES = 1 * MiB;
constexpr size_t WS_MOD = 65536;
constexpr size_t WS_DBG = 512 * 1024;
constexpr size_t WS_ROPED = 1 * MiB;
constexpr size_t WS_ROPEI = 2 * MiB;
constexpr size_t WS_IW = 2 * MiB + 512 * 1024;
constexpr size_t WS_GDEC = 3 * MiB;
constexpr size_t WS_MASK = 4 * MiB;
constexpr size_t WS_IK = 6 * MiB;
constexpr size_t WS_IQ = 7 * MiB;
constexpr size_t WS_ATTN = 15 * MiB;
constexpr size_t WS_WBGA = 20 * MiB, WS_WBDSA = 28 * MiB, WS_WMO = 36 * MiB, WS_WGU = 44 * MiB, WS_WDN = 88 * MiB;
constexpr size_t WS_WIN = 110 * MiB;
constexpr size_t WS_OA = 110 * MiB;
constexpr size_t WS_H = 177 * MiB;
constexpr size_t WS_QA = 209 * MiB, WS_KA = 225 * MiB;
constexpr size_t WS_VA = 241 * MiB;
constexpr size_t WS_RA = 273 * MiB;
constexpr size_t WS_DQ = 305 * MiB, WS_DK = 337 * MiB;
constexpr size_t WS_DV = 369 * MiB;
constexpr size_t WS_SGA = 401 * MiB, WS_SGB = 433 * MiB;
constexpr size_t WS_SMALL = 465 * MiB;
constexpr size_t WS_KTA = 489 * MiB;
constexpr size_t WS_MODP = 505 * MiB;
constexpr size_t WS_END = 512 * MiB;
constexpr size_t WS_OB = WS_QA;
constexpr size_t WS_TMP = WS_VA;
constexpr size_t WS_MERGED = WS_DQ;
constexpr size_t WS_X1 = WS_DK;
constexpr size_t WS_ACT = WS_QA;

#define LAS __attribute__((address_space(3)))
typedef unsigned short bf16_t;
typedef short bf16x8 __attribute__((ext_vector_type(8)));
typedef short bf16x4 __attribute__((ext_vector_type(4)));
typedef float f32x4 __attribute__((ext_vector_type(4)));
typedef float f32x16 __attribute__((ext_vector_type(16)));
typedef unsigned u32x4 __attribute__((ext_vector_type(4)));
typedef unsigned u32x2 __attribute__((ext_vector_type(2)));
constexpr int NT = 512, NW = 8;
constexpr int RING_BYTES = 131072;
constexpr int LDS_BYTES = 147456;

__device__ __forceinline__ float bf2f(unsigned v) { return __uint_as_float(v << 16); }
__device__ __forceinline__ unsigned f2bf(float f) { unsigned u = __float_as_uint(f); return (u + 0x7fffu + ((u >> 16) & 1u)) >> 16; }
__device__ __forceinline__ unsigned pk2(float lo, float hi) { return f2bf(lo) | (f2bf(hi) << 16); }
__device__ __forceinline__ float wave_sum(float v) {
#pragma unroll
    for (int o = 1; o < 64; o <<= 1) v += __shfl_xor(v, o);
    return v;
}
__device__ __forceinline__ float siluf(float v) { return v / (1.f + __expf(-v)); }
__device__ __forceinline__ float sigmf(float v) { return 1.f / (1.f + __expf(-v)); }
__device__ __forceinline__ int crow(int r, int hi) { return (r & 3) + 8 * (r >> 2) + 4 * hi; }

namespace pg8 {
#define PG8_LAS __attribute__((address_space(3)))
typedef unsigned short bf16_t;
typedef short bf16x8 __attribute__((ext_vector_type(8)));
typedef float f32x4 __attribute__((ext_vector_type(4)));
typedef unsigned u32x4 __attribute__((ext_vector_type(4)));
constexpr int BM = 256, BK = 64, HALF = 128, HTB = HALF * BK * 2  , STAGE_BYTES = 8 * HTB, NXCD = 8, WGM = 8;

__host__ __device__ __forceinline__ int lds_byte(int r, int c) { const int st = (r >> 4) * 2 + (c >> 5), rr = r & 15, cc = c & 31, ob = rr * 64 + cc * 2; return st * 1024 + (ob ^ (((ob >> 9) & 1) << 5)); }
__host__ __device__ __forceinline__ void stage_rc(int b, int& R, int& C) { const int st = b / 1024, sb = b % 1024, swz = sb ^ (((sb >> 9) & 1) << 5); R = (st >> 1) * 16 + swz / 64; C = (st & 1) * 32 + (swz % 64) / 2; }
__host__ __device__ __forceinline__ int perm32(int rho) { const int n = rho >> 4, i = rho & 15; return 8 * (i >> 2) + 4 * n + (i & 3); }

struct Unit { int pm, pn; };
struct Gemm { const bf16_t* A; const bf16_t* Bt; int M, N, K; };

struct StaticOrder {
    int nM, nN, nwg, G, c;
    __host__ __device__ void init(int M, int N, int G_, int c_) { nM = M / BM; nN = N / BM; nwg = nM * nN; G = G_; c = c_; }
    __host__ __device__ bool next(int i, Unit& u) const {
        const long L = (long)i * G + c; if (L >= nwg) return false;
        int wgid = (int)L; { const int q = nwg / NXCD, r = nwg % NXCD, xcd = wgid % NXCD, off = wgid / NXCD; wgid = (xcd < r ? xcd * (q + 1) : r * (q + 1) + (xcd - r) * q) + off; }
        const int nig = WGM * nN, gid = wgid / nig, fm = gid * WGM, gsz = (nM - fm) < WGM ? (nM - fm) : WGM;
        u.pm = fm + ((wgid % nig) % gsz); u.pn = (wgid % nig) / gsz; return true;
    }
    __device__ __forceinline__ void a_ready(const Unit&) const {}
    __device__ __forceinline__ void done(const Unit&) const {}
};


__device__ __forceinline__ unsigned cvt_pk_bf16(float lo, float hi) { unsigned r; asm volatile("v_cvt_pk_bf16_f32 %0, %1, %2" : "=v"(r) : "v"(lo), "v"(hi)); return r; }
__device__ __forceinline__ void store8bf(bf16_t* p, f32x4 v0, f32x4 v1) {
    u32x4 w; w.x = cvt_pk_bf16(v0[0], v0[1]); w.y = cvt_pk_bf16(v0[2], v0[3]); w.z = cvt_pk_bf16(v1[0], v1[1]); w.w = cvt_pk_bf16(v1[2], v1[3]); *(u32x4*)p = w;
}
__device__ __forceinline__ f32x4 silu4(f32x4 v) { f32x4 o; o[0] = v[0] / (1.f + __expf(-v[0])); o[1] = v[1] / (1.f + __expf(-v[1])); o[2] = v[2] / (1.f + __expf(-v[2])); o[3] = v[3] / (1.f + __expf(-v[3])); return o; }
__device__ __forceinline__ f32x4 sigm4(f32x4 v) { f32x4 o; o[0] = 1.f / (1.f + __expf(-v[0])); o[1] = 1.f / (1.f + __expf(-v[1])); o[2] = 1.f / (1.f + __expf(-v[2])); o[3] = 1.f / (1.f + __expf(-v[3])); return o; }
__device__ __forceinline__ f32x4 bf4_to_f32(u32x2 w) { f32x4 o; o[0] = __uint_as_float(w.x << 16); o[1] = __uint_as_float(w.x & 0xffff0000u); o[2] = __uint_as_float(w.y << 16); o[3] = __uint_as_float(w.y & 0xffff0000u); return o; }

struct EpiInProj {
    static constexpr bool PERM = true, AFTER_DRAIN = false;
    unsigned char* ws;
    __device__ __forceinline__ void operator()(const f32x4 (&acc)[2][2][4][2], const Unit& u, int wr, int wc, int fr, int fq) const {
        const int pn = u.pn, row0 = u.pm * BM + wr * 64 + fr, cl = wc * 32 + 8 * fq;
        if (pn >= 64) {
            float* base = (float*)(ws + WS_SMALL) + 256 * (pn - 64) + cl;
#pragma unroll
            for (int ai = 0; ai < 2; ++ai)
#pragma unroll
                for (int m = 0; m < 4; ++m) { const int r = row0 + ai * HALF + m * 16; float* rp = base + (size_t)r * SMALLW;
#pragma unroll
                    for (int bj = 0; bj < 2; ++bj) { *(f32x4*)(rp + bj * HALF) = acc[ai][bj][m][0]; *(f32x4*)(rp + bj * HALF + 4) = acc[ai][bj][m][1]; } asm volatile("" ::: "memory"); }
            return;
        }
        size_t wsoff; int A, B, C, E = HALF, op = 0;
        if (pn < 8) { wsoff = pn < 4 ? WS_QA : WS_KA; A = 4 * 64 * 256; B = 256; C = (pn & 3) * 64 * 256; }
        else if (pn < 16) { wsoff = WS_VA; A = 4 * 64 * 512; B = 512; C = ((pn - 8) >> 1) * 64 * 512 + 256 * ((pn - 8) & 1); }
        else if (pn < 24) { wsoff = WS_RA; A = 64 * DM; B = DM; C = 256 * (pn - 16); op = 1; }
        else if (pn < 40) { wsoff = pn < 32 ? WS_DQ : WS_DK; A = 64 * DM; B = DM; C = 256 * ((pn - 24) & 7); }
        else if (pn < 48) { wsoff = WS_DV; A = 16 * 64 * 128; B = 128; C = 2 * (pn - 40) * 64 * 128; E = 64 * 128; }
        else { wsoff = pn < 56 ? WS_SGA : WS_SGB; A = 64 * DM; B = DM; C = 256 * ((pn - 48) & 7); op = 2; }
        bf16_t* base = (bf16_t*)(ws + wsoff) + C + cl;
#pragma unroll
        for (int ai = 0; ai < 2; ++ai)
#pragma unroll
            for (int m = 0; m < 4; ++m) { const int r = row0 + ai * HALF + m * 16; bf16_t* rp = base + (size_t)(r >> 6) * A + (r & 63) * B;
#pragma unroll
                for (int bj = 0; bj < 2; ++bj) { f32x4 v0 = acc[ai][bj][m][0], v1 = acc[ai][bj][m][1];
                    if (op == 1) { v0 = silu4(v0); v1 = silu4(v1); }
                    else if (op == 2) { v0 = sigm4(v0); v1 = sigm4(v1); }
                    store8bf(rp + bj * E, v0, v1); }
                asm volatile("" ::: "memory"); }
    }
};

struct EpiScaleF32 {
    static constexpr bool PERM = false, AFTER_DRAIN = false;
    float* C; const bf16_t* G;
    __device__ __forceinline__ void operator()(const f32x4 (&acc)[2][2][4][2], const Unit& u, int wr, int wc, int fr, int fq) const {
        const int row0 = u.pm * BM + wr * 64 + fr, col0 = u.pn * BM + wc * 32 + 4 * fq;
#pragma unroll
        for (int ai = 0; ai < 2; ++ai)
#pragma unroll
            for (int m = 0; m < 4; ++m) { const size_t off = (size_t)(row0 + ai * HALF + m * 16) * DM + col0;
#pragma unroll
                for (int bj = 0; bj < 2; ++bj)
#pragma unroll
                    for (int n = 0; n < 2; ++n) { const f32x4 g = bf4_to_f32(*(const u32x2*)(G + off + bj * HALF + n * 16)); *(f32x4*)(C + off + bj * HALF + n * 16) = acc[ai][bj][m][n] * g; } }
    }
};
struct EpiMerge {
    static constexpr bool PERM = true, AFTER_DRAIN = false;
    bf16_t* O; const float* T; const bf16_t* G;
    __device__ __forceinline__ void operator()(const f32x4 (&acc)[2][2][4][2], const Unit& u, int wr, int wc, int fr, int fq) const {
        const int row0 = u.pm * BM + wr * 64 + fr, col0 = u.pn * BM + wc * 32 + 8 * fq;
#pragma unroll
        for (int ai = 0; ai < 2; ++ai)
#pragma unroll
            for (int m = 0; m < 4; ++m) { const size_t off = (size_t)(row0 + ai * HALF + m * 16) * DM + col0;
#pragma unroll
                for (int bj = 0; bj < 2; ++bj) { const u32x4 gw = *(const u32x4*)(G + off + bj * HALF);
                    const f32x4 g0 = bf4_to_f32((u32x2){gw.x, gw.y}), g1 = bf4_to_f32((u32x2){gw.z, gw.w});
                    const f32x4 t0 = *(const f32x4*)(T + off + bj * HALF), t1 = *(const f32x4*)(T + off + bj * HALF + 4);
                    store8bf(O + off + bj * HALF, t0 + acc[ai][bj][m][0] * g0, t1 + acc[ai][bj][m][1] * g1); } }
    }
};
struct EpiResid {
    static constexpr bool PERM = false, AFTER_DRAIN = false;
    const float* base; float* out; const float* gate;
    __device__ __forceinline__ void operator()(const f32x4 (&acc)[2][2][4][2], const Unit& u, int wr, int wc, int fr, int fq) const {
        const int row0 = u.pm * BM + wr * 64 + fr, col0 = u.pn * BM + wc * 32 + 4 * fq;
        const float* gb = gate + (size_t)((u.pm * BM) >> 11) * NMOD + col0;
        f32x4 gv[2][2];
#pragma unroll
        for (int bj = 0; bj < 2; ++bj)
#pragma unroll
            for (int n = 0; n < 2; ++n) gv[bj][n] = *(const f32x4*)(gb + bj * HALF + n * 16);
#pragma unroll
        for (int ai = 0; ai < 2; ++ai)
#pragma unroll
            for (int m = 0; m < 4; ++m) { const size_t off = (size_t)(row0 + ai * HALF + m * 16) * DM + col0;
#pragma unroll
                for (int bj = 0; bj < 2; ++bj)
#pragma unroll
                    for (int n = 0; n < 2; ++n) *(f32x4*)(out + off + bj * HALF + n * 16) = *(const f32x4*)(base + off + bj * HALF + n * 16) + gv[bj][n] * acc[ai][bj][m][n]; }
    }
};
struct EpiSwiglu {
    static constexpr bool PERM = true, AFTER_DRAIN = false;
    bf16_t* O;
    __device__ __forceinline__ void operator()(const f32x4 (&acc)[2][2][4][2], const Unit& u, int wr, int wc, int fr, int fq) const {
        const int row0 = u.pm * BM + wr * 64 + fr, col0 = u.pn * HALF + wc * 32 + 8 * fq;
#pragma unroll
        for (int ai = 0; ai < 2; ++ai)
#pragma unroll
            for (int m = 0; m < 4; ++m) { bf16_t* rp = O + (size_t)(row0 + ai * HALF + m * 16) * DFF + col0;
                store8bf(rp, silu4(acc[ai][0][m][0]) * acc[ai][1][m][0], silu4(acc[ai][0][m][1]) * acc[ai][1][m][1]); }
    }
};

template <class Epi, class Sched, bool ALIGN_EPI = false, bool SP2 = false>
__device__ __forceinline__ void gemm_phase(PG8_LAS unsigned char* lds, const Gemm g, const Sched& S, const Epi& E) {
    int tid_ = threadIdx.x; asm volatile("" : "+v"(tid_));
    const int tid = tid_, wid = __builtin_amdgcn_readfirstlane(tid >> 6), lane = tid & 63, wr = wid >> 2, wc = wid & 3, fr = lane & 15, fq = lane >> 4;
    const int K = g.K, nt = K / BK;
    unsigned voffA[2], voffB[2];
#pragma unroll
    for (int i = 0; i < 2; ++i) { int R, C; stage_rc(tid * 16 + i * 8192, R, C); const int Rb = Epi::PERM ? ((R & ~31) + perm32(R & 31)) : R;
        voffA[i] = (unsigned)(R * K + C) * 2u; voffB[i] = (unsigned)(Rb * K + C) * 2u; }
    const size_t kstep = (size_t)(BK * 2);
    const size_t hstep = (size_t)HALF * K * 2;
    const size_t tstep = 2 * hstep;
    const unsigned ldsw = (unsigned)wid * 1024u;
    const int aoff = lds_byte(wr * 64 + fr, fq * 8), boff = lds_byte(wc * 32 + fr, fq * 8);
#define PG8_SA(b, h) (((b) * 2 + (h)) * HTB)
#define PG8_SB(b, h) ((4 + (b) * 2 + (h)) * HTB)
#define PG8_STAGE(bufoff, gbase, voff) do { _Pragma("unroll") for (int _i = 0; _i < 2; ++_i) \
        __builtin_amdgcn_global_load_lds((const unsigned*)((const char*)(gbase) + (voff)[_i]), (PG8_LAS unsigned*)(lds + (bufoff) + ldsw + _i * 8192), 16, 0, 0); } while (0)
#define PG8_LDA(dst, b, h) do { _Pragma("unroll") for (int m = 0; m < 4; ++m) _Pragma("unroll") for (int k = 0; k < 2; ++k) dst[m][k] = *(const PG8_LAS bf16x8*)(lds + PG8_SA(b, h) + aoff + m * 2048 + k * 1024); } while (0)
#define PG8_LDB(dst, b, h) do { _Pragma("unroll") for (int n = 0; n < 2; ++n) _Pragma("unroll") for (int k = 0; k < 2; ++k) dst[n][k] = *(const PG8_LAS bf16x8*)(lds + PG8_SB(b, h) + boff + n * 2048 + k * 1024); } while (0)
#define PG8_MMA(ai, bj, At, Bt) do { __builtin_amdgcn_s_setprio(1); _Pragma("unroll") for (int m = 0; m < 4; ++m) _Pragma("unroll") for (int n = 0; n < 2; ++n) _Pragma("unroll") for (int k = 0; k < 2; ++k) \
        acc[ai][bj][m][n] = __builtin_amdgcn_mfma_f32_16x16x32_bf16(Bt[n][k], At[m][k], acc[ai][bj][m][n], 0, 0, 0); __builtin_amdgcn_s_setprio(0); } while (0)
#define PG8_WAIT_V(n) asm volatile("s_waitcnt vmcnt(" #n ")" ::: "memory")
#define PG8_WAIT_L(n) asm volatile("s_waitcnt lgkmcnt(" #n ")" ::: "memory")
#define PG8_BAR __builtin_amdgcn_s_barrier()
#define PG8_SCHED __builtin_amdgcn_sched_barrier(0)
    Unit cur, nxt; int ui = 0;
    if (!S.next(0, cur)) return;
    f32x4 acc[2][2][4][2];
#pragma unroll
    for (int a = 0; a < 2; ++a)
#pragma unroll
        for (int b = 0; b < 2; ++b)
#pragma unroll
            for (int m = 0; m < 4; ++m)
#pragma unroll
                for (int n = 0; n < 2; ++n) acc[a][b][m][n] = (f32x4){0.f, 0.f, 0.f, 0.f};
    bf16x8 At[4][2], B0[2][2], B1[2][2];
    const char* cA = (const char*)g.A + (size_t)cur.pm * tstep; const char* cB = (const char*)g.Bt + (size_t)cur.pn * tstep;
    S.a_ready(cur);
    if constexpr (SP2) {
        PG8_STAGE(PG8_SB(0, 0), cB, voffB); PG8_STAGE(PG8_SB(0, 1), cB + hstep, voffB); PG8_STAGE(PG8_SA(0, 0), cA, voffA); PG8_STAGE(PG8_SA(0, 1), cA + hstep, voffA);
        if (wr == 1) PG8_BAR;
        PG8_WAIT_V(2); PG8_BAR;
        PG8_STAGE(PG8_SB(1, 0), cB + kstep, voffB); PG8_STAGE(PG8_SA(1, 0), cA + kstep, voffA); PG8_STAGE(PG8_SB(1, 1), cB + hstep + kstep, voffB);
        PG8_WAIT_V(6); PG8_BAR;
    } else {
        PG8_STAGE(PG8_SB(0, 0), cB, voffB); PG8_STAGE(PG8_SA(0, 0), cA, voffA); PG8_STAGE(PG8_SB(0, 1), cB + hstep, voffB); PG8_STAGE(PG8_SA(0, 1), cA + hstep, voffA);
        if (wr == 1) PG8_BAR;
        PG8_WAIT_V(4); PG8_BAR;
        PG8_STAGE(PG8_SB(1, 0), cB + kstep, voffB); PG8_STAGE(PG8_SA(1, 0), cA + kstep, voffA); PG8_STAGE(PG8_SB(1, 1), cB + hstep + kstep, voffB);
        PG8_WAIT_V(6); PG8_BAR;
    }
    for (;;) {
        const bool has_next = S.next(ui + 1, nxt);
        const char* nA = has_next ? (const char*)g.A + (size_t)nxt.pm * tstep : cA; const char* nB = has_next ? (const char*)g.Bt + (size_t)nxt.pn * tstep : cB;
        for (int t = 0; t < nt; t += 2) {
            const bool last = (t == nt - 2);
            const char* a1 = cA + (size_t)(t + 1) * kstep;
            const char* a2 = last ? nA : cA + (size_t)(t + 2) * kstep; const char* b2 = last ? nB : cB + (size_t)(t + 2) * kstep;
            const char* a3 = a2 + kstep; const char* b3 = b2 + kstep;
            if (last && has_next) S.a_ready(nxt);
            if constexpr (SP2) {
            PG8_LDB(B0, 0, 0); PG8_LDB(B1, 0, 1); PG8_SCHED; PG8_LDA(At, 0, 0); PG8_STAGE(PG8_SA(1, 1), a1 + hstep, voffA);
            PG8_WAIT_V(8); PG8_WAIT_L(0); PG8_BAR; PG8_MMA(0, 0, At, B0); PG8_MMA(0, 1, At, B1); PG8_BAR; PG8_SCHED;
            PG8_LDA(At, 0, 1); PG8_STAGE(PG8_SB(0, 0), b2, voffB); PG8_STAGE(PG8_SB(0, 1), b2 + hstep, voffB); PG8_STAGE(PG8_SA(0, 0), a2, voffA);
            PG8_WAIT_V(8); PG8_WAIT_L(0); PG8_BAR; PG8_MMA(1, 0, At, B0); PG8_MMA(1, 1, At, B1); PG8_BAR; PG8_SCHED;
            PG8_LDB(B0, 1, 0); PG8_LDB(B1, 1, 1); PG8_SCHED; PG8_LDA(At, 1, 0); PG8_STAGE(PG8_SA(0, 1), a2 + hstep, voffA);
            PG8_WAIT_V(8); PG8_WAIT_L(0); PG8_BAR; PG8_MMA(0, 0, At, B0); PG8_MMA(0, 1, At, B1); PG8_BAR; PG8_SCHED;
            PG8_LDA(At, 1, 1); PG8_STAGE(PG8_SB(1, 0), b3, voffB); PG8_STAGE(PG8_SB(1, 1), b3 + hstep, voffB); PG8_STAGE(PG8_SA(1, 0), a3, voffA);
            PG8_WAIT_V(8); PG8_WAIT_L(0); PG8_BAR; PG8_MMA(1, 0, At, B0); PG8_MMA(1, 1, At, B1); PG8_BAR; PG8_SCHED;
            } else {
            PG8_LDB(B0, 0, 0); PG8_SCHED; PG8_LDA(At, 0, 0); PG8_STAGE(PG8_SA(1, 1), a1 + hstep, voffA);
            PG8_WAIT_L(8); PG8_BAR; PG8_WAIT_L(0); PG8_MMA(0, 0, At, B0); PG8_BAR; PG8_SCHED;
            PG8_LDB(B1, 0, 1); PG8_STAGE(PG8_SB(0, 0), b2, voffB);
            PG8_BAR; PG8_WAIT_L(0); PG8_MMA(0, 1, At, B1); PG8_BAR;
            PG8_LDA(At, 0, 1); PG8_STAGE(PG8_SA(0, 0), a2, voffA);
            PG8_BAR; PG8_WAIT_L(0); PG8_MMA(1, 0, At, B0); PG8_BAR; PG8_SCHED;
            PG8_STAGE(PG8_SB(0, 1), b2 + hstep, voffB);
            PG8_WAIT_V(6); PG8_BAR; PG8_MMA(1, 1, At, B1); PG8_BAR;
            PG8_LDB(B0, 1, 0); PG8_SCHED; PG8_LDA(At, 1, 0); PG8_STAGE(PG8_SA(0, 1), a2 + hstep, voffA);
            PG8_WAIT_L(8); PG8_BAR; PG8_WAIT_L(0); PG8_MMA(0, 0, At, B0); PG8_BAR; PG8_SCHED;
            PG8_LDB(B1, 1, 1); PG8_STAGE(PG8_SB(1, 0), b3, voffB);
            PG8_BAR; PG8_WAIT_L(0); PG8_MMA(0, 1, At, B1); PG8_BAR;
            PG8_LDA(At, 1, 1); PG8_STAGE(PG8_SA(1, 0), a3, voffA);
            PG8_BAR; PG8_WAIT_L(0); PG8_MMA(1, 0, At, B0); PG8_BAR; PG8_SCHED;
            PG8_STAGE(PG8_SB(1, 1), b3 + hstep, voffB);
            PG8_WAIT_V(6); PG8_BAR; PG8_MMA(1, 1, At, B1); PG8_BAR;
            }
        }
        if constexpr (ALIGN_EPI) { if (wr == 0) PG8_BAR; }
        if constexpr (!Epi::AFTER_DRAIN) { E(acc, cur, wr, wc, fr, fq); S.done(cur); }
        if (!has_next) break;
#pragma unroll
        for (int a = 0; a < 2; ++a)
#pragma unroll
            for (int b = 0; b < 2; ++b)
#pragma unroll
                for (int m = 0; m < 4; ++m)
#pragma unroll
                    for (int n = 0; n < 2; ++n) acc[a][b][m][n] = (f32x4){0.f, 0.f, 0.f, 0.f};
        cur = nxt; cA = nA; cB = nB; ++ui;
        if constexpr (ALIGN_EPI) { if (wr == 1) PG8_BAR; }
    }
    PG8_WAIT_V(0);
    if constexpr (!ALIGN_EPI) { if (wr == 0) PG8_BAR; }
    PG8_BAR;
    if constexpr (Epi::AFTER_DRAIN) { E.fused(acc, cur, wr, wc, fr, fq, lds, wid, lane); S.done(cur); }
#undef PG8_SA
#undef PG8_SB
#undef PG8_STAGE
#undef PG8_LDA
#undef PG8_LDB
#undef PG8_MMA
#undef PG8_WAIT_V
#undef PG8_WAIT_L
#undef PG8_BAR
#undef PG8_SCHED
}
}

#define XB_TMO      128
#define XB_XCNT(j)  (256  + 64 * (j))
#define XB_XSUB(j)  (1280 + 64 * (j))
#define XB_XGEN(j)  (2304 + 64 * (j))
#define XB_TOP      3328
#define XB_TOPGEN   3392
#define XCD_BAR_WORDS 3456
#define XB_SPIN_CAP (1u << 18)

__device__ __forceinline__ unsigned xb_ld(unsigned* p)              { return __hip_atomic_load(p, __ATOMIC_RELAXED, __HIP_MEMORY_SCOPE_AGENT); }
__device__ __forceinline__ unsigned xb_add(unsigned* p, unsigned v) { return __hip_atomic_fetch_add(p, v, __ATOMIC_RELAXED, __HIP_MEMORY_SCOPE_AGENT); }
__device__ __forceinline__ unsigned xb_xcc_id() { return (unsigned)__builtin_amdgcn_s_getreg((3 << 11) | 20) & 0xFu; }
#define XB_SPIN(cond, bar) do { unsigned _sp = 0; while (cond) { __builtin_amdgcn_s_sleep(1); \
    if ((++_sp & 255u) == 0u) { if (xb_ld(&(bar)[XB_TMO])) break; if (_sp > XB_SPIN_CAP) { atomicAdd(&(bar)[XB_TMO], 1u); break; } } } } while (0)

struct XcdBarrier {
    unsigned* bar; unsigned x;
    volatile LAS unsigned* st;
};

__device__ __forceinline__ XcdBarrier xcd_barrier_post(unsigned* bar, volatile LAS unsigned* st) {
    XcdBarrier b; b.bar = bar; b.x = xb_xcc_id(); b.st = st;
    if (threadIdx.x == 0) (void)xb_add(&bar[XB_XCNT(b.x)], 1u);
    return b;
}
__device__ __forceinline__ void xcd_barrier_complete(unsigned* bar, unsigned x, unsigned& nloc, unsigned& nx) {
    const unsigned G = gridDim.x * gridDim.y * gridDim.z;
    unsigned sum, cnt, mine, sp = 0u;
    for (;;) {
        sum = 0u; cnt = 0u; mine = 0u;
#pragma unroll
        for (unsigned j = 0; j < 16; ++j) { const unsigned c = xb_ld(&bar[XB_XCNT(j)]); sum += c; cnt += (c > 0u) ? 1u : 0u; mine = (j == x) ? c : mine; }
        if (sum == G) break;
        __builtin_amdgcn_s_sleep(1);
        if ((++sp & 255u) == 0u) { if (xb_ld(&bar[XB_TMO])) break; if (sp > XB_SPIN_CAP) { atomicAdd(&bar[XB_TMO], 1u); break; } }
    }
    nloc = mine > 0u ? mine : 1u; nx = cnt > 0u ? cnt : 1u;
}

__device__ __forceinline__ void xcd_barrier(const XcdBarrier& b) {
    asm volatile("s_waitcnt vmcnt(0)" ::: "memory");
    __syncthreads();
    if (threadIdx.x == 0) {
        unsigned* bar = b.bar;
        __builtin_amdgcn_s_waitcnt(0);
        unsigned nloc = b.st[0], nx = b.st[1];
        if (nloc == 0u) { xcd_barrier_complete(bar, b.x, nloc, nx); b.st[0] = nloc; b.st[1] = nx; }
        const unsigned old = xb_add(&bar[XB_XSUB(b.x)], 1u);
        const unsigned gen = old / nloc;
        if (old + 1u == (gen + 1u) * nloc) {
            __builtin_amdgcn_fence(__ATOMIC_RELEASE, "agent");
            asm volatile("s_waitcnt vmcnt(0)" ::: "memory");
            const unsigned og = xb_add(&bar[XB_TOP], 1u);
            const unsigned tg = og / nx;
            if (og + 1u == (tg + 1u) * nx) xb_add(&bar[XB_TOPGEN], 1u);
            else XB_SPIN(xb_ld(&bar[XB_TOPGEN]) == tg, bar);
            __builtin_amdgcn_fence(__ATOMIC_ACQUIRE, "agent");
            xb_add(&bar[XB_XGEN(b.x)], 1u);
            asm volatile("s_waitcnt vmcnt(0)" ::: "memory");
        } else {
            XB_SPIN(xb_ld(&bar[XB_XGEN(b.x)]) == gen, bar);
            __builtin_amdgcn_fence(__ATOMIC_ACQUIRE, "agent");
            asm volatile("s_waitcnt vmcnt(0)" ::: "memory");
        }
    }
    __syncthreads();
}


struct Args { const float* in[17]; float* out; unsigned char* ws; int ph_lo, ph_hi; };

#define GAS __attribute__((address_space(1)))
struct Ctx { LAS unsigned char* lds; GAS unsigned char* ws; int tid, lane, wave, bid, G; };

#define LDS_WAIT() asm volatile("s_waitcnt lgkmcnt(0)" ::: "memory")
constexpr int LDS_PTAB = 147200;
__device__ __forceinline__ const float* INP(const Ctx& X, int i) {
    const volatile LAS unsigned* t = (const volatile LAS unsigned*)(X.lds + LDS_PTAB) + 2 * i;
    const unsigned lo = __builtin_amdgcn_readfirstlane(t[0]), hi = __builtin_amdgcn_readfirstlane(t[1]);
    return (const float*)(__attribute__((address_space(1))) const float*)(((unsigned long long)hi << 32) | lo);
}
#ifdef STAMP_A
#define STAMP(k) do { if (X.tid == 0) ((unsigned long long*)(X.ws + WS_DBG))[(k) * 256 + X.bid] = __builtin_amdgcn_s_memrealtime(); } while (0)
#else
#define STAMP(k) do { } while (0)
#endif
#define MFMA32(a, b, c) __builtin_amdgcn_mfma_f32_32x32x16_bf16((a), (b), (c), 0, 0, 0)
#define MFMA16(a, b, c) __builtin_amdgcn_mfma_f32_16x16x32_bf16((a), (b), (c), 0, 0, 0)

__device__ __forceinline__ int map_win(int n) {
    if (n < 1024) return SRC_GQ + n;
    if (n < 2048) return SRC_GK + (n - 1024);
    if (n < 4096) return SRC_GV + (n - 2048);
    if (n < 6144) return SRC_GR + (n - 4096);
    if (n < 8192) return SRC_DQ + (n - 6144);
    if (n < 10240) return SRC_DK + (n - 8192);
    if (n < 12288) return SRC_DV + (n - 10240);
    if (n < 14336) return SRC_GA + (n - 12288);
    if (n < 16384) return SRC_GB + (n - 14336);
    if (n < 16896) return SRC_IQ + (n - 16384);
    n -= 16896;
    if (n < 16) return SRC_GLR + n;
    if (n < 80) return SRC_IK + (n - 16);
    if (n < 88) return SRC_IW + (n - 80);
    return -1;
}
__device__ __forceinline__ int map_wgu(int n) { const int j = n >> 8, rr = n & 255; return rr < 128 ? 128 * j + rr : DFF + 128 * j + (rr - 128); }

__device__ __forceinline__ void transpose_item(const float* W, int N, bf16_t* WT, int K, LAS float* scr, int kb, int nb, int lane, int src) {
    const int k0 = 64 * kb, n0 = 32 * nb;
    const float* wp = W + (size_t)(k0 + (lane >> 5)) * N + (src >= 0 ? src : 0);
    float v[32];
#pragma unroll
    for (int i = 0; i < 32; ++i) v[i] = (src >= 0) ? wp[(size_t)(2 * i) * N] : 0.f;
#pragma unroll
    for (int i = 0; i < 32; ++i) scr[(2 * i + (lane >> 5)) * 33 + (lane & 31)] = v[i];
    LDS_WAIT();
    const int c = lane & 7;
#pragma unroll
    for (int j = 0; j < 4; ++j) { const int n = (lane >> 3) + 8 * j; const LAS float* s = scr + (8 * c) * 33 + n;
        u32x4 o; o.x = pk2(s[0 * 33], s[1 * 33]); o.y = pk2(s[2 * 33], s[3 * 33]); o.z = pk2(s[4 * 33], s[5 * 33]); o.w = pk2(s[6 * 33], s[7 * 33]);
        *(u32x4*)(WT + (size_t)(n0 + n) * K + k0 + 8 * c) = o; }
    LDS_WAIT();
}

#define TR_ISSUE(v_, W_, N_, kb_, src_) do { const float* wp_ = (W_) + (size_t)(64 * (kb_) + (lane >> 5)) * (N_) + ((src_) >= 0 ? (src_) : 0); \
        _Pragma("unroll") for (int i_ = 0; i_ < 32; ++i_) v_[i_] = ((src_) >= 0) ? __builtin_nontemporal_load(wp_ + (size_t)(2 * i_) * (N_)) : 0.f; } while (0)
#define TR_FINISH(v_, WT_, K_, kb_, nb_) do { \
        _Pragma("unroll") for (int i_ = 0; i_ < 32; ++i_) scr[(2 * i_ + (lane >> 5)) * 33 + (lane & 31)] = v_[i_]; \
        LDS_WAIT(); const int c_ = lane & 7; \
        _Pragma("unroll") for (int j_ = 0; j_ < 4; ++j_) { const int n_ = (lane >> 3) + 8 * j_; const LAS float* s_ = scr + (8 * c_) * 33 + n_; \
            u32x4 o_; o_.x = pk2(s_[0 * 33], s_[1 * 33]); o_.y = pk2(s_[2 * 33], s_[3 * 33]); o_.z = pk2(s_[4 * 33], s_[5 * 33]); o_.w = pk2(s_[6 * 33], s_[7 * 33]); \
            *(u32x4*)((WT_) + (size_t)(32 * (nb_) + n_) * (K_) + 64 * (kb_) + 8 * c_) = o_; } \
        LDS_WAIT(); } while (0)

struct TrItem { const float* W; bf16_t* WT; int N, K, kb, nb, src; };
__device__ __forceinline__ TrItem tr_decode(const Ctx& X, int it, int l31) {
    constexpr int I_IN = 32 * (INWP / 32), I_SQ = 32 * 64, I_GU = 32 * (2 * DFF / 32);
    GAS GAS unsigned char* ws = X.ws; TrItem t; int r = it;
    if (r < I_IN) { const int nbk = INWP / 32; t.kb = r / nbk; t.nb = r % nbk; t.W = INP(X, I_WIN); t.N = INW; t.WT = (bf16_t*)(ws + WS_WIN); t.K = DM; t.src = map_win(32 * t.nb + l31); return t; } r -= I_IN;
    if (r < 3 * I_SQ) { const int q = r / I_SQ; r -= q * I_SQ; t.kb = r / 64; t.nb = r % 64; t.W = INP(X, q == 0 ? I_WBGA : (q == 1 ? I_WBDSA : I_WMO)); t.N = DM; t.WT = (bf16_t*)(ws + (q == 0 ? WS_WBGA : (q == 1 ? WS_WBDSA : WS_WMO))); t.K = DM; t.src = 32 * t.nb + l31; return t; } r -= 3 * I_SQ;
    if (r < I_GU) { const int nbk = 2 * DFF / 32; t.kb = r / nbk; t.nb = r % nbk; t.W = INP(X, I_WGU); t.N = 2 * DFF; t.WT = (bf16_t*)(ws + WS_WGU); t.K = DM; t.src = map_wgu(32 * t.nb + l31); return t; } r -= I_GU;
    t.kb = r / 64; t.nb = r % 64; t.W = INP(X, I_WDN); t.N = DM; t.WT = (bf16_t*)(ws + WS_WDN); t.K = DFF; t.src = 32 * t.nb + l31; return t;
}

template <bool DO_MOD>
__device__ __forceinline__ void p0_prologue(const Ctx& X) {
    GAS unsigned char* ws = X.ws; const int lane = X.lane;
    const int gw = X.bid * NW + X.wave, NGW = X.G * NW;
    constexpr int NGV = 32 * 48;
    if (DO_MOD) for (int it = gw; it < NGV; it += NGW) {
        const int kc = it / 48, cb = it % 48, k0 = 64 * kc, col = cb * 256 + 4 * lane;
        const float* wada = INP(X, I_WADA); const float* cvec = INP(X, I_C);
        float scb[4];
#pragma unroll
        for (int b = 0; b < 4; ++b) scb[b] = siluf(cvec[b * DM + k0 + lane]);
        f32x4 acc[4];
#pragma unroll
        for (int b = 0; b < 4; ++b) acc[b] = (f32x4){0.f, 0.f, 0.f, 0.f};
#pragma unroll
        for (int hb = 0; hb < 2; ++hb) {
            f32x4 w[32];
#pragma unroll
            for (int kk = 0; kk < 32; ++kk) w[kk] = __builtin_nontemporal_load((const f32x4*)(wada + (size_t)(k0 + 32 * hb + kk) * NMOD + col));
#pragma unroll
            for (int kk = 0; kk < 32; ++kk)
#pragma unroll
                for (int b = 0; b < 4; ++b) acc[b] += w[kk] * __builtin_bit_cast(float, __builtin_amdgcn_readlane(__builtin_bit_cast(int, scb[b]), 32 * hb + kk));
            asm volatile("" ::: "memory");
        }
        float* part = (float*)(ws + WS_MODP);
#pragma unroll
        for (int b = 0; b < 4; ++b) *(f32x4*)(part + ((size_t)kc * 4 + b) * NMOD + col) = acc[b];
    }
    STAMP(14);
    {
        const int* pos = (const int*)INP(X, I_POS);
        float2* rd = (float2*)(ws + WS_ROPED); float2* ri = (float2*)(ws + WS_ROPEI);
        for (int i = X.bid * NT + X.tid; i < MTOK * 24; i += X.G * NT) {
            int m, j; float ex; float2* dst;
            if (i < MTOK * 16) { m = i >> 4; j = i & 15; ex = (float)j * (1.0f / 16.0f); dst = rd + i; }
            else { const int i2 = i - MTOK * 16; m = i2 >> 3; j = i2 & 7; ex = (float)j * (1.0f / 8.0f); dst = ri + i2; }
            const float inv = exp2f(-ex * 18.931568569324174f);
            const float ang = (float)pos[m] * inv;
            double r = (double)ang * 0.15915494309189535; r -= rint(r);
            const float ar = (float)(r * 6.283185307179586);
            *dst = make_float2(__cosf(ar), __sinf(ar));
        }
    }
    STAMP(15);
    {
        LAS float* scr = (LAS float*)(X.lds + 1024 + X.wave * 8704);
        constexpr int NITEMS = 32 * (INWP / 32) + 3 * 32 * 64 + 32 * (2 * DFF / 32) + (DFF / 64) * 64;
        const int nx = (NGW > NGV) ? (NGW - NGV) : 0, NEXTRA = (DO_MOD && 8 * nx < NITEMS) ? 8 * nx : 0;
        const int nmine_x = (DO_MOD && gw >= NGV && NEXTRA) ? 8 : 0;
        auto item_of = [&](int k) -> int { if (k < nmine_x) return (gw - NGV) * 8 + k; const int it = NEXTRA + gw + (k - nmine_x) * NGW; return it < NITEMS ? it : -1; };
        float va[32], vb[32];
        int k = 0, ia = item_of(0);
        TrItem A, B; A.kb = 0; B.kb = 0;
        if (ia >= 0) { A = tr_decode(X, ia, lane & 31); TR_ISSUE(va, A.W, A.N, A.kb, A.src); }
        while (ia >= 0) {
            const int ib = item_of(k + 1);
            if (ib >= 0) { B = tr_decode(X, ib, lane & 31); TR_ISSUE(vb, B.W, B.N, B.kb, B.src); }
            TR_FINISH(va, A.WT, A.K, A.kb, A.nb);
            if (ib < 0) break;
            const int ic = item_of(k + 2);
            if (ic >= 0) { A = tr_decode(X, ic, lane & 31); TR_ISSUE(va, A.W, A.N, A.kb, A.src); }
            TR_FINISH(vb, B.WT, B.K, B.kb, B.nb);
            ia = ic; k += 2;
        }
    }
}

__device__ __forceinline__ void norm_mod_rows(const Ctx& X, const float* x, const float* gain, const float* mod, int i_sh, int i_sc, bf16_t* out) {
    const int gw = X.bid * NW + X.wave, NGW = X.G * NW;
    for (int row = gw; row < MTOK; row += NGW) {
        const int b = row >> 11;
        const f32x4* xr = (const f32x4*)(x + (size_t)row * DM) + X.lane;
        f32x4 v[8]; float s = 0.f;
#pragma unroll
        for (int j = 0; j < 8; ++j) { v[j] = xr[64 * j]; s += (v[j][0] * v[j][0] + v[j][1] * v[j][1]) + (v[j][2] * v[j][2] + v[j][3] * v[j][3]); }
        const float rs = rsqrtf(wave_sum(s) * (1.f / DM) + RMS_EPS);
        const f32x4* g4 = (const f32x4*)gain + X.lane;
        const f32x4* sh4 = (const f32x4*)(mod + (size_t)b * NMOD + i_sh * DM) + X.lane;
        const f32x4* sc4 = (const f32x4*)(mod + (size_t)b * NMOD + i_sc * DM) + X.lane;
        u32x2* o8 = (u32x2*)(out + (size_t)row * DM) + X.lane;
#pragma unroll
        for (int j = 0; j < 8; ++j) { const f32x4 y = v[j] * rs * g4[64 * j] * (sc4[64 * j] + 1.f) + sh4[64 * j]; u32x2 w; w.x = pk2(y[0], y[1]); w.y = pk2(y[2], y[3]); o8[64 * j] = w; }
    }
}
__device__ __forceinline__ void norm1_rows(const Ctx& X, const float* x, const float* gain, const float* bada, float* mod, bf16_t* out) {
    const float* part = (const float*)(X.ws + WS_MODP);
    for (int o = X.bid * NT + X.tid; o < 4 * NMOD; o += X.G * NT) { const int bb = o / NMOD, n = o % NMOD; float t = bada[n];
#pragma unroll
        for (int kc = 0; kc < 32; ++kc) t += part[((size_t)kc * 4 + bb) * NMOD + n];
        mod[o] = t; }
    const int nbp = X.G >> 2, b = (X.bid / nbp) < 3 ? (X.bid / nbp) : 3, lb = X.bid - b * nbp, nbb = (b == 3) ? (X.G - 3 * nbp) : nbp;
    LAS float* shs = (LAS float*)X.lds;
    for (int n = X.tid; n < 2 * DM; n += NT) { float t = bada[n];
#pragma unroll
        for (int kc = 0; kc < 32; ++kc) t += part[((size_t)kc * 4 + b) * NMOD + n];
        shs[n] = t; }
    __syncthreads();
    for (int rl = lb * NW + X.wave; rl < SEQ; rl += nbb * NW) {
        const int row = b * SEQ + rl;
        const f32x4* xr = (const f32x4*)(x + (size_t)row * DM) + X.lane;
        f32x4 v[8]; float s = 0.f;
#pragma unroll
        for (int j = 0; j < 8; ++j) { v[j] = xr[64 * j]; s += (v[j][0] * v[j][0] + v[j][1] * v[j][1]) + (v[j][2] * v[j][2] + v[j][3] * v[j][3]); }
        const float rs = rsqrtf(wave_sum(s) * (1.f / DM) + RMS_EPS);
        const f32x4* g4 = (const f32x4*)gain + X.lane;
        u32x2* o8 = (u32x2*)(out + (size_t)row * DM) + X.lane;
#pragma unroll
        for (int j = 0; j < 8; ++j) { const f32x4 sh = *(const LAS f32x4*)(shs + 4 * (X.lane + 64 * j)), sc = *(const LAS f32x4*)(shs + DM + 4 * (X.lane + 64 * j));
            const f32x4 y = v[j] * rs * g4[64 * j] * (sc + 1.f) + sh; u32x2 w; w.x = pk2(y[0], y[1]); w.y = pk2(y[2], y[3]); o8[64 * j] = w; }
    }
    __syncthreads();
}
__device__ __forceinline__ void final_norm_rows(const Ctx& X, float* x, const float* gain) {
    const int gw = X.bid * NW + X.wave, NGW = X.G * NW;
    for (int row = gw; row < MTOK; row += NGW) {
        f32x4* xr = (f32x4*)(x + (size_t)row * DM) + X.lane;
        f32x4 v[8]; float s = 0.f;
#pragma unroll
        for (int j = 0; j < 8; ++j) { v[j] = xr[64 * j]; s += (v[j][0] * v[j][0] + v[j][1] * v[j][1]) + (v[j][2] * v[j][2] + v[j][3] * v[j][3]); }
        const float rs = rsqrtf(wave_sum(s) * (1.f / DM) + RMS_EPS);
        const f32x4* g4 = (const f32x4*)gain + X.lane;
#pragma unroll
        for (int j = 0; j < 8; ++j) xr[64 * j] = v[j] * rs * g4[64 * j];
    }
}

__device__ __forceinline__ float log_sigmoid_f(float z) { return fminf(z, 0.f) - __logf(1.f + __expf(-fabsf(z))); }

__device__ __forceinline__ void gla_prep_unit(const Ctx& X, const Args& a, int u) {
    GAS unsigned char* ws = X.ws; const int tid = X.tid, lane = X.lane, wave = X.wave;
    LAS bf16_t* qs = (LAS bf16_t*)X.lds;
    LAS bf16_t* ks = (LAS bf16_t*)(X.lds + 33792);
    LAS float* glr = (LAS float*)(X.lds + 67584);
    LAS float* tot = (LAS float*)(X.lds + 71680);
    const int h = u & 3, row0 = (u >> 2) * 64;
    bf16_t* qblk = (bf16_t*)(ws + WS_QA) + (size_t)u * 64 * 256;
    bf16_t* kblk = (bf16_t*)(ws + WS_KA) + (size_t)u * 64 * 256;
    const float* small = (const float*)(ws + WS_SMALL);
    for (int i = tid; i < 1024; i += NT) glr[i] = small[(size_t)(row0 + (i >> 4)) * SMALLW + 512 + (i & 15)];
#pragma unroll
    for (int i = 0; i < 4; ++i) { const int id = tid + NT * i, t = id >> 5, c16 = id & 31;
        *(LAS u32x4*)(qs + t * 264 + 8 * c16) = *(const u32x4*)(qblk + t * 256 + 8 * c16); *(LAS u32x4*)(ks + t * 264 + 8 * c16) = *(const u32x4*)(kblk + t * 256 + 8 * c16); }
    const int d = tid & 255, half = tid >> 8;
    float up[16];
#pragma unroll
    for (int r = 0; r < 16; ++r) up[r] = INP(X, I_GUP)[r * 1024 + h * 256 + d];
    const float bias = INP(X, I_GBIAS)[h * 256 + d];
    __syncthreads();
    float lg[32]; float tsum = 0.f;
#pragma unroll
    for (int tt = 0; tt < 32; ++tt) { const int t = 32 * half + tt; float z = bias;
        const LAS f32x4* gp = (const LAS f32x4*)(glr + t * 16);
#pragma unroll
        for (int r4 = 0; r4 < 4; ++r4) { const f32x4 g4 = gp[r4]; z += g4[0] * up[4 * r4] + g4[1] * up[4 * r4 + 1] + g4[2] * up[4 * r4 + 2] + g4[3] * up[4 * r4 + 3]; }
        tsum += log_sigmoid_f(z) * 0.0625f; lg[tt] = tsum; }
    if (half == 0) tot[d] = tsum;
    __syncthreads();
    const float cum0 = half ? tot[d] : 0.f; float cum = cum0;
#pragma unroll
    for (int tt = 0; tt < 32; ++tt) { const int t = 32 * half + tt; cum = cum0 + lg[tt];
        const float qv = bf2f(qs[t * 264 + d]), kv = bf2f(ks[t * 264 + d]); const float e = __expf(cum);
        qs[t * 264 + d] = (bf16_t)f2bf(qv * e * 0.0625f); ks[t * 264 + d] = (bf16_t)f2bf(kv * __frcp_rn(e)); }
    if (half == 1) ((float*)(ws + WS_GDEC))[(size_t)u * 256 + d] = expf(cum);
    __syncthreads();
#pragma unroll
    for (int i = 0; i < 4; ++i) { const int id = tid + NT * i, t = id >> 5, c16 = id & 31; *(u32x4*)(qblk + t * 256 + 8 * c16) = *(const LAS u32x4*)(qs + t * 264 + 8 * c16); }
    {
        u32x4* dst = (u32x4*)(kblk + d * 64 + 32 * half);
#pragma unroll
        for (int i = 0; i < 4; ++i) { unsigned e[8];
#pragma unroll
            for (int k = 0; k < 8; ++k) e[k] = ks[(32 * half + 8 * i + k) * 264 + d];
            dst[i] = (u32x4){e[0] | (e[1] << 16), e[2] | (e[3] << 16), e[4] | (e[5] << 16), e[6] | (e[7] << 16)}; }
    }
    if (wave < 4) {
        const int ti = wave >> 1, tj = wave & 1, r32 = lane & 31, hi = lane >> 5;
        f32x16 acc;
#pragma unroll
        for (int r = 0; r < 16; ++r) acc[r] = 0.f;
#pragma unroll
        for (int s = 0; s < 16; ++s) { const bf16x8 af = *(const LAS bf16x8*)(qs + (32 * ti + r32) * 264 + 16 * s + 8 * hi); const bf16x8 bf = *(const LAS bf16x8*)(ks + (32 * tj + r32) * 264 + 16 * s + 8 * hi); acc = MFMA32(af, bf, acc); }
        bf16_t* at = (bf16_t*)(ws + WS_ATTN) + (size_t)u * 4096;
#pragma unroll
        for (int r = 0; r < 16; ++r) { const int i = 32 * ti + crow(r, hi), j = 32 * tj + r32; at[i * 64 + j] = (bf16_t)f2bf(j <= i ? acc[r] : 0.f); }
    }
    __syncthreads();
    {
        LAS bf16_t* vs = (LAS bf16_t*)X.lds;
        bf16_t* vblk = (bf16_t*)(ws + WS_VA) + (size_t)u * 64 * 512;
#pragma unroll
        for (int i = 0; i < 8; ++i) { const int id = tid + NT * i, t = id >> 6, c16 = id & 63; *(LAS u32x4*)(vs + t * 520 + 8 * c16) = *(const u32x4*)(vblk + t * 512 + 8 * c16); }
        __syncthreads();
#pragma unroll
        for (int i = 0; i < 8; ++i) { const int id = tid + NT * i, tq = id & 7, dv = id >> 3; unsigned e[8];
#pragma unroll
            for (int k = 0; k < 8; ++k) e[k] = vs[(8 * tq + k) * 520 + dv];
            *(u32x4*)(vblk + dv * 64 + 8 * tq) = (u32x4){e[0] | (e[1] << 16), e[2] | (e[3] << 16), e[4] | (e[5] << 16), e[6] | (e[7] << 16)}; }
    }
    __syncthreads();
}

__device__ __forceinline__ void dv_transpose(const Ctx& X) {
    LAS bf16_t* scr = (LAS bf16_t*)(X.lds + X.wave * 17408);
    const int gw = X.bid * NW + X.wave, NGW = X.G * NW, lane = X.lane;
    for (int blk = gw; blk < BATCH * NCH * DH; blk += NGW) {
        bf16_t* p = (bf16_t*)(X.ws + WS_DV) + (size_t)blk * 64 * 128;
#pragma unroll
        for (int i = 0; i < 16; ++i) { const int id = lane + 64 * i, t = id >> 4, c16 = id & 15; *(LAS u32x4*)(scr + t * 136 + 8 * c16) = *(const u32x4*)(p + t * 128 + 8 * c16); }
        LDS_WAIT();
#pragma unroll
        for (int i = 0; i < 16; ++i) { const int id = lane + 64 * i, kq = id & 7, dd = id >> 3; unsigned e[8];
#pragma unroll
            for (int k = 0; k < 8; ++k) e[k] = scr[(8 * kq + k) * 136 + dd];
            *(u32x4*)(p + dd * 64 + 8 * kq) = (u32x4){e[0] | (e[1] << 16), e[2] | (e[3] << 16), e[4] | (e[5] << 16), e[6] | (e[7] << 16)}; }
        LDS_WAIT();
    }
}

__device__ __forceinline__ void idx_prep(const Ctx& X) {
    const int gw = X.bid * NW + X.wave, NGW = X.G * NW, lane = X.lane;
    const float* small = (const float*)(X.ws + WS_SMALL);
    const float2* ri = (const float2*)(X.ws + WS_ROPEI);
    for (int m = gw; m < MTOK; m += NGW) {
        const float* sr = small + (size_t)m * SMALLW;
        float2 cs[8];
#pragma unroll
        for (int e = 0; e < 8; ++e) cs[e] = ri[(size_t)m * 8 + e];
        {
            const int seg = lane & 7; float v[8];
            const f32x4 a0 = *(const f32x4*)(sr + 8 * lane), a1 = *(const f32x4*)(sr + 8 * lane + 4);
            v[0] = a0[0]; v[1] = a0[1]; v[2] = a0[2]; v[3] = a0[3]; v[4] = a1[0]; v[5] = a1[1]; v[6] = a1[2]; v[7] = a1[3];
#pragma unroll
            for (int e = 0; e < 8; ++e) { const float p = __shfl_xor(v[e], 1); if (seg == 0) v[e] = v[e] * cs[e].x - p * cs[e].y; else if (seg == 1) v[e] = p * cs[e].y + v[e] * cs[e].x; }
            *(u32x4*)((bf16_t*)(X.ws + WS_IQ) + (size_t)m * 512 + 8 * lane) = (u32x4){pk2(v[0], v[1]), pk2(v[2], v[3]), pk2(v[4], v[5]), pk2(v[6], v[7])};
        }
        {
            const int l7 = lane & 7; float v[8];
            const f32x4 a0 = *(const f32x4*)(sr + 528 + 8 * l7), a1 = *(const f32x4*)(sr + 528 + 8 * l7 + 4);
            v[0] = a0[0]; v[1] = a0[1]; v[2] = a0[2]; v[3] = a0[3]; v[4] = a1[0]; v[5] = a1[1]; v[6] = a1[2]; v[7] = a1[3];
#pragma unroll
            for (int e = 0; e < 8; ++e) { const float p = __shfl_xor(v[e], 1); if (l7 == 0) v[e] = v[e] * cs[e].x - p * cs[e].y; else if (l7 == 1) v[e] = p * cs[e].y + v[e] * cs[e].x; }
            if (lane < 8) *(u32x4*)((bf16_t*)(X.ws + WS_IK) + (size_t)m * 64 + 8 * lane) = (u32x4){pk2(v[0], v[1]), pk2(v[2], v[3]), pk2(v[4], v[5]), pk2(v[6], v[7])};
            if (lane < 8) ((float*)(X.ws + WS_IW))[(size_t)m * 8 + lane] = sr[592 + lane] * 0.044194173824159216f;
        }
    }
}

__device__ __forceinline__ void rope_qk(const Ctx& X) {
    const int gw = X.bid * NW + X.wave, NGW = X.G * NW, lane = X.lane, seg = lane & 3;
    const float sg = (seg < 2) ? -1.f : 1.f;
    for (int m = gw; m < MTOK; m += NGW) {
        const f32x4* cs = (const f32x4*)((const float2*)(X.ws + WS_ROPED) + (size_t)m * 16 + 8 * (seg & 1));
        const f32x4 c01 = cs[0], c23 = cs[1], c45 = cs[2], c67 = cs[3];
#pragma unroll
        for (int which = 0; which < 2; ++which) {
            bf16_t* p = (bf16_t*)(X.ws + (which ? WS_DK : WS_DQ)) + (size_t)m * DM + (lane >> 2) * DHD + 8 * seg;
            const u32x4 w = *(const u32x4*)p;
            float v[8] = {bf2f(w.x & 0xffffu), bf2f(w.x >> 16), bf2f(w.y & 0xffffu), bf2f(w.y >> 16), bf2f(w.z & 0xffffu), bf2f(w.z >> 16), bf2f(w.w & 0xffffu), bf2f(w.w >> 16)};
            float q[8];
#pragma unroll
            for (int e = 0; e < 8; ++e) q[e] = __shfl_xor(v[e], 2);
            v[0] = v[0] * c01[0] + sg * q[0] * c01[1]; v[1] = v[1] * c01[2] + sg * q[1] * c01[3]; v[2] = v[2] * c23[0] + sg * q[2] * c23[1]; v[3] = v[3] * c23[2] + sg * q[3] * c23[3];
            v[4] = v[4] * c45[0] + sg * q[4] * c45[1]; v[5] = v[5] * c45[2] + sg * q[5] * c45[3]; v[6] = v[6] * c67[0] + sg * q[6] * c67[1]; v[7] = v[7] * c67[2] + sg * q[7] * c67[3];
            *(u32x4*)p = (u32x4){pk2(v[0], v[1]), pk2(v[2], v[3]), pk2(v[4], v[5]), pk2(v[6], v[7])};
        }
    }
}

constexpr int LDS_MISC = 143360;
__device__ __forceinline__ void gla_scan_unit(const Ctx& X, int unit) {
    GAS unsigned char* ws = X.ws; const int tid = X.tid, lane = X.lane, wave = X.wave, r32 = lane & 31, hi = lane >> 5;
    const int p = unit & 15, sl = unit >> 4, b = p >> 2, h = p & 3, j = wave & 1, g = wave >> 1;
    LAS bf16_t* qs = (LAS bf16_t*)X.lds;
    LAS bf16_t* kts = (LAS bf16_t*)(X.lds + 33792);
    LAS bf16_t* as_ = (LAS bf16_t*)(X.lds + 70656);
    LAS bf16_t* vts = (LAS bf16_t*)(X.lds + 79872);
    LAS float* gd = (LAS float*)(X.lds + 89088);
    LAS unsigned char* po = X.lds + 90112;
    f32x16 S[2];
#pragma unroll
    for (int k = 0; k < 2; ++k)
#pragma unroll
        for (int r = 0; r < 16; ++r) S[k][r] = 0.f;
    float* oa = (float*)(ws + WS_OA);
    u32x4 pqA[4], pkA[4], pqB[4], pkB[4], pa1, pv1; f32x4 pg1 = (f32x4){0.f, 0.f, 0.f, 0.f};
#define SCAN_ISSUE_BIG(c_, pq, pk) do { const int ub_ = (b * NCH + (c_)) * 4 + h; \
        const bf16_t* qblk_ = (const bf16_t*)(ws + WS_QA) + (size_t)ub_ * 64 * 256; const bf16_t* kblk_ = (const bf16_t*)(ws + WS_KA) + (size_t)ub_ * 64 * 256; \
        _Pragma("unroll") for (int i_ = 0; i_ < 4; ++i_) { const int id_ = tid + NT * i_; pq[i_] = *(const u32x4*)(qblk_ + (id_ >> 5) * 256 + 8 * (id_ & 31)); pk[i_] = *(const u32x4*)(kblk_ + (id_ >> 3) * 64 + 8 * (id_ & 7)); } } while (0)
#define SCAN_ISSUE_SMALL(c_) do { const int ub_ = (b * NCH + (c_)) * 4 + h; \
        const bf16_t* vblk_ = (const bf16_t*)(ws + WS_VA) + (size_t)ub_ * 64 * 512 + (size_t)(64 * sl) * 64; const bf16_t* ablk_ = (const bf16_t*)(ws + WS_ATTN) + (size_t)ub_ * 4096; \
        pa1 = *(const u32x4*)(ablk_ + (tid >> 3) * 64 + 8 * (tid & 7)); pv1 = *(const u32x4*)(vblk_ + (tid >> 3) * 64 + 8 * (tid & 7)); \
        pg1 = *(const f32x4*)((const float*)(ws + WS_GDEC) + (size_t)ub_ * 256 + 4 * (tid & 63)); } while (0)
#define SCAN_COMMIT_BIG(pq, pk) do { \
        _Pragma("unroll") for (int i_ = 0; i_ < 4; ++i_) { const int id_ = tid + NT * i_; *(LAS u32x4*)(qs + (id_ >> 5) * 264 + 8 * (id_ & 31)) = pq[i_]; *(LAS u32x4*)(kts + (id_ >> 3) * 72 + 8 * (id_ & 7)) = pk[i_]; } } while (0)
#define SCAN_COMMIT_SMALL() do { \
        *(LAS u32x4*)(as_ + (tid >> 3) * 72 + 8 * (tid & 7)) = pa1; *(LAS u32x4*)(vts + (tid >> 3) * 72 + 8 * (tid & 7)) = pv1; \
        if (tid < 64) *(LAS f32x4*)(gd + 4 * tid) = pg1; } while (0)
#define SCAN_BAR() do { asm volatile("s_waitcnt lgkmcnt(0)" ::: "memory"); __builtin_amdgcn_s_barrier(); asm volatile("" ::: "memory"); } while (0)
#define SCAN_STEP(c_, ISSUE_, COMMIT_) do { \
        ISSUE_; \
        f32x16 o[2]; \
        _Pragma("unroll") for (int tt = 0; tt < 2; ++tt) _Pragma("unroll") for (int r = 0; r < 16; ++r) o[tt][r] = 0.f; \
          \
        _Pragma("unroll") for (int kk = 0; kk < 2; ++kk) _Pragma("unroll") for (int s = 0; s < 2; ++s) { \
                u32x4 sw; sw.x = pg8::cvt_pk_bf16(S[kk][8 * s + 0], S[kk][8 * s + 1]); sw.y = pg8::cvt_pk_bf16(S[kk][8 * s + 2], S[kk][8 * s + 3]); \
                sw.z = pg8::cvt_pk_bf16(S[kk][8 * s + 4], S[kk][8 * s + 5]); sw.w = pg8::cvt_pk_bf16(S[kk][8 * s + 6], S[kk][8 * s + 7]); \
                const bf16x8 bs = __builtin_bit_cast(bf16x8, sw); \
                _Pragma("unroll") for (int tt = 0; tt < 2; ++tt) { const LAS bf16_t* qp = qs + (32 * tt + r32) * 264 + 64 * g + 32 * kk + 16 * s + 4 * hi; \
                    const u32x2 lo = *(const LAS u32x2*)qp, hi2 = *(const LAS u32x2*)(qp + 8); \
                    const bf16x8 af = __builtin_bit_cast(bf16x8, (u32x4){lo.x, lo.y, hi2.x, hi2.y}); \
                    o[tt] = MFMA32(af, bs, o[tt]); } } \
        asm volatile("" ::: "memory"); \
        bf16x8 bv[4]; \
        _Pragma("unroll") for (int s = 0; s < 4; ++s) bv[s] = *(const LAS bf16x8*)(vts + (32 * j + r32) * 72 + 16 * s + 8 * hi); \
        if (g == 0) { \
            _Pragma("unroll") for (int tt = 0; tt < 2; ++tt) _Pragma("unroll") for (int s = 0; s < 4; ++s) { const bf16x8 af = *(const LAS bf16x8*)(as_ + (32 * tt + r32) * 72 + 16 * s + 8 * hi); o[tt] = MFMA32(af, bv[s], o[tt]); } } \
          \
        _Pragma("unroll") for (int q = 0; q < 4; ++q) if (q != g) { const int rank_ = g < q ? g : g - 1; \
            _Pragma("unroll") for (int tt = 0; tt < 2; ++tt) \
                *(LAS f32x4*)(po + ((((q * 2 + j) * 3 + rank_) * 2 + tt) * 64 + lane) * 16) = (f32x4){o[tt][4 * q], o[tt][4 * q + 1], o[tt][4 * q + 2], o[tt][4 * q + 3]}; } \
        asm volatile("" ::: "memory"); \
        _Pragma("unroll") for (int kk = 0; kk < 2; ++kk) { \
            _Pragma("unroll") for (int s = 0; s < 4; ++s) { const bf16x8 af = *(const LAS bf16x8*)(kts + (64 * g + 32 * kk + r32) * 72 + 16 * s + 8 * hi); S[kk] = MFMA32(af, bv[s], S[kk]); } \
            _Pragma("unroll") for (int q4 = 0; q4 < 4; ++q4) { const f32x4 dv = *(const LAS f32x4*)(gd + 64 * g + 32 * kk + 8 * q4 + 4 * hi); \
                _Pragma("unroll") for (int jj = 0; jj < 4; ++jj) S[kk][4 * q4 + jj] *= dv[jj]; } } \
        SCAN_BAR(); \
        {   \
            _Pragma("unroll") for (int tt = 0; tt < 2; ++tt) { \
                f32x4 own = (f32x4){o[tt][0], o[tt][1], o[tt][2], o[tt][3]}; \
                if (g == 1) own = (f32x4){o[tt][4], o[tt][5], o[tt][6], o[tt][7]}; else if (g == 2) own = (f32x4){o[tt][8], o[tt][9], o[tt][10], o[tt][11]}; else if (g == 3) own = (f32x4){o[tt][12], o[tt][13], o[tt][14], o[tt][15]}; \
                _Pragma("unroll") for (int rk = 0; rk < 3; ++rk) own += *(const LAS f32x4*)(po + ((((g * 2 + j) * 3 + rk) * 2 + tt) * 64 + lane) * 16); \
                float* op_ = oa + ((size_t)((((b * NCH + (c_)) * 4 + h) * 8 + sl) * 2 + j) * 32 + tt * 16 + 4 * g) * 64 + lane; \
                op_[0] = own[0]; op_[64] = own[1]; op_[128] = own[2]; op_[192] = own[3]; } } \
        COMMIT_; \
        SCAN_BAR(); } while (0)
    __syncthreads();
    SCAN_ISSUE_BIG(0, pqA, pkA); SCAN_ISSUE_SMALL(0); SCAN_COMMIT_BIG(pqA, pkA); SCAN_COMMIT_SMALL();
    SCAN_ISSUE_BIG(1, pqB, pkB);
    __syncthreads();
#pragma unroll 1
    for (int c = 0; c < NCH; c += 2) {
        SCAN_STEP(c, do { SCAN_ISSUE_BIG(((c + 2 < NCH) ? c + 2 : NCH - 1), pqA, pkA); SCAN_ISSUE_SMALL(c + 1); } while (0), do { SCAN_COMMIT_BIG(pqB, pkB); SCAN_COMMIT_SMALL(); } while (0));
        SCAN_STEP(c + 1, do { SCAN_ISSUE_BIG(((c + 3 < NCH) ? c + 3 : NCH - 1), pqB, pkB); SCAN_ISSUE_SMALL(((c + 2 < NCH) ? c + 2 : NCH - 1)); } while (0), do { SCAN_COMMIT_BIG(pqA, pkA); SCAN_COMMIT_SMALL(); } while (0));
    }
    __syncthreads();
#undef SCAN_ISSUE_BIG
#undef SCAN_ISSUE_SMALL
#undef SCAN_COMMIT_BIG
#undef SCAN_COMMIT_SMALL
#undef SCAN_STEP
#undef SCAN_BAR
}

__device__ __forceinline__ unsigned fkey(float f) { const unsigned u = __float_as_uint(f); return (u & 0x80000000u) ? ~u : (u | 0x80000000u); }
__device__ __forceinline__ void idx_topk_unit(const Ctx& X, int unit) {
    GAS unsigned char* ws = X.ws; const int lane = X.lane, wave = X.wave;
    const int b = unit >> 7, qb = unit & 127, q0 = 16 * qb;
    LAS float* sc = (LAS float*)X.lds;
    const bf16_t* IQ = (const bf16_t*)(ws + WS_IQ); const bf16_t* IK = (const bf16_t*)(ws + WS_IK); const float* IW = (const float*)(ws + WS_IW);
    const int l15 = lane & 15, l4 = lane >> 4;
    {
        bf16x8 bq[8][2]; float wq[8];
        const size_t mq = (size_t)(b * SEQ + q0 + l15);
#pragma unroll
        for (int hh = 0; hh < 8; ++hh) { wq[hh] = IW[mq * 8 + hh];
#pragma unroll
            for (int s = 0; s < 2; ++s) bq[hh][s] = *(const bf16x8*)(IQ + mq * 512 + hh * 64 + 32 * s + 8 * l4); }
        const int ntile = qb + 1;
        for (int tile0 = wave; tile0 < ntile; tile0 += 4 * NW) {
            bf16x8 ka[4][2];
#pragma unroll
            for (int e = 0; e < 4; ++e) { const int tl = (tile0 + NW * e < ntile) ? tile0 + NW * e : ntile - 1; const size_t mk = (size_t)(b * SEQ + 16 * tl + l15);
                ka[e][0] = *(const bf16x8*)(IK + mk * 64 + 8 * l4); ka[e][1] = *(const bf16x8*)(IK + mk * 64 + 32 + 8 * l4); }
#pragma unroll
            for (int e = 0; e < 4; ++e) { const int tile = tile0 + NW * e;
                if (tile < ntile) {
                    f32x4 s4 = (f32x4){0.f, 0.f, 0.f, 0.f};
#pragma unroll
                    for (int hh = 0; hh < 8; ++hh) { f32x4 acc = (f32x4){0.f, 0.f, 0.f, 0.f}; acc = MFMA16(ka[e][0], bq[hh][0], acc); acc = MFMA16(ka[e][1], bq[hh][1], acc);
#pragma unroll
                        for (int r = 0; r < 4; ++r) s4[r] += wq[hh] * fmaxf(acc[r], 0.f); }
                    *(LAS f32x4*)(sc + l15 * 2048 + 16 * tile + 4 * l4) = s4;
                } }
        }
    }
    __syncthreads();
    unsigned long long* mask = (unsigned long long*)(ws + WS_MASK);
    for (int qi = 0; qi < 2; ++qi) {
        const int q = 2 * wave + qi, t = q0 + q, n = t + 1;
        unsigned long long myw = 0ull;
        if (n <= TOPK) {
            const int lo = 64 * lane;
            if (lo + 63 <= t) myw = ~0ull; else if (lo <= t) myw = (~0ull) >> (63 - (t - lo));
        } else {
            unsigned u[32];
#pragma unroll
            for (int r = 0; r < 32; ++r) { const int key = 64 * r + lane; u[r] = (key <= t) ? fkey(sc[q * 2048 + (key <= t ? key : 0)]) : 0u; }
            unsigned T = 0u; bool exact = false;
            for (int bit = 31; bit >= 0; --bit) { const unsigned cand = T | (1u << bit); int c0 = 0, c1 = 0, c2 = 0, c3 = 0;
#pragma unroll
                for (int r = 0; r < 32; r += 4) { c0 += (u[r] >= cand) ? 1 : 0; c1 += (u[r + 1] >= cand) ? 1 : 0; c2 += (u[r + 2] >= cand) ? 1 : 0; c3 += (u[r + 3] >= cand) ? 1 : 0; }
                const int c = (c0 + c1) + (c2 + c3);
                int cnt = 0;
#pragma unroll
                for (int bb = 0; bb < 6; ++bb) cnt += __popcll(__ballot((c >> bb) & 1)) << bb;
                if (cnt >= TOPK) T = cand;
                if (cnt == TOPK) { exact = true; break; } }
            int cg_ = 0;
#pragma unroll
            for (int r = 0; r < 32; ++r) cg_ += (u[r] > T) ? 1 : 0;
            int ngt = 0;
#pragma unroll
            for (int bb = 0; bb < 6; ++bb) ngt += __popcll(__ballot((cg_ >> bb) & 1)) << bb;
            const int need = exact ? (1 << 20) : (TOPK - ngt);
            int base = 0;
#pragma unroll
            for (int r = 0; r < 32; ++r) { const bool eq = (u[r] == T); const unsigned long long me = __ballot(eq);
                const int before = base + (int)__builtin_amdgcn_mbcnt_hi((unsigned)(me >> 32), __builtin_amdgcn_mbcnt_lo((unsigned)me, 0u));
                const unsigned long long w = __ballot((u[r] > T) || (eq && before < need));
                base += __popcll(me);
                if (lane == r) myw = w;
                __builtin_amdgcn_sched_barrier(0); }
        }
        if (lane < 32) mask[(size_t)(b * SEQ + t) * 32 + lane] = myw;
    }
    __syncthreads();
}

__device__ __forceinline__ void dsa_attn_unit(const Ctx& X, int b, int head, int qb) {
    GAS unsigned char* ws = X.ws; const int tid = X.tid, lane = X.lane, wave = X.wave, r32 = lane & 31, hi = lane >> 5;
    LAS bf16_t* Kb = (LAS bf16_t*)X.lds;
    LAS bf16_t* Vb = (LAS bf16_t*)(X.lds + 34816);
    const bf16_t* DQ = (const bf16_t*)(ws + WS_DQ); const bf16_t* DK = (const bf16_t*)(ws + WS_DK); const bf16_t* DV = (const bf16_t*)(ws + WS_DV);
    const unsigned* mask = (const unsigned*)(ws + WS_MASK);
    const int qrow = b * SEQ + 256 * qb + 32 * wave + r32;
    const int NTL = 4 * qb + 4;
    const int myNT = 4 * qb + ((32 * wave + 31) >> 6) + 1;
    bf16x8 qf[8];
#pragma unroll
    for (int s = 0; s < 8; ++s) qf[s] = *(const bf16x8*)(DQ + (size_t)qrow * DM + head * DHD + 16 * s + 8 * hi);
    f32x16 ot[4];
#pragma unroll
    for (int d = 0; d < 4; ++d)
#pragma unroll
        for (int r = 0; r < 16; ++r) ot[d][r] = 0.f;
    float m_run = -1e30f, l_run = 0.f;
    const float C2 = 0.08838834764831845f * 1.4426950408889634f;
    u32x4 kA0, kA1, vA0, vA1, kB0, kB1, vB0, vB1;
#define ATT_ISSUE(kt_, k0_, k1_, v0_, v1_) do { \
        { const int id = tid, key = id >> 4, c16 = id & 15; k0_ = *(const u32x4*)(DK + (size_t)(b * SEQ + 64 * (kt_) + key) * DM + head * DHD + 8 * c16); } \
        { const int id = tid + NT, key = id >> 4, c16 = id & 15; k1_ = *(const u32x4*)(DK + (size_t)(b * SEQ + 64 * (kt_) + key) * DM + head * DHD + 8 * c16); } \
        { const int id = tid, dv = id >> 3, c16 = id & 7; v0_ = *(const u32x4*)(DV + ((size_t)((b * NCH + (kt_)) * DH + head) * 128 + dv) * 64 + 8 * c16); } \
        { const int id = tid + NT, dv = id >> 3, c16 = id & 7; v1_ = *(const u32x4*)(DV + ((size_t)((b * NCH + (kt_)) * DH + head) * 128 + dv) * 64 + 8 * c16); } } while (0)
#define ATT_COMMIT(buf_, k0_, k1_, v0_, v1_) do { \
        { const int id = tid, key = id >> 4, c16 = id & 15; *(LAS u32x4*)(Kb + (buf_) * 8704 + key * 136 + 8 * c16) = k0_; } \
        { const int id = tid + NT, key = id >> 4, c16 = id & 15; *(LAS u32x4*)(Kb + (buf_) * 8704 + key * 136 + 8 * c16) = k1_; } \
        { const int id = tid, dv = id >> 3, c16 = id & 7; *(LAS u32x4*)(Vb + (buf_) * 9216 + dv * 72 + 8 * c16) = v0_; } \
        { const int id = tid + NT, dv = id >> 3, c16 = id & 7; *(LAS u32x4*)(Vb + (buf_) * 9216 + dv * 72 + 8 * c16) = v1_; } } while (0)
#define ATT_BAR() do { asm volatile("s_waitcnt lgkmcnt(0)" ::: "memory"); __builtin_amdgcn_s_barrier(); asm volatile("" ::: "memory"); } while (0)
    __syncthreads();
    ATT_ISSUE(0, kA0, kA1, vA0, vA1); ATT_COMMIT(0, kA0, kA1, vA0, vA1);
    ATT_ISSUE(1, kB0, kB1, vB0, vB1);
    __syncthreads();
    u32x2 mw_next = *(const u32x2*)(mask + (size_t)qrow * 64);
#define ATT_TILE(kt, ISSUE_, COMMIT_) do { const int buf = (kt) & 1; \
        ISSUE_; \
        if (kt < myNT) { \
            const u32x2 mw = mw_next; mw_next = *(const u32x2*)(mask + (size_t)qrow * 64 + 2 * (((kt) + 1 < NTL) ? (kt) + 1 : NTL - 1)); \
            f32x16 p0, p1; \
_Pragma("unroll") \
            for (int r = 0; r < 16; ++r) { p0[r] = 0.f; p1[r] = 0.f; } \
            const LAS bf16_t* kb = Kb + buf * 8704; \
_Pragma("unroll") \
            for (int s = 0; s < 8; ++s) { const bf16x8 a0 = *(const LAS bf16x8*)(kb + r32 * 136 + 16 * s + 8 * hi), a1 = *(const LAS bf16x8*)(kb + (32 + r32) * 136 + 16 * s + 8 * hi); \
                p0 = MFMA32(a0, qf[s], p0); p1 = MFMA32(a1, qf[s], p1); } \
            const unsigned lo = mw.x >> (4 * hi), hi_w = mw.y >> (4 * hi); \
            float mx = -INFINITY; \
_Pragma("unroll") \
            for (int r = 0; r < 16; ++r) { const int cb = (r & 3) + 8 * (r >> 2); \
                p0[r] = ((lo >> cb) & 1u) ? p0[r] : -INFINITY; p1[r] = ((hi_w >> cb) & 1u) ? p1[r] : -INFINITY; mx = fmaxf(mx, fmaxf(p0[r], p1[r])); } \
            mx = fmaxf(mx, __shfl_xor(mx, 32)); \
            const float m_new = fmaxf(m_run, mx); \
            const float alpha = exp2f((m_run - m_new) * C2); \
            const float mc = m_new * C2; \
            float ls = 0.f; \
_Pragma("unroll") \
            for (int r = 0; r < 16; ++r) { p0[r] = exp2f(fmaf(p0[r], C2, -mc)); p1[r] = exp2f(fmaf(p1[r], C2, -mc)); ls += p0[r] + p1[r]; } \
            l_run = l_run * alpha + ls; m_run = m_new; \
_Pragma("unroll") \
            for (int d = 0; d < 4; ++d) \
_Pragma("unroll") \
                for (int r = 0; r < 16; ++r) ot[d][r] *= alpha; \
            bf16x8 pb[4]; \
_Pragma("unroll") \
            for (int s = 0; s < 4; ++s) { u32x4 w; \
                if (s < 2) { w.x = pg8::cvt_pk_bf16(p0[8 * s + 0], p0[8 * s + 1]); w.y = pg8::cvt_pk_bf16(p0[8 * s + 2], p0[8 * s + 3]); w.z = pg8::cvt_pk_bf16(p0[8 * s + 4], p0[8 * s + 5]); w.w = pg8::cvt_pk_bf16(p0[8 * s + 6], p0[8 * s + 7]); } \
                else { const int s2 = s - 2; w.x = pg8::cvt_pk_bf16(p1[8 * s2 + 0], p1[8 * s2 + 1]); w.y = pg8::cvt_pk_bf16(p1[8 * s2 + 2], p1[8 * s2 + 3]); w.z = pg8::cvt_pk_bf16(p1[8 * s2 + 4], p1[8 * s2 + 5]); w.w = pg8::cvt_pk_bf16(p1[8 * s2 + 6], p1[8 * s2 + 7]); } \
                pb[s] = __builtin_bit_cast(bf16x8, w); } \
            const LAS bf16_t* vb = Vb + buf * 9216; \
_Pragma("unroll") \
            for (int d = 0; d < 4; ++d) \
_Pragma("unroll") \
                for (int s = 0; s < 4; ++s) { const LAS bf16_t* vp = vb + (32 * d + r32) * 72 + 16 * s + 4 * hi; \
                    const u32x2 v0 = *(const LAS u32x2*)vp, v1 = *(const LAS u32x2*)(vp + 8); \
                    const bf16x8 af = __builtin_bit_cast(bf16x8, (u32x4){v0.x, v0.y, v1.x, v1.y}); \
                    ot[d] = MFMA32(af, pb[s], ot[d]); } \
        } \
        COMMIT_; \
        ATT_BAR(); } while (0)
    for (int kt = 0; kt < NTL; kt += 2) {
        ATT_TILE(kt, ATT_ISSUE(((kt + 2 < NTL) ? kt + 2 : NTL - 1), kA0, kA1, vA0, vA1), ATT_COMMIT(1, kB0, kB1, vB0, vB1));
        ATT_TILE(kt + 1, ATT_ISSUE(((kt + 3 < NTL) ? kt + 3 : NTL - 1), kB0, kB1, vB0, vB1), ATT_COMMIT(0, kA0, kA1, vA0, vA1));
    }
#undef ATT_TILE
    const float lt = l_run + __shfl_xor(l_run, 32);
    const float inv = 1.f / lt;
    bf16_t* ob = (bf16_t*)(ws + WS_OB) + (size_t)qrow * DM + head * DHD;
#pragma unroll
    for (int d = 0; d < 4; ++d)
#pragma unroll
        for (int g = 0; g < 4; ++g) { u32x2 w; w.x = pg8::cvt_pk_bf16(ot[d][4 * g] * inv, ot[d][4 * g + 1] * inv); w.y = pg8::cvt_pk_bf16(ot[d][4 * g + 2] * inv, ot[d][4 * g + 3] * inv);
            *(u32x2*)(ob + 32 * d + 8 * g + 4 * hi) = w; }
}

__device__ __forceinline__ void oa_norm_rows(const Ctx& X, const float* gng) {
    const int gw = X.bid * NW + X.wave, NGW = X.G * NW, lane = X.lane;
    const float* oa = (const float*)(X.ws + WS_OA); const bf16_t* ra = (const bf16_t*)(X.ws + WS_RA); bf16_t* oan = (bf16_t*)(X.ws + WS_H);
    for (int row = gw; row < MTOK; row += NGW) {
        const int bc = row >> 6, tl = row & 63, tt = tl >> 5, rr = tl & 31, hi = (rr >> 2) & 1, r = (rr & 3) + 4 * (rr >> 3);
#pragma unroll
        for (int hh = 0; hh < GH; ++hh) {
            const size_t off = (size_t)row * DM + hh * GDV + 4 * lane;
            const size_t ib = ((size_t)(((bc * 4 + hh) * 8 + (lane >> 4)) * 2 + ((lane >> 3) & 1)) * 32 + tt * 16 + r) * 64 + 32 * hi + 4 * (lane & 7);
            const f32x4 v0 = *(const f32x4*)(oa + ib), v1 = *(const f32x4*)(oa + ib + (size_t)4 * 2 * 32 * 64);
            float s = (v0[0] * v0[0] + v0[1] * v0[1]) + (v0[2] * v0[2] + v0[3] * v0[3]) + (v1[0] * v1[0] + v1[1] * v1[1]) + (v1[2] * v1[2] + v1[3] * v1[3]);
            const float rs = rsqrtf(wave_sum(s) * (1.f / GDV) + RMS_EPS);
            const f32x4 g0 = *(const f32x4*)(gng + hh * GDV + 4 * lane), g1 = *(const f32x4*)(gng + hh * GDV + 4 * lane + 256);
            const f32x4 r0 = pg8::bf4_to_f32(*(const u32x2*)(ra + off)), r1 = pg8::bf4_to_f32(*(const u32x2*)(ra + off + 256));
            const f32x4 y0 = v0 * rs * g0 * r0, y1 = v1 * rs * g1 * r1;
            *(u32x2*)(oan + off) = (u32x2){pk2(y0[0], y0[1]), pk2(y0[2], y0[3])}; *(u32x2*)(oan + off + 256) = (u32x2){pk2(y1[0], y1[1]), pk2(y1[2], y1[3])};
        }
    }
}


constexpr int NPHASE = 13;

__global__ void __launch_bounds__(NT, 2) fwd_kernel(Args args) {
    extern __shared__ __attribute__((aligned(16))) unsigned char lds_raw[];
    cg::grid_group grid = cg::this_grid();
    Ctx X;
    X.lds = (LAS unsigned char*)lds_raw; X.ws = (GAS unsigned char*)args.ws;
    X.tid = threadIdx.x; X.lane = X.tid & 63; X.wave = __builtin_amdgcn_readfirstlane(X.tid >> 6);
    X.bid = blockIdx.x; X.G = gridDim.x;
    if (X.tid < 18) { const float* pv_ = (X.tid < 17) ? args.in[X.tid < 17 ? X.tid : 0] : (const float*)args.out; *(LAS unsigned long long*)(X.lds + LDS_PTAB + 8 * X.tid) = (unsigned long long)pv_; }
    if (X.tid < 2) ((volatile LAS unsigned*)(X.lds + LDS_PTAB + 160))[X.tid] = 0u;
    __syncthreads();
    XcdBarrier xbar = xcd_barrier_post((unsigned*)(args.ws + WS_CTL) + 4096, (volatile LAS unsigned*)(X.lds + LDS_PTAB + 160));
    GAS unsigned char* ws = (GAS unsigned char*)args.ws;
#define mod ((float*)(ws + WS_MOD))
    const int lo = args.ph_lo, hi = args.ph_hi;
    STAMP(13);
#ifdef EXTRA_SYNCS
    for (int es_ = 0; es_ < EXTRA_SYNCS; ++es_) grid.sync();
#endif
#ifndef PH_ONLY
#define PH_ONLY -1
#endif
#ifndef PH_MASK
#define PH_MASK 0x1fff
#endif
#define IN(k) ((PH_ONLY < 0 || PH_ONLY == (k)) && ((PH_MASK >> (k)) & 1) && lo <= (k) && (k) < hi)
#define LAUNDER() do { int t_ = threadIdx.x; asm volatile("" : "+v"(t_)); X.tid = t_; X.lane = t_ & 63; X.wave = __builtin_amdgcn_readfirstlane(t_ >> 6); \
        unsigned char* w_ = args.ws; asm volatile("" : "+s"(w_)); ws = (GAS unsigned char*)w_; X.ws = ws; } while (0)
#ifndef USE_CG_SYNC
#define GSYNC(k) xcd_barrier(xbar)
#else
#define GSYNC(k) grid.sync()
#endif
#define SEAM(k) do { STAMP(k); if (IN(k) && IN((k) + 1)) GSYNC(k); } while (0)

    if (IN(0)) {
    { LAUNDER(); p0_prologue<true>(X); }
    }
    SEAM(0);
    if (IN(1)) {
    { LAUNDER(); norm1_rows(X, INP(X, I_X), INP(X, I_N1G), INP(X, I_BADA), mod, (bf16_t*)(ws + WS_H)); }
    }
    SEAM(1);
    if (IN(2)) {
    { LAUNDER();
        pg8::Gemm g{(const bf16_t*)(ws + WS_H), (const bf16_t*)(ws + WS_WIN), MTOK, INWP, DM}; pg8::StaticOrder S; S.init(MTOK, INWP, X.G, X.bid);
        pg8::EpiInProj E{(unsigned char*)ws};
        pg8::gemm_phase<pg8::EpiInProj, pg8::StaticOrder, true, true>(X.lds, g, S, E);
    }
    }
    SEAM(2);
    if (IN(3)) {
    { LAUNDER();
        for (int u = X.bid; u < BATCH * NCH * GH; u += X.G) gla_prep_unit(X, args, u);
        dv_transpose(X);
        idx_prep(X);
        rope_qk(X);
    }
    }
    SEAM(3);
    if (IN(4)) {
    { LAUNDER();
        if (X.bid < 128) { const int xx = X.bid & 7, mm = X.bid >> 3; gla_scan_unit(X, (mm & 7) * 16 + xx + 8 * (mm >> 3)); STAMP(16); }
        {
            unsigned* qctr = (unsigned*)(ws + WS_CTL) + 64;
            volatile LAS unsigned* qsh = (volatile LAS unsigned*)(X.lds + LDS_MISC);
            for (;;) {
                __syncthreads();
                if (X.tid == 0) qsh[0] = atomicAdd(qctr, 1u);
                __syncthreads();
                const unsigned uq = qsh[0];
                if (uq >= (unsigned)(BATCH * 128)) break;
                idx_topk_unit(X, (int)((uq & 3u) * 128u + (127u - (uq >> 2))));
            }
        }
    }
    }
    SEAM(4);
    if (IN(5)) {
    { LAUNDER();
        const int NU = BATCH * DH * 8;
        for (int i = 0; i * X.G < NU; ++i) {
            const int v = i * X.G + ((i & 1) ? (X.G - 1 - X.bid) : X.bid);
            if (v < NU) { const int qb = 7 - (v >> 6), bh = v & 63; dsa_attn_unit(X, bh >> 4, bh & 15, qb); }
        }
        STAMP(17);
        oa_norm_rows(X, INP(X, I_GNG));
    }
    }
    SEAM(5);
    if (IN(6)) {
    { LAUNDER();
        pg8::Gemm g{(const bf16_t*)(ws + WS_H), (const bf16_t*)(ws + WS_WBGA), MTOK, DM, DM}; pg8::StaticOrder S; S.init(MTOK, DM, X.G, X.bid);
        pg8::EpiScaleF32 E{(float*)(ws + WS_TMP), (const bf16_t*)(ws + WS_SGA)};
        pg8::gemm_phase<pg8::EpiScaleF32, pg8::StaticOrder, true, true>(X.lds, g, S, E);
    }
    }
    SEAM(6);
    if (IN(7)) {
    { LAUNDER();
        pg8::Gemm g{(const bf16_t*)(ws + WS_OB), (const bf16_t*)(ws + WS_WBDSA), MTOK, DM, DM}; pg8::StaticOrder S; S.init(MTOK, DM, X.G, X.bid);
        pg8::EpiMerge E{(bf16_t*)(ws + WS_MERGED), (const float*)(ws + WS_TMP), (const bf16_t*)(ws + WS_SGB)};
        pg8::gemm_phase<pg8::EpiMerge, pg8::StaticOrder, true, true>(X.lds, g, S, E);
    }
    }
    SEAM(7);
    if (IN(8)) {
    { LAUNDER();
        pg8::Gemm g{(const bf16_t*)(ws + WS_MERGED), (const bf16_t*)(ws + WS_WMO), MTOK, DM, DM}; pg8::StaticOrder S; S.init(MTOK, DM, X.G, X.bid);
        pg8::EpiResid E{INP(X, I_X), (float*)(ws + WS_X1), mod + 2 * DM};
        pg8::gemm_phase<pg8::EpiResid, pg8::StaticOrder, true, true>(X.lds, g, S, E);
    }
    }
    SEAM(8);
    if (IN(9)) {
    { LAUNDER(); norm_mod_rows(X, (const float*)(ws + WS_X1), INP(X, I_N2G), mod, 3, 4, (bf16_t*)(ws + WS_H)); }
    }
    SEAM(9);
    if (IN(10)) {
    { LAUNDER();
        pg8::Gemm g{(const bf16_t*)(ws + WS_H), (const bf16_t*)(ws + WS_WGU), MTOK, 2 * DFF, DM}; pg8::StaticOrder S; S.init(MTOK, 2 * DFF, X.G, X.bid);
        pg8::EpiSwiglu E{(bf16_t*)(ws + WS_ACT)};
        pg8::gemm_phase<pg8::EpiSwiglu, pg8::StaticOrder, true, true>(X.lds, g, S, E);
    }
    }
    SEAM(10);
    if (IN(11)) {
    { LAUNDER();
        pg8::Gemm g{(const bf16_t*)(ws + WS_ACT), (const bf16_t*)(ws + WS_WDN), MTOK, DM, DFF}; pg8::StaticOrder S; S.init(MTOK, DM, X.G, X.bid);
        pg8::EpiResid E{(const float*)(ws + WS_X1), (float*)INP(X, 17), mod + 5 * DM};
        pg8::gemm_phase<pg8::EpiResid, pg8::StaticOrder, true, true>(X.lds, g, S, E);
    }
    }
    SEAM(11);
    if (IN(12)) {
    { LAUNDER(); final_norm_rows(X, (float*)INP(X, 17), INP(X, I_FNG)); }
    }
    if (args.ph_lo > 4096) grid.sync();
#ifdef STAMP_A
    {
        STAMP(12);
        __threadfence(); grid.sync();
        if (X.bid == 0 && X.tid == 0) {
            const unsigned long long* ts = (const unsigned long long*)(ws + WS_DBG);
            unsigned long long e1 = 0, e0 = 0, mn = ~0ull;
            for (int b = 0; b < X.G; ++b) { const unsigned long long v = __hip_atomic_load(ts + STAMP_A * 256 + b, __ATOMIC_RELAXED, __HIP_MEMORY_SCOPE_AGENT); if (v) { e1 = v > e1 ? v : e1; mn = v < mn ? v : mn; } }
            for (int b = 0; b < X.G; ++b) { const unsigned long long v = __hip_atomic_load(ts + STAMP_B * 256 + b, __ATOMIC_RELAXED, __HIP_MEMORY_SCOPE_AGENT); e0 = v > e0 ? v : e0; }
#if STAMP_MODE == 1
            e1 = mn;
#endif
            const unsigned long long dur = (e1 > e0) ? (e1 - e0) : 0ull;
            const unsigned long long t0 = __builtin_amdgcn_s_memrealtime();
            while (__builtin_amdgcn_s_memrealtime() - t0 < 4ull * dur) __builtin_amdgcn_s_sleep(8);
        }
    }
#endif
#undef IN
#undef SEAM
#undef mod
}


extern "C" void kernel_launch(void* const* d_in, const int* in_sizes, int n_in, void* d_out, int out_size, void* d_ws, size_t ws_size, hipStream_t stream) {
    static int grid = 0;
    if (grid == 0) {
        if (n_in != 17 || out_size != MTOK * DM || ws_size < WS_END) { fprintf(stderr, "kernel_launch: unexpected shapes (n_in %d out %d ws %zu need %zu)\n", n_in, out_size, ws_size, (size_t)WS_END); grid = -1; return; }
        int dev = 0, cus = 0, per_cu = 0;
        if (hipGetDevice(&dev) != hipSuccess || hipDeviceGetAttribute(&cus, hipDeviceAttributeMultiprocessorCount, dev) != hipSuccess) { grid = -1; return; }
        if (hipFuncSetAttribute((const void*)fwd_kernel, hipFuncAttributeMaxDynamicSharedMemorySize, LDS_BYTES) != hipSuccess) { grid = -1; return; }
        if (hipOccupancyMaxActiveBlocksPerMultiprocessor(&per_cu, (const void*)fwd_kernel, NT, LDS_BYTES) != hipSuccess || per_cu < 1) { fprintf(stderr, "kernel_launch: occupancy query says %d\n", per_cu); }
        (void)hipGetLastError();
        grid = cus;
    }
    if (grid < 0) return;
    (void)hipMemsetAsync((char*)d_ws + WS_CTL, 0, CTL_BYTES, stream);
    Args a{};
    for (int i = 0; i < 17; ++i) a.in[i] = (const float*)d_in[i];
    a.out = (float*)d_out; a.ws = (unsigned char*)d_ws; a.ph_lo = 0; a.ph_hi = (PH_STOP < NPHASE) ? PH_STOP : NPHASE;
    void* kargs[] = {&a};
    hipError_t e = hipLaunchCooperativeKernel((const void*)fwd_kernel, dim3(grid), dim3(NT), kargs, LDS_BYTES, stream);
    if (e != hipSuccess) fprintf(stderr, "kernel_launch: cooperative launch failed: %s (grid %d)\n", hipGetErrorString(e), grid);
#if DBG
    dbg_run(a, stream);
#endif
}
```

```cpp
#include <hip/hip_runtime.h>
#include <hip/hip_cooperative_groups.h>
#include <cstdio>
#include <cstdint>
namespace cg = cooperative_groups;

#ifndef DBG
#define DBG 0
#endif
#ifndef PH_STOP
#define PH_STOP 99
#endif

constexpr int BATCH = 4, SEQ = 2048, DM = 2048, MTOK = BATCH * SEQ;
constexpr int INW = 16984, INWP = 17152, DFF = 5632, NMOD = 6 * DM;
constexpr int GH = 4, GDK = 256, GDV = 512, GRANK = 16, NCH = SEQ / 64;
constexpr int DH = 16, DHD = 128, IH = 8, ID = 64, TOPK = 256;
constexpr int SMALLW = 768;
constexpr float RMS_EPS = 1e-6f;
constexpr int SRC_GQ = 0, SRC_GK = 1024, SRC_GV = 2048, SRC_GR = 4096, SRC_GLR = 6144, SRC_DQ = 6160, SRC_DK = 8208, SRC_DV = 10256,
              SRC_IQ = 12304, SRC_IK = 12816, SRC_IW = 12880, SRC_GA = 12888, SRC_GB = 14936;
enum { I_X = 0, I_C, I_POS, I_N1G, I_N2G, I_WADA, I_BADA, I_WIN, I_GUP, I_GBIAS, I_GNG, I_WBGA, I_WBDSA, I_WMO, I_WGU, I_WDN, I_FNG };

constexpr size_t MiB = 1u << 20;
constexpr size_t WS_CTL = 0, CTL_BYTES = 1 * MiB;
constexpr size_t WS_MOD = 65536;
constexpr size_t WS_DBG = 512 * 1024;
constexpr size_t WS_ROPED = 1 * MiB;
constexpr size_t WS_ROPEI = 2 * MiB;
constexpr size_t WS_IW = 2 * MiB + 512 * 1024;
constexpr size_t WS_GDEC = 3 * MiB;
constexpr size_t WS_MASK = 4 * MiB;
constexpr size_t WS_IK = 6 * MiB;
constexpr size_t WS_IQ = 7 * MiB;
constexpr size_t WS_ATTN = 15 * MiB;
constexpr size_t WS_WBGA = 20 * MiB, WS_WBDSA = 28 * MiB, WS_WMO = 36 * MiB, WS_WGU = 44 * MiB, WS_WDN = 88 * MiB;
constexpr size_t WS_WIN = 110 * MiB;
constexpr size_t WS_OA = 110 * MiB;
constexpr size_t WS_H = 177 * MiB;
constexpr size_t WS_QA = 209 * MiB, WS_KA = 225 * MiB;
constexpr size_t WS_VA = 241 * MiB;
constexpr size_t WS_RA = 273 * MiB;
constexpr size_t WS_DQ = 305 * MiB, WS_DK = 337 * MiB;
constexpr size_t WS_DV = 369 * MiB;
constexpr size_t WS_SGA = 401 * MiB, WS_SGB = 433 * MiB;
constexpr size_t WS_SMALL = 465 * MiB;
constexpr size_t WS_KTA = 489 * MiB;
constexpr size_t WS_MODP = 505 * MiB;
constexpr size_t WS_END = 512 * MiB;
constexpr size_t WS_OB = WS_QA;
constexpr size_t WS_TMP = WS_VA;
constexpr size_t WS_MERGED = WS_DQ;
constexpr size_t WS_X1 = WS_DK;
constexpr size_t WS_ACT = WS_QA;

#define LAS __attribute__((address_space(3)))
typedef unsigned short bf16_t;
typedef short bf16x8 __attribute__((ext_vector_type(8)));
typedef short bf16x4 __attribute__((ext_vector_type(4)));
typedef float f32x4 __attribute__((ext_vector_type(4)));
typedef float f32x16 __attribute__((ext_vector_type(16)));
typedef unsigned u32x4 __attribute__((ext_vector_type(4)));
typedef unsigned u32x2 __attribute__((ext_vector_type(2)));
constexpr int NT = 512, NW = 8;
constexpr int RING_BYTES = 131072;
constexpr int LDS_BYTES = 147456;

__device__ __forceinline__ float bf2f(unsigned v) { return __uint_as_float(v << 16); }
__device__ __forceinline__ unsigned f2bf(float f) { unsigned u = __float_as_uint(f); return (u + 0x7fffu + ((u >> 16) & 1u)) >> 16; }
__device__ __forceinline__ unsigned pk2(float lo, float hi) { return f2bf(lo) | (f2bf(hi) << 16); }
__device__ __forceinline__ float wave_sum(float v) {
#pragma unroll
    for (int o = 1; o < 64; o <<= 1) v += __shfl_xor(v, o);
    return v;
}
__device__ __forceinline__ float siluf(float v) { return v / (1.f + __expf(-v)); }
__device__ __forceinline__ float sigmf(float v) { return 1.f / (1.f + __expf(-v)); }
__device__ __forceinline__ int crow(int r, int hi) { return (r & 3) + 8 * (r >> 2) + 4 * hi; }

namespace pg8 {
#define PG8_LAS __attribute__((address_space(3)))
typedef unsigned short bf16_t;
typedef short bf16x8 __attribute__((ext_vector_type(8)));
typedef float f32x4 __attribute__((ext_vector_type(4)));
typedef unsigned u32x4 __attribute__((ext_vector_type(4)));
constexpr int BM = 256, BK = 64, HALF = 128, HTB = HALF * BK * 2  , STAGE_BYTES = 8 * HTB, NXCD = 8, WGM = 8;

__host__ __device__ __forceinline__ int lds_byte(int r, int c) { const int st = (r >> 4) * 2 + (c >> 5), rr = r & 15, cc = c & 31, ob = rr * 64 + cc * 2; return st * 1024 + (ob ^ (((ob >> 9) & 1) << 5)); }
__host__ __device__ __forceinline__ void stage_rc(int b, int& R, int& C) { const int st = b / 1024, sb = b % 1024, swz = sb ^ (((sb >> 9) & 1) << 5); R = (st >> 1) * 16 + swz / 64; C = (st & 1) * 32 + (swz % 64) / 2; }
__host__ __device__ __forceinline__ int perm32(int rho) { const int n = rho >> 4, i = rho & 15; return 8 * (i >> 2) + 4 * n + (i & 3); }

struct Unit { int pm, pn; };
struct Gemm { const bf16_t* A; const bf16_t* Bt; int M, N, K; };

struct StaticOrder {
    int nM, nN, nwg, G, c;
    __host__ __device__ void init(int M, int N, int G_, int c_) { nM = M / BM; nN = N / BM; nwg = nM * nN; G = G_; c = c_; }
    __host__ __device__ bool next(int i, Unit& u) const {
        const long L = (long)i * G + c; if (L >= nwg) return false;
        int wgid = (int)L; { const int q = nwg / NXCD, r = nwg % NXCD, xcd = wgid % NXCD, off = wgid / NXCD; wgid = (xcd < r ? xcd * (q + 1) : r * (q + 1) + (xcd - r) * q) + off; }
        const int nig = WGM * nN, gid = wgid / nig, fm = gid * WGM, gsz = (nM - fm) < WGM ? (nM - fm) : WGM;
        u.pm = fm + ((wgid % nig) % gsz); u.pn = (wgid % nig) / gsz; return true;
    }
    __device__ __forceinline__ void a_ready(const Unit&) const {}
    __device__ __forceinline__ void done(const Unit&) const {}
};


__device__ __forceinline__ unsigned cvt_pk_bf16(float lo, float hi) { unsigned r; asm volatile("v_cvt_pk_bf16_f32 %0, %1, %2" : "=v"(r) : "v"(lo), "v"(hi)); return r; }
__device__ __forceinline__ void store8bf(bf16_t* p, f32x4 v0, f32x4 v1) {
    u32x4 w; w.x = cvt_pk_bf16(v0[0], v0[1]); w.y = cvt_pk_bf16(v0[2], v0[3]); w.z = cvt_pk_bf16(v1[0], v1[1]); w.w = cvt_pk_bf16(v1[2], v1[3]); *(u32x4*)p = w;
}
__device__ __forceinline__ f32x4 silu4(f32x4 v) { f32x4 o; o[0] = v[0] / (1.f + __expf(-v[0])); o[1] = v[1] / (1.f + __expf(-v[1])); o[2] = v[2] / (1.f + __expf(-v[2])); o[3] = v[3] / (1.f + __expf(-v[3])); return o; }
__device__ __forceinline__ f32x4 sigm4(f32x4 v) { f32x4 o; o[0] = 1.f / (1.f + __expf(-v[0])); o[1] = 1.f / (1.f + __expf(-v[1])); o[2] = 1.f / (1.f + __expf(-v[2])); o[3] = 1.f / (1.f + __expf(-v[3])); return o; }
__device__ __forceinline__ f32x4 bf4_to_f32(u32x2 w) { f32x4 o; o[0] = __uint_as_float(w.x << 16); o[1] = __uint_as_float(w.x & 0xffff0000u); o[2] = __uint_as_float(w.y << 16); o[3] = __uint_as_float(w.y & 0xffff0000u); return o; }

struct EpiInProj {
    static constexpr bool PERM = true, AFTER_DRAIN = false;
    unsigned char* ws;
    __device__ __forceinline__ void operator()(const f32x4 (&acc)[2][2][4][2], const Unit& u, int wr, int wc, int fr, int fq) const {
        const int pn = u.pn, row0 = u.pm * BM + wr * 64 + fr, cl = wc * 32 + 8 * fq;
        if (pn >= 64) {
            float* base = (float*)(ws + WS_SMALL) + 256 * (pn - 64) + cl;
#pragma unroll
            for (int ai = 0; ai < 2; ++ai)
#pragma unroll
                for (int m = 0; m < 4; ++m) { const int r = row0 + ai * HALF + m * 16; float* rp = base + (size_t)r * SMALLW;
#pragma unroll
                    for (int bj = 0; bj < 2; ++bj) { *(f32x4*)(rp + bj * HALF) = acc[ai][bj][m][0]; *(f32x4*)(rp + bj * HALF + 4) = acc[ai][bj][m][1]; } asm volatile("" ::: "memory"); }
            return;
        }
        size_t wsoff; int A, B, C, E = HALF, op = 0;
        if (pn < 8) { wsoff = pn < 4 ? WS_QA : WS_KA; A = 4 * 64 * 256; B = 256; C = (pn & 3) * 64 * 256; }
        else if (pn < 16) { wsoff = WS_VA; A = 4 * 64 * 512; B = 512; C = ((pn - 8) >> 1) * 64 * 512 + 256 * ((pn - 8) & 1); }
        else if (pn < 24) { wsoff = WS_RA; A = 64 * DM; B = DM; C = 256 * (pn - 16); op = 1; }
        else if (pn < 40) { wsoff = pn < 32 ? WS_DQ : WS_DK; A = 64 * DM; B = DM; C = 256 * ((pn - 24) & 7); }
        else if (pn < 48) { wsoff = WS_DV; A = 16 * 64 * 128; B = 128; C = 2 * (pn - 40) * 64 * 128; E = 64 * 128; }
        else { wsoff = pn < 56 ? WS_SGA : WS_SGB; A = 64 * DM; B = DM; C = 256 * ((pn - 48) & 7); op = 2; }
        bf16_t* base = (bf16_t*)(ws + wsoff) + C + cl;
#pragma unroll
        for (int ai = 0; ai < 2; ++ai)
#pragma unroll
            for (int m = 0; m < 4; ++m) { const int r = row0 + ai * HALF + m * 16; bf16_t* rp = base + (size_t)(r >> 6) * A + (r & 63) * B;
#pragma unroll
                for (int bj = 0; bj < 2; ++bj) { f32x4 v0 = acc[ai][bj][m][0], v1 = acc[ai][bj][m][1];
                    if (op == 1) { v0 = silu4(v0); v1 = silu4(v1); }
                    else if (op == 2) { v0 = sigm4(v0); v1 = sigm4(v1); }
                    store8bf(rp + bj * E, v0, v1); }
                asm volatile("" ::: "memory"); }
    }
};

struct EpiScaleF32 {
    static constexpr bool PERM = false, AFTER_DRAIN = false;
    float* C; const bf16_t* G;
    __device__ __forceinline__ void operator()(const f32x4 (&acc)[2][2][4][2], const Unit& u, int wr, int wc, int fr, int fq) const {
        const int row0 = u.pm * BM + wr * 64 + fr, col0 = u.pn * BM + wc * 32 + 4 * fq;
#pragma unroll
        for (int ai = 0; ai < 2; ++ai)
#pragma unroll
            for (int m = 0; m < 4; ++m) { const size_t off = (size_t)(row0 + ai * HALF + m * 16) * DM + col0;
#pragma unroll
                for (int bj = 0; bj < 2; ++bj)
#pragma unroll
                    for (int n = 0; n < 2; ++n) { const f32x4 g = bf4_to_f32(*(const u32x2*)(G + off + bj * HALF + n * 16)); *(f32x4*)(C + off + bj * HALF + n * 16) = acc[ai][bj][m][n] * g; } }
    }
};
struct EpiMerge {
    static constexpr bool PERM = true, AFTER_DRAIN = false;
    bf16_t* O; const float* T; const bf16_t* G;
    __device__ __forceinline__ void operator()(const f32x4 (&acc)[2][2][4][2], const Unit& u, int wr, int wc, int fr, int fq) const {
        const int row0 = u.pm * BM + wr * 64 + fr, col0 = u.pn * BM + wc * 32 + 8 * fq;
#pragma unroll
        for (int ai = 0; ai < 2; ++ai)
#pragma unroll
            for (int m = 0; m < 4; ++m) { const size_t off = (size_t)(row0 + ai * HALF + m * 16) * DM + col0;
#pragma unroll
                for (int bj = 0; bj < 2; ++bj) { const u32x4 gw = *(const u32x4*)(G + off + bj * HALF);
                    const f32x4 g0 = bf4_to_f32((u32x2){gw.x, gw.y}), g1 = bf4_to_f32((u32x2){gw.z, gw.w});
                    const f32x4 t0 = *(const f32x4*)(T + off + bj * HALF), t1 = *(const f32x4*)(T + off + bj * HALF + 4);
                    store8bf(O + off + bj * HALF, t0 + acc[ai][bj][m][0] * g0, t1 + acc[ai][bj][m][1] * g1); } }
    }
};
struct EpiResid {
    static constexpr bool PERM = false, AFTER_DRAIN = false;
    const float* base; float* out; const float* gate;
    __device__ __forceinline__ void operator()(const f32x4 (&acc)[2][2][4][2], const Unit& u, int wr, int wc, int fr, int fq) const {
        const int row0 = u.pm * BM + wr * 64 + fr, col0 = u.pn * BM + wc * 32 + 4 * fq;
        const float* gb = gate + (size_t)((u.pm * BM) >> 11) * NMOD + col0;
        f32x4 gv[2][2];
#pragma unroll
        for (int bj = 0; bj < 2; ++bj)
#pragma unroll
            for (int n = 0; n < 2; ++n) gv[bj][n] = *(const f32x4*)(gb + bj * HALF + n * 16);
#pragma unroll
        for (int ai = 0; ai < 2; ++ai)
#pragma unroll
            for (int m = 0; m < 4; ++m) { const size_t off = (size_t)(row0 + ai * HALF + m * 16) * DM + col0;
#pragma unroll
                for (int bj = 0; bj < 2; ++bj)
#pragma unroll
                    for (int n = 0; n < 2; ++n) *(f32x4*)(out + off + bj * HALF + n * 16) = *(const f32x4*)(base + off + bj * HALF + n * 16) + gv[bj][n] * acc[ai][bj][m][n]; }
    }
};
struct EpiSwiglu {
    static constexpr bool PERM = true, AFTER_DRAIN = false;
    bf16_t* O;
    __device__ __forceinline__ void operator()(const f32x4 (&acc)[2][2][4][2], const Unit& u, int wr, int wc, int fr, int fq) const {
        const int row0 = u.pm * BM + wr * 64 + fr, col0 = u.pn * HALF + wc * 32 + 8 * fq;
#pragma unroll
        for (int ai = 0; ai < 2; ++ai)
#pragma unroll
            for (int m = 0; m < 4; ++m) { bf16_t* rp = O + (size_t)(row0 + ai * HALF + m * 16) * DFF + col0;
                store8bf(rp, silu4(acc[ai][0][m][0]) * acc[ai][1][m][0], silu4(acc[ai][0][m][1]) * acc[ai][1][m][1]); }
    }
};

template <class Epi, class Sched, bool ALIGN_EPI = false, bool SP2 = false>
__device__ __forceinline__ void gemm_phase(PG8_LAS unsigned char* lds, const Gemm g, const Sched& S, const Epi& E) {
    int tid_ = threadIdx.x; asm volatile("" : "+v"(tid_));
    const int tid = tid_, wid = __builtin_amdgcn_readfirstlane(tid >> 6), lane = tid & 63, wr = wid >> 2, wc = wid & 3, fr = lane & 15, fq = lane >> 4;
    const int K = g.K, nt = K / BK;
    unsigned voffA[2], voffB[2];
#pragma unroll
    for (int i = 0; i < 2; ++i) { int R, C; stage_rc(tid * 16 + i * 8192, R, C); const int Rb = Epi::PERM ? ((R & ~31) + perm32(R & 31)) : R;
        voffA[i] = (unsigned)(R * K + C) * 2u; voffB[i] = (unsigned)(Rb * K + C) * 2u; }
    const size_t kstep = (size_t)(BK * 2);
    const size_t hstep = (size_t)HALF * K * 2;
    const size_t tstep = 2 * hstep;
    const unsigned ldsw = (unsigned)wid * 1024u;
    const int aoff = lds_byte(wr * 64 + fr, fq * 8), boff = lds_byte(wc * 32 + fr, fq * 8);
#define PG8_SA(b, h) (((b) * 2 + (h)) * HTB)
#define PG8_SB(b, h) ((4 + (b) * 2 + (h)) * HTB)
#define PG8_STAGE(bufoff, gbase, voff) do { _Pragma("unroll") for (int _i = 0; _i < 2; ++_i) \
        __builtin_amdgcn_global_load_lds((const unsigned*)((const char*)(gbase) + (voff)[_i]), (PG8_LAS unsigned*)(lds + (bufoff) + ldsw + _i * 8192), 16, 0, 0); } while (0)
#define PG8_LDA(dst, b, h) do { _Pragma("unroll") for (int m = 0; m < 4; ++m) _Pragma("unroll") for (int k = 0; k < 2; ++k) dst[m][k] = *(const PG8_LAS bf16x8*)(lds + PG8_SA(b, h) + aoff + m * 2048 + k * 1024); } while (0)
#define PG8_LDB(dst, b, h) do { _Pragma("unroll") for (int n = 0; n < 2; ++n) _Pragma("unroll") for (int k = 0; k < 2; ++k) dst[n][k] = *(const PG8_LAS bf16x8*)(lds + PG8_SB(b, h) + boff + n * 2048 + k * 1024); } while (0)
#define PG8_MMA(ai, bj, At, Bt) do { __builtin_amdgcn_s_setprio(1); _Pragma("unroll") for (int m = 0; m < 4; ++m) _Pragma("unroll") for (int n = 0; n < 2; ++n) _Pragma("unroll") for (int k = 0; k < 2; ++k) \
        acc[ai][bj][m][n] = __builtin_amdgcn_mfma_f32_16x16x32_bf16(Bt[n][k], At[m][k], acc[ai][bj][m][n], 0, 0, 0); __builtin_amdgcn_s_setprio(0); } while (0)
#define PG8_WAIT_V(n) asm volatile("s_waitcnt vmcnt(" #n ")" ::: "memory")
#define PG8_WAIT_L(n) asm volatile("s_waitcnt lgkmcnt(" #n ")" ::: "memory")
#define PG8_BAR __builtin_amdgcn_s_barrier()
#define PG8_SCHED __builtin_amdgcn_sched_barrier(0)
    Unit cur, nxt; int ui = 0;
    if (!S.next(0, cur)) return;
    f32x4 acc[2][2][4][2];
#pragma unroll
    for (int a = 0; a < 2; ++a)
#pragma unroll
        for (int b = 0; b < 2; ++b)
#pragma unroll
            for (int m = 0; m < 4; ++m)
#pragma unroll
                for (int n = 0; n < 2; ++n) acc[a][b][m][n] = (f32x4){0.f, 0.f, 0.f, 0.f};
    bf16x8 At[4][2], B0[2][2], B1[2][2];
    const char* cA = (const char*)g.A + (size_t)cur.pm * tstep; const char* cB = (const char*)g.Bt + (size_t)cur.pn * tstep;
    S.a_ready(cur);
    if constexpr (SP2) {
        PG8_STAGE(PG8_SB(0, 0), cB, voffB); PG8_STAGE(PG8_SB(0, 1), cB + hstep, voffB); PG8_STAGE(PG8_SA(0, 0), cA, voffA); PG8_STAGE(PG8_SA(0, 1), cA + hstep, voffA);
        if (wr == 1) PG8_BAR;
        PG8_WAIT_V(2); PG8_BAR;
        PG8_STAGE(PG8_SB(1, 0), cB + kstep, voffB); PG8_STAGE(PG8_SA(1, 0), cA + kstep, voffA); PG8_STAGE(PG8_SB(1, 1), cB + hstep + kstep, voffB);
        PG8_WAIT_V(6); PG8_BAR;
    } else {
        PG8_STAGE(PG8_SB(0, 0), cB, voffB); PG8_STAGE(PG8_SA(0, 0), cA, voffA); PG8_STAGE(PG8_SB(0, 1), cB + hstep, voffB); PG8_STAGE(PG8_SA(0, 1), cA + hstep, voffA);
        if (wr == 1) PG8_BAR;
        PG8_WAIT_V(4); PG8_BAR;
        PG8_STAGE(PG8_SB(1, 0), cB + kstep, voffB); PG8_STAGE(PG8_SA(1, 0), cA + kstep, voffA); PG8_STAGE(PG8_SB(1, 1), cB + hstep + kstep, voffB);
        PG8_WAIT_V(6); PG8_BAR;
    }
    for (;;) {
        const bool has_next = S.next(ui + 1, nxt);
        const char* nA = has_next ? (const char*)g.A + (size_t)nxt.pm * tstep : cA; const char* nB = has_next ? (const char*)g.Bt + (size_t)nxt.pn * tstep : cB;
        for (int t = 0; t < nt; t += 2) {
            const bool last = (t == nt - 2);
            const char* a1 = cA + (size_t)(t + 1) * kstep;
            const char* a2 = last ? nA : cA + (size_t)(t + 2) * kstep; const char* b2 = last ? nB : cB + (size_t)(t + 2) * kstep;
            const char* a3 = a2 + kstep; const char* b3 = b2 + kstep;
            if (last && has_next) S.a_ready(nxt);
            if constexpr (SP2) {
            PG8_LDB(B0, 0, 0); PG8_LDB(B1, 0, 1); PG8_SCHED; PG8_LDA(At, 0, 0); PG8_STAGE(PG8_SA(1, 1), a1 + hstep, voffA);
            PG8_WAIT_V(8); PG8_WAIT_L(0); PG8_BAR; PG8_MMA(0, 0, At, B0); PG8_MMA(0, 1, At, B1); PG8_BAR; PG8_SCHED;
            PG8_LDA(At, 0, 1); PG8_STAGE(PG8_SB(0, 0), b2, voffB); PG8_STAGE(PG8_SB(0, 1), b2 + hstep, voffB); PG8_STAGE(PG8_SA(0, 0), a2, voffA);
            PG8_WAIT_V(8); PG8_WAIT_L(0); PG8_BAR; PG8_MMA(1, 0, At, B0); PG8_MMA(1, 1, At, B1); PG8_BAR; PG8_SCHED;
            PG8_LDB(B0, 1, 0); PG8_LDB(B1, 1, 1); PG8_SCHED; PG8_LDA(At, 1, 0); PG8_STAGE(PG8_SA(0, 1), a2 + hstep, voffA);
            PG8_WAIT_V(8); PG8_WAIT_L(0); PG8_BAR; PG8_MMA(0, 0, At, B0); PG8_MMA(0, 1, At, B1); PG8_BAR; PG8_SCHED;
            PG8_LDA(At, 1, 1); PG8_STAGE(PG8_SB(1, 0), b3, voffB); PG8_STAGE(PG8_SB(1, 1), b3 + hstep, voffB); PG8_STAGE(PG8_SA(1, 0), a3, voffA);
            PG8_WAIT_V(8); PG8_WAIT_L(0); PG8_BAR; PG8_MMA(1, 0, At, B0); PG8_MMA(1, 1, At, B1); PG8_BAR; PG8_SCHED;
            } else {
            PG8_LDB(B0, 0, 0); PG8_SCHED; PG8_LDA(At, 0, 0); PG8_STAGE(PG8_SA(1, 1), a1 + hstep, voffA);
            PG8_WAIT_L(8); PG8_BAR; PG8_WAIT_L(0); PG8_MMA(0, 0, At, B0); PG8_BAR; PG8_SCHED;
            PG8_LDB(B1, 0, 1); PG8_STAGE(PG8_SB(0, 0), b2, voffB);
            PG8_BAR; PG8_WAIT_L(0); PG8_MMA(0, 1, At, B1); PG8_BAR;
            PG8_LDA(At, 0, 1); PG8_STAGE(PG8_SA(0, 0), a2, voffA);
            PG8_BAR; PG8_WAIT_L(0); PG8_MMA(1, 0, At, B0); PG8_BAR; PG8_SCHED;
            PG8_STAGE(PG8_SB(0, 1), b2 + hstep, voffB);
            PG8_WAIT_V(6); PG8_BAR; PG8_MMA(1, 1, At, B1); PG8_BAR;
            PG8_LDB(B0, 1, 0); PG8_SCHED; PG8_LDA(At, 1, 0); PG8_STAGE(PG8_SA(0, 1), a2 + hstep, voffA);
            PG8_WAIT_L(8); PG8_BAR; PG8_WAIT_L(0); PG8_MMA(0, 0, At, B0); PG8_BAR; PG8_SCHED;
            PG8_LDB(B1, 1, 1); PG8_STAGE(PG8_SB(1, 0), b3, voffB);
            PG8_BAR; PG8_WAIT_L(0); PG8_MMA(0, 1, At, B1); PG8_BAR;
            PG8_LDA(At, 1, 1); PG8_STAGE(PG8_SA(1, 0), a3, voffA);
            PG8_BAR; PG8_WAIT_L(0); PG8_MMA(1, 0, At, B0); PG8_BAR; PG8_SCHED;
            PG8_STAGE(PG8_SB(1, 1), b3 + hstep, voffB);
            PG8_WAIT_V(6); PG8_BAR; PG8_MMA(1, 1, At, B1); PG8_BAR;
            }
        }
        if constexpr (ALIGN_EPI) { if (wr == 0) PG8_BAR; }
        if constexpr (!Epi::AFTER_DRAIN) { E(acc, cur, wr, wc, fr, fq); S.done(cur); }
        if (!has_next) break;
#pragma unroll
        for (int a = 0; a < 2; ++a)
#pragma unroll
            for (int b = 0; b < 2; ++b)
#pragma unroll
                for (int m = 0; m < 4; ++m)
#pragma unroll
                    for (int n = 0; n < 2; ++n) acc[a][b][m][n] = (f32x4){0.f, 0.f, 0.f, 0.f};
        cur = nxt; cA = nA; cB = nB; ++ui;
        if constexpr (ALIGN_EPI) { if (wr == 1) PG8_BAR; }
    }
    PG8_WAIT_V(0);
    if constexpr (!ALIGN_EPI) { if (wr == 0) PG8_BAR; }
    PG8_BAR;
    if constexpr (Epi::AFTER_DRAIN) { E.fused(acc, cur, wr, wc, fr, fq, lds, wid, lane); S.done(cur); }
#undef PG8_SA
#undef PG8_SB
#undef PG8_STAGE
#undef PG8_LDA
#undef PG8_LDB
#undef PG8_MMA
#undef PG8_WAIT_V
#undef PG8_WAIT_L
#undef PG8_BAR
#undef PG8_SCHED
}
}

#define XB_TMO      128
#define XB_XCNT(j)  (256  + 64 * (j))
#define XB_XSUB(j)  (1280 + 64 * (j))
#define XB_XGEN(j)  (2304 + 64 * (j))
#define XB_TOP      3328
#define XB_TOPGEN   3392
#define XCD_BAR_WORDS 3456
#define XB_SPIN_CAP (1u << 18)

__device__ __forceinline__ unsigned xb_ld(unsigned* p)              { return __hip_atomic_load(p, __ATOMIC_RELAXED, __HIP_MEMORY_SCOPE_AGENT); }
__device__ __forceinline__ unsigned xb_add(unsigned* p, unsigned v) { return __hip_atomic_fetch_add(p, v, __ATOMIC_RELAXED, __HIP_MEMORY_SCOPE_AGENT); }
__device__ __forceinline__ unsigned xb_xcc_id() { return (unsigned)__builtin_amdgcn_s_getreg((3 << 11) | 20) & 0xFu; }
#define XB_SPIN(cond, bar) do { unsigned _sp = 0; while (cond) { __builtin_amdgcn_s_sleep(1); \
    if ((++_sp & 255u) == 0u) { if (xb_ld(&(bar)[XB_TMO])) break; if (_sp > XB_SPIN_CAP) { atomicAdd(&(bar)[XB_TMO], 1u); break; } } } } while (0)

struct XcdBarrier {
    unsigned* bar; unsigned x;
    volatile LAS unsigned* st;
};

__device__ __forceinline__ XcdBarrier xcd_barrier_post(unsigned* bar, volatile LAS unsigned* st) {
    XcdBarrier b; b.bar = bar; b.x = xb_xcc_id(); b.st = st;
    if (threadIdx.x == 0) (void)xb_add(&bar[XB_XCNT(b.x)], 1u);
    return b;
}
__device__ __forceinline__ void xcd_barrier_complete(unsigned* bar, unsigned x, unsigned& nloc, unsigned& nx) {
    const unsigned G = gridDim.x * gridDim.y * gridDim.z;
    unsigned sum, cnt, mine, sp = 0u;
    for (;;) {
        sum = 0u; cnt = 0u; mine = 0u;
#pragma unroll
        for (unsigned j = 0; j < 16; ++j) { const unsigned c = xb_ld(&bar[XB_XCNT(j)]); sum += c; cnt += (c > 0u) ? 1u : 0u; mine = (j == x) ? c : mine; }
        if (sum == G) break;
        __builtin_amdgcn_s_sleep(1);
        if ((++sp & 255u) == 0u) { if (xb_ld(&bar[XB_TMO])) break; if (sp > XB_SPIN_CAP) { atomicAdd(&bar[XB_TMO], 1u); break; } }
    }
    nloc = mine > 0u ? mine : 1u; nx = cnt > 0u ? cnt : 1u;
}

__device__ __forceinline__ void xcd_barrier(const XcdBarrier& b) {
    asm volatile("s_waitcnt vmcnt(0)" ::: "memory");
    __syncthreads();
    if (threadIdx.x == 0) {
        unsigned* bar = b.bar;
        __builtin_amdgcn_s_waitcnt(0);
        unsigned nloc = b.st[0], nx = b.st[1];
        if (nloc == 0u) { xcd_barrier_complete(bar, b.x, nloc, nx); b.st[0] = nloc; b.st[1] = nx; }
        const unsigned old = xb_add(&bar[XB_XSUB(b.x)], 1u);
        const unsigned gen = old / nloc;
        if (old + 1u == (gen + 1u) * nloc) {
            __builtin_amdgcn_fence(__ATOMIC_RELEASE, "agent");
            asm volatile("s_waitcnt vmcnt(0)" ::: "memory");
            const unsigned og = xb_add(&bar[XB_TOP], 1u);
            const unsigned tg = og / nx;
            if (og + 1u == (tg + 1u) * nx) xb_add(&bar[XB_TOPGEN], 1u);
            else XB_SPIN(xb_ld(&bar[XB_TOPGEN]) == tg, bar);
            __builtin_amdgcn_fence(__ATOMIC_ACQUIRE, "agent");
            xb_add(&bar[XB_XGEN(b.x)], 1u);
            asm volatile("s_waitcnt vmcnt(0)" ::: "memory");
        } else {
            XB_SPIN(xb_ld(&bar[XB_XGEN(b.x)]) == gen, bar);
            __builtin_amdgcn_fence(__ATOMIC_ACQUIRE, "agent");
            asm volatile("s_waitcnt vmcnt(0)" ::: "memory");
        }
    }
    __syncthreads();
}


struct Args { const float* in[17]; float* out; unsigned char* ws; int ph_lo, ph_hi; };

#define GAS __attribute__((address_space(1)))
struct Ctx { LAS unsigned char* lds; GAS unsigned char* ws; int tid, lane, wave, bid, G; };

#define LDS_WAIT() asm volatile("s_waitcnt lgkmcnt(0)" ::: "memory")
constexpr int LDS_PTAB = 147200;
__device__ __forceinline__ const float* INP(const Ctx& X, int i) {
    const volatile LAS unsigned* t = (const volatile LAS unsigned*)(X.lds + LDS_PTAB) + 2 * i;
    const unsigned lo = __builtin_amdgcn_readfirstlane(t[0]), hi = __builtin_amdgcn_readfirstlane(t[1]);
    return (const float*)(__attribute__((address_space(1))) const float*)(((unsigned long long)hi << 32) | lo);
}
#ifdef STAMP_A
#define STAMP(k) do { if (X.tid == 0) ((unsigned long long*)(X.ws + WS_DBG))[(k) * 256 + X.bid] = __builtin_amdgcn_s_memrealtime(); } while (0)
#else
#define STAMP(k) do { } while (0)
#endif
#define MFMA32(a, b, c) __builtin_amdgcn_mfma_f32_32x32x16_bf16((a), (b), (c), 0, 0, 0)
#define MFMA16(a, b, c) __builtin_amdgcn_mfma_f32_16x16x32_bf16((a), (b), (c), 0, 0, 0)

__device__ __forceinline__ int map_win(int n) {
    if (n < 1024) return SRC_GQ + n;
    if (n < 2048) return SRC_GK + (n - 1024);
    if (n < 4096) return SRC_GV + (n - 2048);
    if (n < 6144) return SRC_GR + (n - 4096);
    if (n < 8192) return SRC_DQ + (n - 6144);
    if (n < 10240) return SRC_DK + (n - 8192);
    if (n < 12288) return SRC_DV + (n - 10240);
    if (n < 14336) return SRC_GA + (n - 12288);
    if (n < 16384) return SRC_GB + (n - 14336);
    if (n < 16896) return SRC_IQ + (n - 16384);
    n -= 16896;
    if (n < 16) return SRC_GLR + n;
    if (n < 80) return SRC_IK + (n - 16);
    if (n < 88) return SRC_IW + (n - 80);
    return -1;
}
__device__ __forceinline__ int map_wgu(int n) { const int j = n >> 8, rr = n & 255; return rr < 128 ? 128 * j + rr : DFF + 128 * j + (rr - 128); }

__device__ __forceinline__ void transpose_item(const float* W, int N, bf16_t* WT, int K, LAS float* scr, int kb, int nb, int lane, int src) {
    const int k0 = 64 * kb, n0 = 32 * nb;
    const float* wp = W + (size_t)(k0 + (lane >> 5)) * N + (src >= 0 ? src : 0);
    float v[32];
#pragma unroll
    for (int i = 0; i < 32; ++i) v[i] = (src >= 0) ? wp[(size_t)(2 * i) * N] : 0.f;
#pragma unroll
    for (int i = 0; i < 32; ++i) scr[(2 * i + (lane >> 5)) * 33 + (lane & 31)] = v[i];
    LDS_WAIT();
    const int c = lane & 7;
#pragma unroll
    for (int j = 0; j < 4; ++j) { const int n = (lane >> 3) + 8 * j; const LAS float* s = scr + (8 * c) * 33 + n;
        u32x4 o; o.x = pk2(s[0 * 33], s[1 * 33]); o.y = pk2(s[2 * 33], s[3 * 33]); o.z = pk2(s[4 * 33], s[5 * 33]); o.w = pk2(s[6 * 33], s[7 * 33]);
        *(u32x4*)(WT + (size_t)(n0 + n) * K + k0 + 8 * c) = o; }
    LDS_WAIT();
}

#define TR_ISSUE(v_, W_, N_, kb_, src_) do { const float* wp_ = (W_) + (size_t)(64 * (kb_) + (lane >> 5)) * (N_) + ((src_) >= 0 ? (src_) : 0); \
        _Pragma("unroll") for (int i_ = 0; i_ < 32; ++i_) v_[i_] = ((src_) >= 0) ? __builtin_nontemporal_load(wp_ + (size_t)(2 * i_) * (N_)) : 0.f; } while (0)
#define TR_FINISH(v_, WT_, K_, kb_, nb_) do { \
        _Pragma("unroll") for (int i_ = 0; i_ < 32; ++i_) scr[(2 * i_ + (lane >> 5)) * 33 + (lane & 31)] = v_[i_]; \
        LDS_WAIT(); const int c_ = lane & 7; \
        _Pragma("unroll") for (int j_ = 0; j_ < 4; ++j_) { const int n_ = (lane >> 3) + 8 * j_; const LAS float* s_ = scr + (8 * c_) * 33 + n_; \
            u32x4 o_; o_.x = pk2(s_[0 * 33], s_[1 * 33]); o_.y = pk2(s_[2 * 33], s_[3 * 33]); o_.z = pk2(s_[4 * 33], s_[5 * 33]); o_.w = pk2(s_[6 * 33], s_[7 * 33]); \
            *(u32x4*)((WT_) + (size_t)(32 * (nb_) + n_) * (K_) + 64 * (kb_) + 8 * c_) = o_; } \
        LDS_WAIT(); } while (0)

struct TrItem { const float* W; bf16_t* WT; int N, K, kb, nb, src; };
__device__ __forceinline__ TrItem tr_decode(const Ctx& X, int it, int l31) {
    constexpr int I_IN = 32 * (INWP / 32), I_SQ = 32 * 64, I_GU = 32 * (2 * DFF / 32);
    GAS GAS unsigned char* ws = X.ws; TrItem t; int r = it;
    if (r < I_IN) { const int nbk = INWP / 32; t.kb = r / nbk; t.nb = r % nbk; t.W = INP(X, I_WIN); t.N = INW; t.WT = (bf16_t*)(ws + WS_WIN); t.K = DM; t.src = map_win(32 * t.nb + l31); return t; } r -= I_IN;
    if (r < 3 * I_SQ) { const int q = r / I_SQ; r -= q * I_SQ; t.kb = r / 64; t.nb = r % 64; t.W = INP(X, q == 0 ? I_WBGA : (q == 1 ? I_WBDSA : I_WMO)); t.N = DM; t.WT = (bf16_t*)(ws + (q == 0 ? WS_WBGA : (q == 1 ? WS_WBDSA : WS_WMO))); t.K = DM; t.src = 32 * t.nb + l31; return t; } r -= 3 * I_SQ;
    if (r < I_GU) { const int nbk = 2 * DFF / 32; t.kb = r / nbk; t.nb = r % nbk; t.W = INP(X, I_WGU); t.N = 2 * DFF; t.WT = (bf16_t*)(ws + WS_WGU); t.K = DM; t.src = map_wgu(32 * t.nb + l31); return t; } r -= I_GU;
    t.kb = r / 64; t.nb = r % 64; t.W = INP(X, I_WDN); t.N = DM; t.WT = (bf16_t*)(ws + WS_WDN); t.K = DFF; t.src = 32 * t.nb + l31; return t;
}

template <bool DO_MOD>
__device__ __forceinline__ void p0_prologue(const Ctx& X) {
    GAS unsigned char* ws = X.ws; const int lane = X.lane;
    const int gw = X.bid * NW + X.wave, NGW = X.G * NW;
    constexpr int NGV = 32 * 48;
    if (DO_MOD) for (int it = gw; it < NGV; it += NGW) {
        const int kc = it / 48, cb = it % 48, k0 = 64 * kc, col = cb * 256 + 4 * lane;
        const float* wada = INP(X, I_WADA); const float* cvec = INP(X, I_C);
        float scb[4];
#pragma unroll
        for (int b = 0; b < 4; ++b) scb[b] = siluf(cvec[b * DM + k0 + lane]);
        f32x4 acc[4];
#pragma unroll
        for (int b = 0; b < 4; ++b) acc[b] = (f32x4){0.f, 0.f, 0.f, 0.f};
#pragma unroll
        for (int hb = 0; hb < 2; ++hb) {
            f32x4 w[32];
#pragma unroll
            for (int kk = 0; kk < 32; ++kk) w[kk] = __builtin_nontemporal_load((const f32x4*)(wada + (size_t)(k0 + 32 * hb + kk) * NMOD + col));
#pragma unroll
            for (int kk = 0; kk < 32; ++kk)
#pragma unroll
                for (int b = 0; b < 4; ++b) acc[b] += w[kk] * __builtin_bit_cast(float, __builtin_amdgcn_readlane(__builtin_bit_cast(int, scb[b]), 32 * hb + kk));
            asm volatile("" ::: "memory");
        }
        float* part = (float*)(ws + WS_MODP);
#pragma unroll
        for (int b = 0; b < 4; ++b) *(f32x4*)(part + ((size_t)kc * 4 + b) * NMOD + col) = acc[b];
    }
    STAMP(14);
    {
        const int* pos = (const int*)INP(X, I_POS);
        float2* rd = (float2*)(ws + WS_ROPED); float2* ri = (float2*)(ws + WS_ROPEI);
        for (int i = X.bid * NT + X.tid; i < MTOK * 24; i += X.G * NT) {
            int m, j; float ex; float2* dst;
            if (i < MTOK * 16) { m = i >> 4; j = i & 15; ex = (float)j * (1.0f / 16.0f); dst = rd + i; }
            else { const int i2 = i - MTOK * 16; m = i2 >> 3; j = i2 & 7; ex = (float)j * (1.0f / 8.0f); dst = ri + i2; }
            const float inv = exp2f(-ex * 18.931568569324174f);
            const float ang = (float)pos[m] * inv;
            double r = (double)ang * 0.15915494309189535; r -= rint(r);
            const float ar = (float)(r * 6.283185307179586);
            *dst = make_float2(__cosf(ar), __sinf(ar));
        }
    }
    STAMP(15);
    {
        LAS float* scr = (LAS float*)(X.lds + 1024 + X.wave * 8704);
        constexpr int NITEMS = 32 * (INWP / 32) + 3 * 32 * 64 + 32 * (2 * DFF / 32) + (DFF / 64) * 64;
        const int nx = (NGW > NGV) ? (NGW - NGV) : 0, NEXTRA = (DO_MOD && 8 * nx < NITEMS) ? 8 * nx : 0;
        const int nmine_x = (DO_MOD && gw >= NGV && NEXTRA) ? 8 : 0;
        auto item_of = [&](int k) -> int { if (k < nmine_x) return (gw - NGV) * 8 + k; const int it = NEXTRA + gw + (k - nmine_x) * NGW; return it < NITEMS ? it : -1; };
        float va[32], vb[32];
        int k = 0, ia = item_of(0);
        TrItem A, B; A.kb = 0; B.kb = 0;
        if (ia >= 0) { A = tr_decode(X, ia, lane & 31); TR_ISSUE(va, A.W, A.N, A.kb, A.src); }
        while (ia >= 0) {
            const int ib = item_of(k + 1);
            if (ib >= 0) { B = tr_decode(X, ib, lane & 31); TR_ISSUE(vb, B.W, B.N, B.kb, B.src); }
            TR_FINISH(va, A.WT, A.K, A.kb, A.nb);
            if (ib < 0) break;
            const int ic = item_of(k + 2);
            if (ic >= 0) { A = tr_decode(X, ic, lane & 31); TR_ISSUE(va, A.W, A.N, A.kb, A.src); }
            TR_FINISH(vb, B.WT, B.K, B.kb, B.nb);
            ia = ic; k += 2;
        }
    }
}

__device__ __forceinline__ void norm_mod_rows(const Ctx& X, const float* x, const float* gain, const float* mod, int i_sh, int i_sc, bf16_t* out) {
    const int gw = X.bid * NW + X.wave, NGW = X.G * NW;
    for (int row = gw; row < MTOK; row += NGW) {
        const int b = row >> 11;
        const f32x4* xr = (const f32x4*)(x + (size_t)row * DM) + X.lane;
        f32x4 v[8]; float s = 0.f;
#pragma unroll
        for (int j = 0; j < 8; ++j) { v[j] = xr[64 * j]; s += (v[j][0] * v[j][0] + v[j][1] * v[j][1]) + (v[j][2] * v[j][2] + v[j][3] * v[j][3]); }
        const float rs = rsqrtf(wave_sum(s) * (1.f / DM) + RMS_EPS);
        const f32x4* g4 = (const f32x4*)gain + X.lane;
        const f32x4* sh4 = (const f32x4*)(mod + (size_t)b * NMOD + i_sh * DM) + X.lane;
        const f32x4* sc4 = (const f32x4*)(mod + (size_t)b * NMOD + i_sc * DM) + X.lane;
        u32x2* o8 = (u32x2*)(out + (size_t)row * DM) + X.lane;
#pragma unroll
        for (int j = 0; j < 8; ++j) { const f32x4 y = v[j] * rs * g4[64 * j] * (sc4[64 * j] + 1.f) + sh4[64 * j]; u32x2 w; w.x = pk2(y[0], y[1]); w.y = pk2(y[2], y[3]); o8[64 * j] = w; }
    }
}
__device__ __forceinline__ void norm1_rows(const Ctx& X, const float* x, const float* gain, const float* bada, float* mod, bf16_t* out) {
    const float* part = (const float*)(X.ws + WS_MODP);
    for (int o = X.bid * NT + X.tid; o < 4 * NMOD; o += X.G * NT) { const int bb = o / NMOD, n = o % NMOD; float t = bada[n];
#pragma unroll
        for (int kc = 0; kc < 32; ++kc) t += part[((size_t)kc * 4 + bb) * NMOD + n];
        mod[o] = t; }
    const int nbp = X.G >> 2, b = (X.bid / nbp) < 3 ? (X.bid / nbp) : 3, lb = X.bid - b * nbp, nbb = (b == 3) ? (X.G - 3 * nbp) : nbp;
    LAS float* shs = (LAS float*)X.lds;
    for (int n = X.tid; n < 2 * DM; n += NT) { float t = bada[n];
#pragma unroll
        for (int kc = 0; kc < 32; ++kc) t += part[((size_t)kc * 4 + b) * NMOD + n];
        shs[n] = t; }
    __syncthreads();
    for (int rl = lb * NW + X.wave; rl < SEQ; rl += nbb * NW) {
        const int row = b * SEQ + rl;
        const f32x4* xr = (const f32x4*)(x + (size_t)row * DM) + X.lane;
        f32x4 v[8]; float s = 0.f;
#pragma unroll
        for (int j = 0; j < 8; ++j) { v[j] = xr[64 * j]; s += (v[j][0] * v[j][0] + v[j][1] * v[j][1]) + (v[j][2] * v[j][2] + v[j][3] * v[j][3]); }
        const float rs = rsqrtf(wave_sum(s) * (1.f / DM) + RMS_EPS);
        const f32x4* g4 = (const f32x4*)gain + X.lane;
        u32x2* o8 = (u32x2*)(out + (size_t)row * DM) + X.lane;
#pragma unroll
        for (int j = 0; j < 8; ++j) { const f32x4 sh = *(const LAS f32x4*)(shs + 4 * (X.lane + 64 * j)), sc = *(const LAS f32x4*)(shs + DM + 4 * (X.lane + 64 * j));
            const f32x4 y = v[j] * rs * g4[64 * j] * (sc + 1.f) + sh; u32x2 w; w.x = pk2(y[0], y[1]); w.y = pk2(y[2], y[3]); o8[64 * j] = w; }
    }
    __syncthreads();
}
__device__ __forceinline__ void final_norm_rows(const Ctx& X, float* x, const float* gain) {
    const int gw = X.bid * NW + X.wave, NGW = X.G * NW;
    for (int row = gw; row < MTOK; row += NGW) {
        f32x4* xr = (f32x4*)(x + (size_t)row * DM) + X.lane;
        f32x4 v[8]; float s = 0.f;
#pragma unroll
        for (int j = 0; j < 8; ++j) { v[j] = xr[64 * j]; s += (v[j][0] * v[j][0] + v[j][1] * v[j][1]) + (v[j][2] * v[j][2] + v[j][3] * v[j][3]); }
        const float rs = rsqrtf(wave_sum(s) * (1.f / DM) + RMS_EPS);
        const f32x4* g4 = (const f32x4*)gain + X.lane;
#pragma unroll
        for (int j = 0; j < 8; ++j) xr[64 * j] = v[j] * rs * g4[64 * j];
    }
}

__device__ __forceinline__ float log_sigmoid_f(float z) { return fminf(z, 0.f) - __logf(1.f + __expf(-fabsf(z))); }

__device__ __forceinline__ void gla_prep_unit(const Ctx& X, const Args& a, int u) {
    GAS unsigned char* ws = X.ws; const int tid = X.tid, lane = X.lane, wave = X.wave;
    LAS bf16_t* qs = (LAS bf16_t*)X.lds;
    LAS bf16_t* ks = (LAS bf16_t*)(X.lds + 33792);
    LAS float* glr = (LAS float*)(X.lds + 67584);
    LAS float* tot = (LAS float*)(X.lds + 71680);
    const int h = u & 3, row0 = (u >> 2) * 64;
    bf16_t* qblk = (bf16_t*)(ws + WS_QA) + (size_t)u * 64 * 256;
    bf16_t* kblk = (bf16_t*)(ws + WS_KA) + (size_t)u * 64 * 256;
    const float* small = (const float*)(ws + WS_SMALL);
    for (int i = tid; i < 1024; i += NT) glr[i] = small[(size_t)(row0 + (i >> 4)) * SMALLW + 512 + (i & 15)];
#pragma unroll
    for (int i = 0; i < 4; ++i) { const int id = tid + NT * i, t = id >> 5, c16 = id & 31;
        *(LAS u32x4*)(qs + t * 264 + 8 * c16) = *(const u32x4*)(qblk + t * 256 + 8 * c16); *(LAS u32x4*)(ks + t * 264 + 8 * c16) = *(const u32x4*)(kblk + t * 256 + 8 * c16); }
    const int d = tid & 255, half = tid >> 8;
    float up[16];
#pragma unroll
    for (int r = 0; r < 16; ++r) up[r] = INP(X, I_GUP)[r * 1024 + h * 256 + d];
    const float bias = INP(X, I_GBIAS)[h * 256 + d];
    __syncthreads();
    float lg[32]; float tsum = 0.f;
#pragma unroll
    for (int tt = 0; tt < 32; ++tt) { const int t = 32 * half + tt; float z = bias;
        const LAS f32x4* gp = (const LAS f32x4*)(glr + t * 16);
#pragma unroll
        for (int r4 = 0; r4 < 4; ++r4) { const f32x4 g4 = gp[r4]; z += g4[0] * up[4 * r4] + g4[1] * up[4 * r4 + 1] + g4[2] * up[4 * r4 + 2] + g4[3] * up[4 * r4 + 3]; }
        tsum += log_sigmoid_f(z) * 0.0625f; lg[tt] = tsum; }
    if (half == 0) tot[d] = tsum;
    __syncthreads();
    const float cum0 = half ? tot[d] : 0.f; float cum = cum0;
#pragma unroll
    for (int tt = 0; tt < 32; ++tt) { const int t = 32 * half + tt; cum = cum0 + lg[tt];
        const float qv = bf2f(qs[t * 264 + d]), kv = bf2f(ks[t * 264 + d]); const float e = __expf(cum);
        qs[t * 264 + d] = (bf16_t)f2bf(qv * e * 0.0625f); ks[t * 264 + d] = (bf16_t)f2bf(kv * __frcp_rn(e)); }
    if (half == 1) ((float*)(ws + WS_GDEC))[(size_t)u * 256 + d] = expf(cum);
    __syncthreads();
#pragma unroll
    for (int i = 0; i < 4; ++i) { const int id = tid + NT * i, t = id >> 5, c16 = id & 31; *(u32x4*)(qblk + t * 256 + 8 * c16) = *(const LAS u32x4*)(qs + t * 264 + 8 * c16); }
    {
        u32x4* dst = (u32x4*)(kblk + d * 64 + 32 * half);
#pragma unroll
        for (int i = 0; i < 4; ++i) { unsigned e[8];
#pragma unroll
            for (int k = 0; k < 8; ++k) e[k] = ks[(32 * half + 8 * i + k) * 264 + d];
            dst[i] = (u32x4){e[0] | (e[1] << 16), e[2] | (e[3] << 16), e[4] | (e[5] << 16), e[6] | (e[7] << 16)}; }
    }
    if (wave < 4) {
        const int ti = wave >> 1, tj = wave & 1, r32 = lane & 31, hi = lane >> 5;
        f32x16 acc;
#pragma unroll
        for (int r = 0; r < 16; ++r) acc[r] = 0.f;
#pragma unroll
        for (int s = 0; s < 16; ++s) { const bf16x8 af = *(const LAS bf16x8*)(qs + (32 * ti + r32) * 264 + 16 * s + 8 * hi); const bf16x8 bf = *(const LAS bf16x8*)(ks + (32 * tj + r32) * 264 + 16 * s + 8 * hi); acc = MFMA32(af, bf, acc); }
        bf16_t* at = (bf16_t*)(ws + WS_ATTN) + (size_t)u * 4096;
#pragma unroll
        for (int r = 0; r < 16; ++r) { const int i = 32 * ti + crow(r, hi), j = 32 * tj + r32; at[i * 64 + j] = (bf16_t)f2bf(j <= i ? acc[r] : 0.f); }
    }
    __syncthreads();
    {
        LAS bf16_t* vs = (LAS bf16_t*)X.lds;
        bf16_t* vblk = (bf16_t*)(ws + WS_VA) + (size_t)u * 64 * 512;
#pragma unroll
        for (int i = 0; i < 8; ++i) { const int id = tid + NT * i, t = id >> 6, c16 = id & 63; *(LAS u32x4*)(vs + t * 520 + 8 * c16) = *(const u32x4*)(vblk + t * 512 + 8 * c16); }
        __syncthreads();
#pragma unroll
        for (int i = 0; i < 8; ++i) { const int id = tid + NT * i, tq = id & 7, dv = id >> 3; unsigned e[8];
#pragma unroll
            for (int k = 0; k < 8; ++k) e[k] = vs[(8 * tq + k) * 520 + dv];
            *(u32x4*)(vblk + dv * 64 + 8 * tq) = (u32x4){e[0] | (e[1] << 16), e[2] | (e[3] << 16), e[4] | (e[5] << 16), e[6] | (e[7] << 16)}; }
    }
    __syncthreads();
}

__device__ __forceinline__ void dv_transpose(const Ctx& X) {
    LAS bf16_t* scr = (LAS bf16_t*)(X.lds + X.wave * 17408);
    const int gw = X.bid * NW + X.wave, NGW = X.G * NW, lane = X.lane;
    for (int blk = gw; blk < BATCH * NCH * DH; blk += NGW) {
        bf16_t* p = (bf16_t*)(X.ws + WS_DV) + (size_t)blk * 64 * 128;
#pragma unroll
        for (int i = 0; i < 16; ++i) { const int id = lane + 64 * i, t = id >> 4, c16 = id & 15; *(LAS u32x4*)(scr + t * 136 + 8 * c16) = *(const u32x4*)(p + t * 128 + 8 * c16); }
        LDS_WAIT();
#pragma unroll
        for (int i = 0; i < 16; ++i) { const int id = lane + 64 * i, kq = id & 7, dd = id >> 3; unsigned e[8];
#pragma unroll
            for (int k = 0; k < 8; ++k) e[k] = scr[(8 * kq + k) * 136 + dd];
            *(u32x4*)(p + dd * 64 + 8 * kq) = (u32x4){e[0] | (e[1] << 16), e[2] | (e[3] << 16), e[4] | (e[5] << 16), e[6] | (e[7] << 16)}; }
        LDS_WAIT();
    }
}

__device__ __forceinline__ void idx_prep(const Ctx& X) {
    const int gw = X.bid * NW + X.wave, NGW = X.G * NW, lane = X.lane;
    const float* small = (const float*)(X.ws + WS_SMALL);
    const float2* ri = (const float2*)(X.ws + WS_ROPEI);
    for (int m = gw; m < MTOK; m += NGW) {
        const float* sr = small + (size_t)m * SMALLW;
        float2 cs[8];
#pragma unroll
        for (int e = 0; e < 8; ++e) cs[e] = ri[(size_t)m * 8 + e];
        {
            const int seg = lane & 7; float v[8];
            const f32x4 a0 = *(const f32x4*)(sr + 8 * lane), a1 = *(const f32x4*)(sr + 8 * lane + 4);
            v[0] = a0[0]; v[1] = a0[1]; v[2] = a0[2]; v[3] = a0[3]; v[4] = a1[0]; v[5] = a1[1]; v[6] = a1[2]; v[7] = a1[3];
#pragma unroll
            for (int e = 0; e < 8; ++e) { const float p = __shfl_xor(v[e], 1); if (seg == 0) v[e] = v[e] * cs[e].x - p * cs[e].y; else if (seg == 1) v[e] = p * cs[e].y + v[e] * cs[e].x; }
            *(u32x4*)((bf16_t*)(X.ws + WS_IQ) + (size_t)m * 512 + 8 * lane) = (u32x4){pk2(v[0], v[1]), pk2(v[2], v[3]), pk2(v[4], v[5]), pk2(v[6], v[7])};
        }
        {
            const int l7 = lane & 7; float v[8];
            const f32x4 a0 = *(const f32x4*)(sr + 528 + 8 * l7), a1 = *(const f32x4*)(sr + 528 + 8 * l7 + 4);
            v[0] = a0[0]; v[1] = a0[1]; v[2] = a0[2]; v[3] = a0[3]; v[4] = a1[0]; v[5] = a1[1]; v[6] = a1[2]; v[7] = a1[3];
#pragma unroll
            for (int e = 0; e < 8; ++e) { const float p = __shfl_xor(v[e], 1); if (l7 == 0) v[e] = v[e] * cs[e].x - p * cs[e].y; else if (l7 == 1) v[e] = p * cs[e].y + v[e] * cs[e].x; }
            if (lane < 8) *(u32x4*)((bf16_t*)(X.ws + WS_IK) + (size_t)m * 64 + 8 * lane) = (u32x4){pk2(v[0], v[1]), pk2(v[2], v[3]), pk2(v[4], v[5]), pk2(v[6], v[7])};
            if (lane < 8) ((float*)(X.ws + WS_IW))[(size_t)m * 8 + lane] = sr[592 + lane] * 0.044194173824159216f;
        }
    }
}

__device__ __forceinline__ void rope_qk(const Ctx& X) {
    const int gw = X.bid * NW + X.wave, NGW = X.G * NW, lane = X.lane, seg = lane & 3;
    const float sg = (seg < 2) ? -1.f : 1.f;
    for (int m = gw; m < MTOK; m += NGW) {
        const f32x4* cs = (const f32x4*)((const float2*)(X.ws + WS_ROPED) + (size_t)m * 16 + 8 * (seg & 1));
        const f32x4 c01 = cs[0], c23 = cs[1], c45 = cs[2], c67 = cs[3];
#pragma unroll
        for (int which = 0; which < 2; ++which) {
            bf16_t* p = (bf16_t*)(X.ws + (which ? WS_DK : WS_DQ)) + (size_t)m * DM + (lane >> 2) * DHD + 8 * seg;
            const u32x4 w = *(const u32x4*)p;
            float v[8] = {bf2f(w.x & 0xffffu), bf2f(w.x >> 16), bf2f(w.y & 0xffffu), bf2f(w.y >> 16), bf2f(w.z & 0xffffu), bf2f(w.z >> 16), bf2f(w.w & 0xffffu), bf2f(w.w >> 16)};
            float q[8];
#pragma unroll
            for (int e = 0; e < 8; ++e) q[e] = __shfl_xor(v[e], 2);
            v[0] = v[0] * c01[0] + sg * q[0] * c01[1]; v[1] = v[1] * c01[2] + sg * q[1] * c01[3]; v[2] = v[2] * c23[0] + sg * q[2] * c23[1]; v[3] = v[3] * c23[2] + sg * q[3] * c23[3];
            v[4] = v[4] * c45[0] + sg * q[4] * c45[1]; v[5] = v[5] * c45[2] + sg * q[5] * c45[3]; v[6] = v[6] * c67[0] + sg * q[6] * c67[1]; v[7] = v[7] * c67[2] + sg * q[7] * c67[3];
            *(u32x4*)p = (u32x4){pk2(v[0], v[1]), pk2(v[2], v[3]), pk2(v[4], v[5]), pk2(v[6], v[7])};
        }
    }
}

constexpr int LDS_MISC = 143360;
__device__ __forceinline__ void gla_scan_unit(const Ctx& X, int unit) {
    GAS unsigned char* ws = X.ws; const int tid = X.tid, lane = X.lane, wave = X.wave, r32 = lane & 31, hi = lane >> 5;
    const int p = unit & 15, sl = unit >> 4, b = p >> 2, h = p & 3, j = wave & 1, g = wave >> 1;
    LAS bf16_t* qs = (LAS bf16_t*)X.lds;
    LAS bf16_t* kts = (LAS bf16_t*)(X.lds + 33792);
    LAS bf16_t* as_ = (LAS bf16_t*)(X.lds + 70656);
    LAS bf16_t* vts = (LAS bf16_t*)(X.lds + 79872);
    LAS float* gd = (LAS float*)(X.lds + 89088);
    LAS unsigned char* po = X.lds + 90112;
    f32x16 S[2];
#pragma unroll
    for (int k = 0; k < 2; ++k)
#pragma unroll
        for (int r = 0; r < 16; ++r) S[k][r] = 0.f;
    float* oa = (float*)(ws + WS_OA);
    u32x4 pqA[4], pkA[4], pqB[4], pkB[4], pa1, pv1; f32x4 pg1 = (f32x4){0.f, 0.f, 0.f, 0.f};
#define SCAN_ISSUE_BIG(c_, pq, pk) do { const int ub_ = (b * NCH + (c_)) * 4 + h; \
        const bf16_t* qblk_ = (const bf16_t*)(ws + WS_QA) + (size_t)ub_ * 64 * 256; const bf16_t* kblk_ = (const bf16_t*)(ws + WS_KA) + (size_t)ub_ * 64 * 256; \
        _Pragma("unroll") for (int i_ = 0; i_ < 4; ++i_) { const int id_ = tid + NT * i_; pq[i_] = *(const u32x4*)(qblk_ + (id_ >> 5) * 256 + 8 * (id_ & 31)); pk[i_] = *(const u32x4*)(kblk_ + (id_ >> 3) * 64 + 8 * (id_ & 7)); } } while (0)
#define SCAN_ISSUE_SMALL(c_) do { const int ub_ = (b * NCH + (c_)) * 4 + h; \
        const bf16_t* vblk_ = (const bf16_t*)(ws + WS_VA) + (size_t)ub_ * 64 * 512 + (size_t)(64 * sl) * 64; const bf16_t* ablk_ = (const bf16_t*)(ws + WS_ATTN) + (size_t)ub_ * 4096; \
        pa1 = *(const u32x4*)(ablk_ + (tid >> 3) * 64 + 8 * (tid & 7)); pv1 = *(const u32x4*)(vblk_ + (tid >> 3) * 64 + 8 * (tid & 7)); \
        pg1 = *(const f32x4*)((const float*)(ws + WS_GDEC) + (size_t)ub_ * 256 + 4 * (tid & 63)); } while (0)
#define SCAN_COMMIT_BIG(pq, pk) do { \
        _Pragma("unroll") for (int i_ = 0; i_ < 4; ++i_) { const int id_ = tid + NT * i_; *(LAS u32x4*)(qs + (id_ >> 5) * 264 + 8 * (id_ & 31)) = pq[i_]; *(LAS u32x4*)(kts + (id_ >> 3) * 72 + 8 * (id_ & 7)) = pk[i_]; } } while (0)
#define SCAN_COMMIT_SMALL() do { \
        *(LAS u32x4*)(as_ + (tid >> 3) * 72 + 8 * (tid & 7)) = pa1; *(LAS u32x4*)(vts + (tid >> 3) * 72 + 8 * (tid & 7)) = pv1; \
        if (tid < 64) *(LAS f32x4*)(gd + 4 * tid) = pg1; } while (0)
#define SCAN_BAR() do { asm volatile("s_waitcnt lgkmcnt(0)" ::: "memory"); __builtin_amdgcn_s_barrier(); asm volatile("" ::: "memory"); } while (0)
#define SCAN_STEP(c_, ISSUE_, COMMIT_) do { \
        ISSUE_; \
        f32x16 o[2]; \
        _Pragma("unroll") for (int tt = 0; tt < 2; ++tt) _Pragma("unroll") for (int r = 0; r < 16; ++r) o[tt][r] = 0.f; \
          \
        _Pragma("unroll") for (int kk = 0; kk < 2; ++kk) _Pragma("unroll") for (int s = 0; s < 2; ++s) { \
                u32x4 sw; sw.x = pg8::cvt_pk_bf16(S[kk][8 * s + 0], S[kk][8 * s + 1]); sw.y = pg8::cvt_pk_bf16(S[kk][8 * s + 2], S[kk][8 * s + 3]); \
                sw.z = pg8::cvt_pk_bf16(S[kk][8 * s + 4], S[kk][8 * s + 5]); sw.w = pg8::cvt_pk_bf16(S[kk][8 * s + 6], S[kk][8 * s + 7]); \
                const bf16x8 bs = __builtin_bit_cast(bf16x8, sw); \
                _Pragma("unroll") for (int tt = 0; tt < 2; ++tt) { const LAS bf16_t* qp = qs + (32 * tt + r32) * 264 + 64 * g + 32 * kk + 16 * s + 4 * hi; \
                    const u32x2 lo = *(const LAS u32x2*)qp, hi2 = *(const LAS u32x2*)(qp + 8); \
                    const bf16x8 af = __builtin_bit_cast(bf16x8, (u32x4){lo.x, lo.y, hi2.x, hi2.y}); \
                    o[tt] = MFMA32(af, bs, o[tt]); } } \
        asm volatile("" ::: "memory"); \
        bf16x8 bv[4]; \
        _Pragma("unroll") for (int s = 0; s < 4; ++s) bv[s] = *(const LAS bf16x8*)(vts + (32 * j + r32) * 72 + 16 * s + 8 * hi); \
        if (g == 0) { \
            _Pragma("unroll") for (int tt = 0; tt < 2; ++tt) _Pragma("unroll") for (int s = 0; s < 4; ++s) { const bf16x8 af = *(const LAS bf16x8*)(as_ + (32 * tt + r32) * 72 + 16 * s + 8 * hi); o[tt] = MFMA32(af, bv[s], o[tt]); } } \
          \
        _Pragma("unroll") for (int q = 0; q < 4; ++q) if (q != g) { const int rank_ = g < q ? g : g - 1; \
            _Pragma("unroll") for (int tt = 0; tt < 2; ++tt) \
                *(LAS f32x4*)(po + ((((q * 2 + j) * 3 + rank_) * 2 + tt) * 64 + lane) * 16) = (f32x4){o[tt][4 * q], o[tt][4 * q + 1], o[tt][4 * q + 2], o[tt][4 * q + 3]}; } \
        asm volatile("" ::: "memory"); \
        _Pragma("unroll") for (int kk = 0; kk < 2; ++kk) { \
            _Pragma("unroll") for (int s = 0; s < 4; ++s) { const bf16x8 af = *(const LAS bf16x8*)(kts + (64 * g + 32 * kk + r32) * 72 + 16 * s + 8 * hi); S[kk] = MFMA32(af, bv[s], S[kk]); } \
            _Pragma("unroll") for (int q4 = 0; q4 < 4; ++q4) { const f32x4 dv = *(const LAS f32x4*)(gd + 64 * g + 32 * kk + 8 * q4 + 4 * hi); \
                _Pragma("unroll") for (int jj = 0; jj < 4; ++jj) S[kk][4 * q4 + jj] *= dv[jj]; } } \
        SCAN_BAR(); \
        {   \
            _Pragma("unroll") for (int tt = 0; tt < 2; ++tt) { \
                f32x4 own = (f32x4){o[tt][0], o[tt][1], o[tt][2], o[tt][3]}; \
                if (g == 1) own = (f32x4){o[tt][4], o[tt][5], o[tt][6], o[tt][7]}; else if (g == 2) own = (f32x4){o[tt][8], o[tt][9], o[tt][10], o[tt][11]}; else if (g == 3) own = (f32x4){o[tt][12], o[tt][13], o[tt][14], o[tt][15]}; \
                _Pragma("unroll") for (int rk = 0; rk < 3; ++rk) own += *(const LAS f32x4*)(po + ((((g * 2 + j) * 3 + rk) * 2 + tt) * 64 + lane) * 16); \
                float* op_ = oa + ((size_t)((((b * NCH + (c_)) * 4 + h) * 8 + sl) * 2 + j) * 32 + tt * 16 + 4 * g) * 64 + lane; \
                op_[0] = own[0]; op_[64] = own[1]; op_[128] = own[2]; op_[192] = own[3]; } } \
        COMMIT_; \
        SCAN_BAR(); } while (0)
    __syncthreads();
    SCAN_ISSUE_BIG(0, pqA, pkA); SCAN_ISSUE_SMALL(0); SCAN_COMMIT_BIG(pqA, pkA); SCAN_COMMIT_SMALL();
    SCAN_ISSUE_BIG(1, pqB, pkB);
    __syncthreads();
#pragma unroll 1
    for (int c = 0; c < NCH; c += 2) {
        SCAN_STEP(c, do { SCAN_ISSUE_BIG(((c + 2 < NCH) ? c + 2 : NCH - 1), pqA, pkA); SCAN_ISSUE_SMALL(c + 1); } while (0), do { SCAN_COMMIT_BIG(pqB, pkB); SCAN_COMMIT_SMALL(); } while (0));
        SCAN_STEP(c + 1, do { SCAN_ISSUE_BIG(((c + 3 < NCH) ? c + 3 : NCH - 1), pqB, pkB); SCAN_ISSUE_SMALL(((c + 2 < NCH) ? c + 2 : NCH - 1)); } while (0), do { SCAN_COMMIT_BIG(pqA, pkA); SCAN_COMMIT_SMALL(); } while (0));
    }
    __syncthreads();
#undef SCAN_ISSUE_BIG
#undef SCAN_ISSUE_SMALL
#undef SCAN_COMMIT_BIG
#undef SCAN_COMMIT_SMALL
#undef SCAN_STEP
#undef SCAN_BAR
}

__device__ __forceinline__ unsigned fkey(float f) { const unsigned u = __float_as_uint(f); return (u & 0x80000000u) ? ~u : (u | 0x80000000u); }
__device__ __forceinline__ void idx_topk_unit(const Ctx& X, int unit) {
    GAS unsigned char* ws = X.ws; const int lane = X.lane, wave = X.wave;
    const int b = unit >> 7, qb = unit & 127, q0 = 16 * qb;
    LAS float* sc = (LAS float*)X.lds;
    const bf16_t* IQ = (const bf16_t*)(ws + WS_IQ); const bf16_t* IK = (const bf16_t*)(ws + WS_IK); const float* IW = (const float*)(ws + WS_IW);
    const int l15 = lane & 15, l4 = lane >> 4;
    {
        bf16x8 bq[8][2]; float wq[8];
        const size_t mq = (size_t)(b * SEQ + q0 + l15);
#pragma unroll
        for (int hh = 0; hh < 8; ++hh) { wq[hh] = IW[mq * 8 + hh];
#pragma unroll
            for (int s = 0; s < 2; ++s) bq[hh][s] = *(const bf16x8*)(IQ + mq * 512 + hh * 64 + 32 * s + 8 * l4); }
        const int ntile = qb + 1;
        for (int tile0 = wave; tile0 < ntile; tile0 += 4 * NW) {
            bf16x8 ka[4][2];
#pragma unroll
            for (int e = 0; e < 4; ++e) { const int tl = (tile0 + NW * e < ntile) ? tile0 + NW * e : ntile - 1; const size_t mk = (size_t)(b * SEQ + 16 * tl + l15);
                ka[e][0] = *(const bf16x8*)(IK + mk * 64 + 8 * l4); ka[e][1] = *(const bf16x8*)(IK + mk * 64 + 32 + 8 * l4); }
#pragma unroll
            for (int e = 0; e < 4; ++e) { const int tile = tile0 + NW * e;
                if (tile < ntile) {
                    f32x4 s4 = (f32x4){0.f, 0.f, 0.f, 0.f};
#pragma unroll
                    for (int hh = 0; hh < 8; ++hh) { f32x4 acc = (f32x4){0.f, 0.f, 0.f, 0.f}; acc = MFMA16(ka[e][0], bq[hh][0], acc); acc = MFMA16(ka[e][1], bq[hh][1], acc);
#pragma unroll
                        for (int r = 0; r < 4; ++r) s4[r] += wq[hh] * fmaxf(acc[r], 0.f); }
                    *(LAS f32x4*)(sc + l15 * 2048 + 16 * tile + 4 * l4) = s4;
                } }
        }
    }
    __syncthreads();
    unsigned long long* mask = (unsigned long long*)(ws + WS_MASK);
    for (int qi = 0; qi < 2; ++qi) {
        const int q = 2 * wave + qi, t = q0 + q, n = t + 1;
        unsigned long long myw = 0ull;
        if (n <= TOPK) {
            const int lo = 64 * lane;
            if (lo + 63 <= t) myw = ~0ull; else if (lo <= t) myw = (~0ull) >> (63 - (t - lo));
        } else {
            unsigned u[32];
#pragma unroll
            for (int r = 0; r < 32; ++r) { const int key = 64 * r + lane; u[r] = (key <= t) ? fkey(sc[q * 2048 + (key <= t ? key : 0)]) : 0u; }
            unsigned T = 0u; bool exact = false;
            for (int bit = 31; bit >= 0; --bit) { const unsigned cand = T | (1u << bit); int c0 = 0, c1 = 0, c2 = 0, c3 = 0;
#pragma unroll
                for (int r = 0; r < 32; r += 4) { c0 += (u[r] >= cand) ? 1 : 0; c1 += (u[r + 1] >= cand) ? 1 : 0; c2 += (u[r + 2] >= cand) ? 1 : 0; c3 += (u[r + 3] >= cand) ? 1 : 0; }
                const int c = (c0 + c1) + (c2 + c3);
                int cnt = 0;
#pragma unroll
                for (int bb = 0; bb < 6; ++bb) cnt += __popcll(__ballot((c >> bb) & 1)) << bb;
                if (cnt >= TOPK) T = cand;
                if (cnt == TOPK) { exact = true; break; } }
            int cg_ = 0;
#pragma unroll
            for (int r = 0; r < 32; ++r) cg_ += (u[r] > T) ? 1 : 0;
            int ngt = 0;
#pragma unroll
            for (int bb = 0; bb < 6; ++bb) ngt += __popcll(__ballot((cg_ >> bb) & 1)) << bb;
            const int need = exact ? (1 << 20) : (TOPK - ngt);
            int base = 0;
#pragma unroll
            for (int r = 0; r < 32; ++r) { const bool eq = (u[r] == T); const unsigned long long me = __ballot(eq);
                const int before = base + (int)__builtin_amdgcn_mbcnt_hi((unsigned)(me >> 32), __builtin_amdgcn_mbcnt_lo((unsigned)me, 0u));
                const unsigned long long w = __ballot((u[r] > T) || (eq && before < need));
                base += __popcll(me);
                if (lane == r) myw = w;
                __builtin_amdgcn_sched_barrier(0); }
        }
        if (lane < 32) mask[(size_t)(b * SEQ + t) * 32 + lane] = myw;
    }
    __syncthreads();
}

__device__ __forceinline__ void dsa_attn_unit(const Ctx& X, int b, int head, int qb) {
    GAS unsigned char* ws = X.ws; const int tid = X.tid, lane = X.lane, wave = X.wave, r32 = lane & 31, hi = lane >> 5;
    LAS bf16_t* Kb = (LAS bf16_t*)X.lds;
    LAS bf16_t* Vb = (LAS bf16_t*)(X.lds + 34816);
    const bf16_t* DQ = (const bf16_t*)(ws + WS_DQ); const bf16_t* DK = (const bf16_t*)(ws + WS_DK); const bf16_t* DV = (const bf16_t*)(ws + WS_DV);
    const unsigned* mask = (const unsigned*)(ws + WS_MASK);
    const int qrow = b * SEQ + 256 * qb + 32 * wave + r32;
    const int NTL = 4 * qb + 4;
    const int myNT = 4 * qb + ((32 * wave + 31) >> 6) + 1;
    bf16x8 qf[8];
#pragma unroll
    for (int s = 0; s < 8; ++s) qf[s] = *(const bf16x8*)(DQ + (size_t)qrow * DM + head * DHD + 16 * s + 8 * hi);
    f32x16 ot[4];
#pragma unroll
    for (int d = 0; d < 4; ++d)
#pragma unroll
        for (int r = 0; r < 16; ++r) ot[d][r] = 0.f;
    float m_run = -1e30f, l_run = 0.f;
    const float C2 = 0.08838834764831845f * 1.4426950408889634f;
    u32x4 kA0, kA1, vA0, vA1, kB0, kB1, vB0, vB1;
#define ATT_ISSUE(kt_, k0_, k1_, v0_, v1_) do { \
        { const int id = tid, key = id >> 4, c16 = id & 15; k0_ = *(const u32x4*)(DK + (size_t)(b * SEQ + 64 * (kt_) + key) * DM + head * DHD + 8 * c16); } \
        { const int id = tid + NT, key = id >> 4, c16 = id & 15; k1_ = *(const u32x4*)(DK + (size_t)(b * SEQ + 64 * (kt_) + key) * DM + head * DHD + 8 * c16); } \
        { const int id = tid, dv = id >> 3, c16 = id & 7; v0_ = *(const u32x4*)(DV + ((size_t)((b * NCH + (kt_)) * DH + head) * 128 + dv) * 64 + 8 * c16); } \
        { const int id = tid + NT, dv = id >> 3, c16 = id & 7; v1_ = *(const u32x4*)(DV + ((size_t)((b * NCH + (kt_)) * DH + head) * 128 + dv) * 64 + 8 * c16); } } while (0)
#define ATT_COMMIT(buf_, k0_, k1_, v0_, v1_) do { \
        { const int id = tid, key = id >> 4, c16 = id & 15; *(LAS u32x4*)(Kb + (buf_) * 8704 + key * 136 + 8 * c16) = k0_; } \
        { const int id = tid + NT, key = id >> 4, c16 = id & 15; *(LAS u32x4*)(Kb + (buf_) * 8704 + key * 136 + 8 * c16) = k1_; } \
        { const int id = tid, dv = id >> 3, c16 = id & 7; *(LAS u32x4*)(Vb + (buf_) * 9216 + dv * 72 + 8 * c16) = v0_; } \
        { const int id = tid + NT, dv = id >> 3, c16 = id & 7; *(LAS u32x4*)(Vb + (buf_) * 9216 + dv * 72 + 8 * c16) = v1_; } } while (0)
#define ATT_BAR() do { asm volatile("s_waitcnt lgkmcnt(0)" ::: "memory"); __builtin_amdgcn_s_barrier(); asm volatile("" ::: "memory"); } while (0)
    __syncthreads();
    ATT_ISSUE(0, kA0, kA1, vA0, vA1); ATT_COMMIT(0, kA0, kA1, vA0, vA1);
    ATT_ISSUE(1, kB0, kB1, vB0, vB1);
    __syncthreads();
    u32x2 mw_next = *(const u32x2*)(mask + (size_t)qrow * 64);
#define ATT_TILE(kt, ISSUE_, COMMIT_) do { const int buf = (kt) & 1; \
        ISSUE_; \
        if (kt < myNT) { \
            const u32x2 mw = mw_next; mw_next = *(const u32x2*)(mask + (size_t)qrow * 64 + 2 * (((kt) + 1 < NTL) ? (kt) + 1 : NTL - 1)); \
            f32x16 p0, p1; \
_Pragma("unroll") \
            for (int r = 0; r < 16; ++r) { p0[r] = 0.f; p1[r] = 0.f; } \
            const LAS bf16_t* kb = Kb + buf * 8704; \
_Pragma("unroll") \
            for (int s = 0; s < 8; ++s) { const bf16x8 a0 = *(const LAS bf16x8*)(kb + r32 * 136 + 16 * s + 8 * hi), a1 = *(const LAS bf16x8*)(kb + (32 + r32) * 136 + 16 * s + 8 * hi); \
                p0 = MFMA32(a0, qf[s], p0); p1 = MFMA32(a1, qf[s], p1); } \
            const int lo = (int)(mw.x >> (4 * hi)), hi_w = (int)(mw.y >> (4 * hi)); \
            float mx = -INFINITY; \
_Pragma("unroll") \
            for (int r = 0; r < 16; ++r) { const int cb = (r & 3) + 8 * (r >> 2); \
                const int m0 = __builtin_amdgcn_sbfe(lo, cb, 1), m1 = __builtin_amdgcn_sbfe(hi_w, cb, 1);        \
                p0[r] = __int_as_float((__float_as_int(p0[r]) & m0) | (~m0 & (int)0xff800000)); p1[r] = __int_as_float((__float_as_int(p1[r]) & m1) | (~m1 & (int)0xff800000)); \
                mx = fmaxf(mx, fmaxf(p0[r], p1[r])); } \
            mx = fmaxf(mx, __shfl_xor(mx, 32)); \
              \
            if (__any((mx - m_run) * C2 > 8.0f)) { \
                const float m_new = fmaxf(m_run, mx); \
                const float alpha = __builtin_amdgcn_exp2f((m_run - m_new) * C2); \
                l_run *= alpha; m_run = m_new; \
_Pragma("unroll") \
                for (int d = 0; d < 4; ++d) \
_Pragma("unroll") \
                    for (int r = 0; r < 16; ++r) ot[d][r] *= alpha; \
            } \
            const float mc = m_run * C2; \
            float ls = 0.f; \
_Pragma("unroll") \
            for (int r = 0; r < 16; ++r) { p0[r] = __builtin_amdgcn_exp2f(fmaf(p0[r], C2, -mc)); p1[r] = __builtin_amdgcn_exp2f(fmaf(p1[r], C2, -mc)); ls += p0[r] + p1[r]; } \
            l_run += ls; \
            bf16x8 pb[4]; \
_Pragma("unroll") \
            for (int s = 0; s < 4; ++s) { u32x4 w; \
                if (s < 2) { w.x = pg8::cvt_pk_bf16(p0[8 * s + 0], p0[8 * s + 1]); w.y = pg8::cvt_pk_bf16(p0[8 * s + 2], p0[8 * s + 3]); w.z = pg8::cvt_pk_bf16(p0[8 * s + 4], p0[8 * s + 5]); w.w = pg8::cvt_pk_bf16(p0[8 * s + 6], p0[8 * s + 7]); } \
                else { const int s2 = s - 2; w.x = pg8::cvt_pk_bf16(p1[8 * s2 + 0], p1[8 * s2 + 1]); w.y = pg8::cvt_pk_bf16(p1[8 * s2 + 2], p1[8 * s2 + 3]); w.z = pg8::cvt_pk_bf16(p1[8 * s2 + 4], p1[8 * s2 + 5]); w.w = pg8::cvt_pk_bf16(p1[8 * s2 + 6], p1[8 * s2 + 7]); } \
                pb[s] = __builtin_bit_cast(bf16x8, w); } \
            const LAS bf16_t* vb = Vb + buf * 9216; \
_Pragma("unroll") \
            for (int d = 0; d < 4; ++d) \
_Pragma("unroll") \
                for (int s = 0; s < 4; ++s) { const LAS bf16_t* vp = vb + (32 * d + r32) * 72 + 16 * s + 4 * hi; \
                    const u32x2 v0 = *(const LAS u32x2*)vp, v1 = *(const LAS u32x2*)(vp + 8); \
                    const bf16x8 af = __builtin_bit_cast(bf16x8, (u32x4){v0.x, v0.y, v1.x, v1.y}); \
                    ot[d] = MFMA32(af, pb[s], ot[d]); } \
        } \
        COMMIT_; \
        ATT_BAR(); } while (0)
    for (int kt = 0; kt < NTL; kt += 2) {
        ATT_TILE(kt, ATT_ISSUE(((kt + 2 < NTL) ? kt + 2 : NTL - 1), kA0, kA1, vA0, vA1), ATT_COMMIT(1, kB0, kB1, vB0, vB1));
        ATT_TILE(kt + 1, ATT_ISSUE(((kt + 3 < NTL) ? kt + 3 : NTL - 1), kB0, kB1, vB0, vB1), ATT_COMMIT(0, kA0, kA1, vA0, vA1));
    }
#undef ATT_TILE
    const float lt = l_run + __shfl_xor(l_run, 32);
    const float inv = 1.f / lt;
    bf16_t* ob = (bf16_t*)(ws + WS_OB) + (size_t)qrow * DM + head * DHD;
#pragma unroll
    for (int d = 0; d < 4; ++d)
#pragma unroll
        for (int g = 0; g < 4; ++g) { u32x2 w; w.x = pg8::cvt_pk_bf16(ot[d][4 * g] * inv, ot[d][4 * g + 1] * inv); w.y = pg8::cvt_pk_bf16(ot[d][4 * g + 2] * inv, ot[d][4 * g + 3] * inv);
            *(u32x2*)(ob + 32 * d + 8 * g + 4 * hi) = w; }
}

__device__ __forceinline__ void oa_norm_rows(const Ctx& X, const float* gng) {
    const int gw = X.bid * NW + X.wave, NGW = X.G * NW, lane = X.lane;
    const float* oa = (const float*)(X.ws + WS_OA); const bf16_t* ra = (const bf16_t*)(X.ws + WS_RA); bf16_t* oan = (bf16_t*)(X.ws + WS_H);
    for (int row = gw; row < MTOK; row += NGW) {
        const int bc = row >> 6, tl = row & 63, tt = tl >> 5, rr = tl & 31, hi = (rr >> 2) & 1, r = (rr & 3) + 4 * (rr >> 3);
#pragma unroll
        for (int hh = 0; hh < GH; ++hh) {
            const size_t off = (size_t)row * DM + hh * GDV + 4 * lane;
            const size_t ib = ((size_t)(((bc * 4 + hh) * 8 + (lane >> 4)) * 2 + ((lane >> 3) & 1)) * 32 + tt * 16 + r) * 64 + 32 * hi + 4 * (lane & 7);
            const f32x4 v0 = *(const f32x4*)(oa + ib), v1 = *(const f32x4*)(oa + ib + (size_t)4 * 2 * 32 * 64);
            float s = (v0[0] * v0[0] + v0[1] * v0[1]) + (v0[2] * v0[2] + v0[3] * v0[3]) + (v1[0] * v1[0] + v1[1] * v1[1]) + (v1[2] * v1[2] + v1[3] * v1[3]);
            const float rs = rsqrtf(wave_sum(s) * (1.f / GDV) + RMS_EPS);
            const f32x4 g0 = *(const f32x4*)(gng + hh * GDV + 4 * lane), g1 = *(const f32x4*)(gng + hh * GDV + 4 * lane + 256);
            const f32x4 r0 = pg8::bf4_to_f32(*(const u32x2*)(ra + off)), r1 = pg8::bf4_to_f32(*(const u32x2*)(ra + off + 256));
            const f32x4 y0 = v0 * rs * g0 * r0, y1 = v1 * rs * g1 * r1;
            *(u32x2*)(oan + off) = (u32x2){pk2(y0[0], y0[1]), pk2(y0[2], y0[3])}; *(u32x2*)(oan + off + 256) = (u32x2){pk2(y1[0], y1[1]), pk2(y1[2], y1[3])};
        }
    }
}


constexpr int NPHASE = 13;

__global__ void __launch_bounds__(NT, 2) fwd_kernel(Args args) {
    extern __shared__ __attribute__((aligned(16))) unsigned char lds_raw[];
    cg::grid_group grid = cg::this_grid();
    Ctx X;
    X.lds = (LAS unsigned char*)lds_raw; X.ws = (GAS unsigned char*)args.ws;
    X.tid = threadIdx.x; X.lane = X.tid & 63; X.wave = __builtin_amdgcn_readfirstlane(X.tid >> 6);
    X.bid = blockIdx.x; X.G = gridDim.x;
    if (X.tid < 18) { const float* pv_ = (X.tid < 17) ? args.in[X.tid < 17 ? X.tid : 0] : (const float*)args.out; *(LAS unsigned long long*)(X.lds + LDS_PTAB + 8 * X.tid) = (unsigned long long)pv_; }
    if (X.tid < 2) ((volatile LAS unsigned*)(X.lds + LDS_PTAB + 160))[X.tid] = 0u;
    __syncthreads();
    XcdBarrier xbar = xcd_barrier_post((unsigned*)(args.ws + WS_CTL) + 4096, (volatile LAS unsigned*)(X.lds + LDS_PTAB + 160));
    GAS unsigned char* ws = (GAS unsigned char*)args.ws;
#define mod ((float*)(ws + WS_MOD))
    const int lo = args.ph_lo, hi = args.ph_hi;
    STAMP(13);
#ifdef EXTRA_SYNCS
    for (int es_ = 0; es_ < EXTRA_SYNCS; ++es_) grid.sync();
#endif
#ifndef PH_ONLY
#define PH_ONLY -1
#endif
#ifndef PH_MASK
#define PH_MASK 0x1fff
#endif
#define IN(k) ((PH_ONLY < 0 || PH_ONLY == (k)) && ((PH_MASK >> (k)) & 1) && lo <= (k) && (k) < hi)
#define LAUNDER() do { int t_ = threadIdx.x; asm volatile("" : "+v"(t_)); X.tid = t_; X.lane = t_ & 63; X.wave = __builtin_amdgcn_readfirstlane(t_ >> 6); \
        unsigned char* w_ = args.ws; asm volatile("" : "+s"(w_)); ws = (GAS unsigned char*)w_; X.ws = ws; } while (0)
#ifndef USE_CG_SYNC
#define GSYNC(k) xcd_barrier(xbar)
#else
#define GSYNC(k) grid.sync()
#endif
#define SEAM(k) do { STAMP(k); if (IN(k) && IN((k) + 1)) GSYNC(k); } while (0)

    if (IN(0)) {
    { LAUNDER(); p0_prologue<true>(X); }
    }
    SEAM(0);
    if (IN(1)) {
    { LAUNDER(); norm1_rows(X, INP(X, I_X), INP(X, I_N1G), INP(X, I_BADA), mod, (bf16_t*)(ws + WS_H)); }
    }
    SEAM(1);
    if (IN(2)) {
    { LAUNDER();
        pg8::Gemm g{(const bf16_t*)(ws + WS_H), (const bf16_t*)(ws + WS_WIN), MTOK, INWP, DM}; pg8::StaticOrder S; S.init(MTOK, INWP, X.G, X.bid);
        pg8::EpiInProj E{(unsigned char*)ws};
        pg8::gemm_phase<pg8::EpiInProj, pg8::StaticOrder, true, true>(X.lds, g, S, E);
    }
    }
    SEAM(2);
    if (IN(3)) {
    { LAUNDER();
        for (int u = X.bid; u < BATCH * NCH * GH; u += X.G) gla_prep_unit(X, args, u);
        dv_transpose(X);
        idx_prep(X);
        rope_qk(X);
    }
    }
    SEAM(3);
    if (IN(4)) {
    { LAUNDER();
        if (X.bid < 128) { const int xx = X.bid & 7, mm = X.bid >> 3; gla_scan_unit(X, (mm & 7) * 16 + xx + 8 * (mm >> 3)); STAMP(16); }
        {
            unsigned* qctr = (unsigned*)(ws + WS_CTL) + 64;
            volatile LAS unsigned* qsh = (volatile LAS unsigned*)(X.lds + LDS_MISC);
            const unsigned NQ = (unsigned)(BATCH * 128);
            if (X.bid >= 128) for (int e = 0; e < 2; ++e) { const unsigned uq = (unsigned)(X.bid - 128) + 128u * (unsigned)e; idx_topk_unit(X, (int)((uq & 3u) * 128u + (127u - (uq >> 2)))); }
            for (;;) {
                __syncthreads();
                if (X.tid == 0) qsh[0] = 256u + atomicAdd(qctr, 1u);
                __syncthreads();
                const unsigned uq = qsh[0];
                if (uq >= NQ) break;
                idx_topk_unit(X, (int)((uq & 3u) * 128u + (127u - (uq >> 2))));
            }
        }
    }
    }
    SEAM(4);
    if (IN(5)) {
    { LAUNDER();
        const int NU = BATCH * DH * 8;
        for (int i = 0; i * X.G < NU; ++i) {
            const int v = i * X.G + ((i & 1) ? (X.G - 1 - X.bid) : X.bid);
            if (v < NU) { const int qb = 7 - (v >> 6), bh = v & 63; dsa_attn_unit(X, bh >> 4, bh & 15, qb); }
        }
        STAMP(17);
        oa_norm_rows(X, INP(X, I_GNG));
    }
    }
    SEAM(5);
    if (IN(6)) {
    { LAUNDER();
        pg8::Gemm g{(const bf16_t*)(ws + WS_H), (const bf16_t*)(ws + WS_WBGA), MTOK, DM, DM}; pg8::StaticOrder S; S.init(MTOK, DM, X.G, X.bid);
        pg8::EpiScaleF32 E{(float*)(ws + WS_TMP), (const bf16_t*)(ws + WS_SGA)};
        pg8::gemm_phase<pg8::EpiScaleF32, pg8::StaticOrder, true, true>(X.lds, g, S, E);
    }
    }
    SEAM(6);
    if (IN(7)) {
    { LAUNDER();
        pg8::Gemm g{(const bf16_t*)(ws + WS_OB), (const bf16_t*)(ws + WS_WBDSA), MTOK, DM, DM}; pg8::StaticOrder S; S.init(MTOK, DM, X.G, X.bid);
        pg8::EpiMerge E{(bf16_t*)(ws + WS_MERGED), (const float*)(ws + WS_TMP), (const bf16_t*)(ws + WS_SGB)};
        pg8::gemm_phase<pg8::EpiMerge, pg8::StaticOrder, true, true>(X.lds, g, S, E);
    }
    }
    SEAM(7);
    if (IN(8)) {
    { LAUNDER();
        pg8::Gemm g{(const bf16_t*)(ws + WS_MERGED), (const bf16_t*)(ws + WS_WMO), MTOK, DM, DM}; pg8::StaticOrder S; S.init(MTOK, DM, X.G, X.bid);
        pg8::EpiResid E{INP(X, I_X), (float*)(ws + WS_X1), mod + 2 * DM};
        pg8::gemm_phase<pg8::EpiResid, pg8::StaticOrder, true, true>(X.lds, g, S, E);
    }
    }
    SEAM(8);
    if (IN(9)) {
    { LAUNDER(); norm_mod_rows(X, (const float*)(ws + WS_X1), INP(X, I_N2G), mod, 3, 4, (bf16_t*)(ws + WS_H)); }
    }
    SEAM(9);
    if (IN(10)) {
    { LAUNDER();
        pg8::Gemm g{(const bf16_t*)(ws + WS_H), (const bf16_t*)(ws + WS_WGU), MTOK, 2 * DFF, DM}; pg8::StaticOrder S; S.init(MTOK, 2 * DFF, X.G, X.bid);
        pg8::EpiSwiglu E{(bf16_t*)(ws + WS_ACT)};
        pg8::gemm_phase<pg8::EpiSwiglu, pg8::StaticOrder, true, true>(X.lds, g, S, E);
    }
    }
    SEAM(10);
    if (IN(11)) {
    { LAUNDER();
        pg8::Gemm g{(const bf16_t*)(ws + WS_ACT), (const bf16_t*)(ws + WS_WDN), MTOK, DM, DFF}; pg8::StaticOrder S; S.init(MTOK, DM, X.G, X.bid);
        pg8::EpiResid E{(const float*)(ws + WS_X1), (float*)INP(X, 17), mod + 5 * DM};
        pg8::gemm_phase<pg8::EpiResid, pg8::StaticOrder, true, true>(X.lds, g, S, E);
    }
    }
    SEAM(11);
    if (IN(12)) {
    { LAUNDER(); final_norm_rows(X, (float*)INP(X, 17), INP(X, I_FNG)); }
    }
    if (args.ph_lo > 4096) grid.sync();
#ifdef STAMP_A
    {
        STAMP(12);
        __threadfence(); grid.sync();
        if (X.bid == 0 && X.tid == 0) {
            const unsigned long long* ts = (const unsigned long long*)(ws + WS_DBG);
            unsigned long long e1 = 0, e0 = 0, mn = ~0ull;
            for (int b = 0; b < X.G; ++b) { const unsigned long long v = __hip_atomic_load(ts + STAMP_A * 256 + b, __ATOMIC_RELAXED, __HIP_MEMORY_SCOPE_AGENT); if (v) { e1 = v > e1 ? v : e1; mn = v < mn ? v : mn; } }
            for (int b = 0; b < X.G; ++b) { const unsigned long long v = __hip_atomic_load(ts + STAMP_B * 256 + b, __ATOMIC_RELAXED, __HIP_MEMORY_SCOPE_AGENT); e0 = v > e0 ? v : e0; }
#if STAMP_MODE == 1
            e1 = mn;
#endif
            const unsigned long long dur = (e1 > e0) ? (e1 - e0) : 0ull;
            const unsigned long long t0 = __builtin_amdgcn_s_memrealtime();
            while (__builtin_amdgcn_s_memrealtime() - t0 < 4ull * dur) __builtin_amdgcn_s_sleep(8);
        }
    }
#endif
#undef IN
#undef SEAM
#undef mod
}


extern "C" void kernel_launch(void* const* d_in, const int* in_sizes, int n_in, void* d_out, int out_size, void* d_ws, size_t ws_size, hipStream_t stream) {
    static int grid = 0;
    if (grid == 0) {
        if (n_in != 17 || out_size != MTOK * DM || ws_size < WS_END) { fprintf(stderr, "kernel_launch: unexpected shapes (n_in %d out %d ws %zu need %zu)\n", n_in, out_size, ws_size, (size_t)WS_END); grid = -1; return; }
        int dev = 0, cus = 0, per_cu = 0;
        if (hipGetDevice(&dev) != hipSuccess || hipDeviceGetAttribute(&cus, hipDeviceAttributeMultiprocessorCount, dev) != hipSuccess) { grid = -1; return; }
        if (hipFuncSetAttribute((const void*)fwd_kernel, hipFuncAttributeMaxDynamicSharedMemorySize, LDS_BYTES) != hipSuccess) { grid = -1; return; }
        if (hipOccupancyMaxActiveBlocksPerMultiprocessor(&per_cu, (const void*)fwd_kernel, NT, LDS_BYTES) != hipSuccess || per_cu < 1) { fprintf(stderr, "kernel_launch: occupancy query says %d\n", per_cu); }
        (void)hipGetLastError();
        grid = cus;
    }
    if (grid < 0) return;
    (void)hipMemsetAsync((char*)d_ws + WS_CTL, 0, CTL_BYTES, stream);
    Args a{};
    for (int i = 0; i < 17; ++i) a.in[i] = (const float*)d_in[i];
    a.out = (float*)d_out; a.ws = (unsigned char*)d_ws; a.ph_lo = 0; a.ph_hi = (PH_STOP < NPHASE) ? PH_STOP : NPHASE;
    void* kargs[] = {&a};
    hipError_t e = hipLaunchCooperativeKernel((const void*)fwd_kernel, dim3(grid), dim3(NT), kargs, LDS_BYTES, stream);
    if (e != hipSuccess) fprintf(stderr, "kernel_launch: cooperative launch failed: %s (grid %d)\n", hipGetErrorString(e), grid);
#if DBG
    dbg_run(a, stream);
#endif
}
```
